# Optimizing an MI355X kernel written in HIP

```python
import math
import jax, jax.numpy as jnp
from jax import lax
import numpy as np

D_MODEL = 1024
BATCH = 8
SEQ = 2048
DEPTH = 4

ATTN_HEADS = 6
ATTN_HEAD_DIM = 64
ATTN_WIDTH = ATTN_HEADS * ATTN_HEAD_DIM
MOBA_BLOCK = 256
MOBA_TOPK = 3
MOBA_QUERY_CHUNK = 64
SSD_HEADS = 6
SSD_HEAD_DIM = 64
SSD_WIDTH = SSD_HEADS * SSD_HEAD_DIM
SSD_GROUPS = 2
SSD_STATE = 128
SSD_CONV = 4
SSD_CHUNK = 128
XBC_WIDTH = SSD_WIDTH + 2 * SSD_GROUPS * SSD_STATE
POOL_WINDOWS = (2, 4, 8, 16)
POOL_GROUPS = len(POOL_WINDOWS)
POOL_GROUP_DIM = 64
POOL_WIDTH = POOL_GROUPS * POOL_GROUP_DIM
MIX_WIDTH = ATTN_WIDTH + SSD_WIDTH + POOL_WIDTH
IN_PROJ_WIDTH = 3 * ATTN_WIDTH + SSD_WIDTH + XBC_WIDTH + SSD_HEADS + POOL_WIDTH
FFN_HIDDEN = ((8 * D_MODEL // 3 + 255) // 256) * 256
NORM_EPS = 1e-6
NEG_INF = -1e30

kernel_name = 'hybrid_moba_ssd_pool_trunk'


def rmsnorm(x, g):
    xf = x.astype(jnp.float32)
    xf = xf * lax.rsqrt(jnp.mean(xf * xf, axis=-1, keepdims=True) + NORM_EPS)
    return xf.astype(x.dtype) * g


def causal_depthwise_conv(x, w, b):
    k_width, ch = w.shape
    y = lax.conv_general_dilated(
        x, w[:, None, :], window_strides=(1,), padding=[(k_width - 1, 0)],
        dimension_numbers=('NWC', 'WIO', 'NWC'), feature_group_count=ch)
    return y + b


def moba_attention(q, k, v):
    bsz, n_heads, seq, hd = q.shape
    n_blocks = -(-seq // MOBA_BLOCK)
    pad = n_blocks * MOBA_BLOCK - seq
    k_p = jnp.pad(k, ((0, 0), (0, 0), (0, pad), (0, 0)))
    v_p = jnp.pad(v, ((0, 0), (0, 0), (0, pad), (0, 0)))
    k_blocks = k_p.reshape(bsz, n_heads, n_blocks, MOBA_BLOCK, hd)
    v_blocks = v_p.reshape(bsz, n_heads, n_blocks, MOBA_BLOCK, hd)
    k_mean = jnp.mean(k_blocks, axis=3)
    n_sel = min(MOBA_TOPK, n_blocks)
    scale = hd ** -0.5
    b_idx = jnp.arange(bsz)[:, None, None, None]
    h_idx = jnp.arange(n_heads)[None, :, None, None]
    block_ids = jnp.arange(n_blocks)

    def query_chunk(c):
        q0 = c * MOBA_QUERY_CHUNK
        qc = lax.dynamic_slice_in_dim(q, q0, MOBA_QUERY_CHUNK, axis=2)
        blk = q0 // MOBA_BLOCK
        gate = jnp.einsum('bhqd,bhnd->bhqn', qc, k_mean).astype(jnp.float32)
        gate = jnp.where(block_ids < blk, gate, NEG_INF)
        _, idx = lax.top_k(gate, n_sel)
        valid = jnp.arange(n_sel) < blk
        k_sel = k_blocks[b_idx, h_idx, idx]
        v_sel = v_blocks[b_idx, h_idx, idx]
        s_sel = jnp.einsum('bhqd,bhqnkd->bhqnk', qc, k_sel).astype(jnp.float32) * scale
        s_sel = jnp.where(valid[:, None], s_sel, NEG_INF)
        s_sel = s_sel.reshape(bsz, n_heads, MOBA_QUERY_CHUNK, n_sel * MOBA_BLOCK)
        k_own = lax.dynamic_index_in_dim(k_blocks, blk, axis=2, keepdims=False)
        v_own = lax.dynamic_index_in_dim(v_blocks, blk, axis=2, keepdims=False)
        s_own = jnp.einsum('bhqd,bhkd->bhqk', qc, k_own).astype(jnp.float32) * scale
        q_pos = q0 + jnp.arange(MOBA_QUERY_CHUNK)
        k_pos = blk * MOBA_BLOCK + jnp.arange(MOBA_BLOCK)
        s_own = jnp.where(k_pos[None, :] <= q_pos[:, None], s_own, NEG_INF)
        p = jax.nn.softmax(jnp.concatenate([s_sel, s_own], axis=-1), axis=-1).astype(v.dtype)
        p_sel = p[..., :n_sel * MOBA_BLOCK].reshape(bsz, n_heads, MOBA_QUERY_CHUNK, n_sel, MOBA_BLOCK)
        p_own = p[..., n_sel * MOBA_BLOCK:]
        return (jnp.einsum('bhqnk,bhqnkd->bhqd', p_sel, v_sel)
                + jnp.einsum('bhqk,bhkd->bhqd', p_own, v_own))

    out = lax.map(query_chunk, jnp.arange(seq // MOBA_QUERY_CHUNK))
    return out.transpose(1, 0, 3, 2, 4).reshape(bsz, seq, n_heads * hd)


def ssd_mixer(xbc, z, dt_raw, conv_w, conv_b, dt_bias, a_log, d_skip, norm_w):
    bsz, seq, _ = xbc.shape
    n_chunks = seq // SSD_CHUNK
    rep = SSD_HEADS // SSD_GROUPS
    xbc = jax.nn.silu(causal_depthwise_conv(xbc, conv_w, conv_b)).astype(jnp.float32)
    xs, b_in, c_in = jnp.split(xbc, [SSD_WIDTH, SSD_WIDTH + SSD_GROUPS * SSD_STATE], axis=-1)
    x_h = xs.reshape(bsz, seq, SSD_HEADS, SSD_HEAD_DIM)
    b_h = jnp.repeat(b_in.reshape(bsz, seq, SSD_GROUPS, SSD_STATE), rep, axis=2)
    c_h = jnp.repeat(c_in.reshape(bsz, seq, SSD_GROUPS, SSD_STATE), rep, axis=2)
    dt = jax.nn.softplus(dt_raw.astype(jnp.float32) + dt_bias.astype(jnp.float32))
    a = -jnp.exp(a_log.astype(jnp.float32))

    def chunks(t):
        return t.reshape((bsz, n_chunks, SSD_CHUNK) + t.shape[2:])

    xdt = chunks(x_h * dt[..., None])
    b_c, c_c = chunks(b_h), chunks(c_h)
    a_cum = jnp.cumsum(chunks(dt * a).transpose(0, 3, 1, 2), axis=-1)
    causal = jnp.tril(jnp.ones((SSD_CHUNK, SSD_CHUNK), dtype=bool))
    decay = jnp.exp(jnp.where(causal, a_cum[..., :, None] - a_cum[..., None, :], -jnp.inf))
    y_diag = jnp.einsum('bclhn,bcshn,bhcls,bcshp->bclhp', c_c, b_c, decay, xdt)
    decay_to_end = jnp.exp(a_cum[..., -1:] - a_cum)
    states = jnp.einsum('bclhn,bhcl,bclhp->bchpn', b_c, decay_to_end, xdt)
    chunk_decay = jnp.exp(a_cum[..., -1])

    def step(h, inp):
        st, d = inp
        return h * d[..., None, None] + st, h

    _, prev = lax.scan(step, jnp.zeros_like(states[:, 0]),
                       (states.transpose(1, 0, 2, 3, 4), chunk_decay.transpose(2, 0, 1)))
    prev = prev.transpose(1, 0, 2, 3, 4)
    y_off = jnp.einsum('bclhn,bchpn,bhcl->bclhp', c_c, prev, jnp.exp(a_cum))
    y = (y_diag + y_off).reshape(bsz, seq, SSD_HEADS, SSD_HEAD_DIM) + x_h * d_skip.astype(jnp.float32)[:, None]
    y = y.reshape(bsz, seq, SSD_WIDTH) * jax.nn.silu(z.astype(jnp.float32))
    yg = y.reshape(bsz, seq, SSD_GROUPS, SSD_WIDTH // SSD_GROUPS)
    yg = yg * lax.rsqrt(jnp.mean(yg * yg, axis=-1, keepdims=True) + NORM_EPS)
    return (yg.reshape(bsz, seq, SSD_WIDTH) * norm_w.astype(jnp.float32)).astype(z.dtype)


def pool_mixer(p, pool_w, pool_scale):
    bsz, seq, _ = p.shape
    pg = p.astype(jnp.float32).reshape(bsz, seq, POOL_GROUPS, POOL_GROUP_DIM)
    csum = jnp.concatenate([jnp.zeros_like(pg[:, :1]), jnp.cumsum(pg, axis=1)], axis=1)
    t = jnp.arange(seq)[:, None]
    win = jnp.asarray(POOL_WINDOWS, dtype=jnp.int32)[None, :]
    start = jnp.maximum(t + 1 - win, 0)
    lower = csum[:, start, jnp.arange(POOL_GROUPS)[None, :], :]
    count = jnp.minimum(t + 1, win).astype(jnp.float32)
    mean = (csum[:, 1:] - lower) / count[None, :, :, None]
    mixed = jnp.einsum('bsgc,gcd->bsgd', mean - pg, pool_w.astype(jnp.float32))
    return (mixed.reshape(bsz, seq, POOL_WIDTH) * pool_scale.astype(jnp.float32)).astype(p.dtype)


def hybrid_layer(x, norm_mix, w_in, conv_w, conv_b, dt_bias, a_log, d_skip, ssd_norm,
                 pool_w, pool_scale, w_out, norm_ffn, w_gate_up, w_down):
    bsz, seq, _ = x.shape
    h = rmsnorm(x, norm_mix)
    u = h @ w_in
    sizes = (ATTN_WIDTH, ATTN_WIDTH, ATTN_WIDTH, SSD_WIDTH, XBC_WIDTH, SSD_HEADS, POOL_WIDTH)
    offsets = []
    acc = 0
    for s in sizes[:-1]:
        acc += s
        offsets.append(acc)
    q, k, v, z, xbc, dt_raw, p_in = jnp.split(u, offsets, axis=-1)

    def heads(t):
        return t.reshape(bsz, seq, ATTN_HEADS, ATTN_HEAD_DIM).transpose(0, 2, 1, 3)

    y_attn = moba_attention(heads(q), heads(k), heads(v))
    y_ssd = ssd_mixer(xbc, z, dt_raw, conv_w, conv_b, dt_bias, a_log, d_skip, ssd_norm)
    y_pool = pool_mixer(p_in, pool_w, pool_scale)
    x = x + jnp.concatenate([y_attn, y_ssd, y_pool], axis=-1) @ w_out
    h = rmsnorm(x, norm_ffn)
    gate, up = jnp.split(h @ w_gate_up, 2, axis=-1)
    return x + (jax.nn.silu(gate) * up) @ w_down


def setup_inputs(seed: int = 0) -> dict:
    key = jax.random.key(seed)
    ks = jax.random.split(key, 16)
    nrm = jax.random.normal
    dt0 = jnp.exp(jax.random.uniform(ks[5], (DEPTH, SSD_HEADS), minval=math.log(1e-3), maxval=math.log(1e-1)))
    return {
        'x': nrm(ks[0], (BATCH, SEQ, D_MODEL), jnp.float32),
        'norm_mix': 1.0 + 0.05 * nrm(ks[1], (DEPTH, D_MODEL), jnp.float32),
        'w_in': nrm(ks[2], (DEPTH, D_MODEL, IN_PROJ_WIDTH), jnp.float32) * D_MODEL ** -0.5,
        'conv_w': nrm(ks[3], (DEPTH, SSD_CONV, XBC_WIDTH), jnp.float32) * SSD_CONV ** -0.5,
        'conv_b': 0.02 * nrm(ks[4], (DEPTH, XBC_WIDTH), jnp.float32),
        'dt_bias': dt0 + jnp.log(-jnp.expm1(-dt0)),
        'a_log': jnp.log(jax.random.uniform(ks[6], (DEPTH, SSD_HEADS), minval=1.0, maxval=16.0)),
        'd_skip': 1.0 + 0.1 * nrm(ks[7], (DEPTH, SSD_HEADS), jnp.float32),
        'ssd_norm': 1.0 + 0.05 * nrm(ks[8], (DEPTH, SSD_WIDTH), jnp.float32),
        'pool_w': nrm(ks[9], (DEPTH, POOL_GROUPS, POOL_GROUP_DIM, POOL_GROUP_DIM), jnp.float32) * POOL_GROUP_DIM ** -0.5,
        'pool_scale': 1.0 + 0.1 * nrm(ks[10], (DEPTH, POOL_WIDTH), jnp.float32),
        'w_out': nrm(ks[11], (DEPTH, MIX_WIDTH, D_MODEL), jnp.float32) * MIX_WIDTH ** -0.5,
        'norm_ffn': 1.0 + 0.05 * nrm(ks[12], (DEPTH, D_MODEL), jnp.float32),
        'w_gate_up': nrm(ks[13], (DEPTH, D_MODEL, 2 * FFN_HIDDEN), jnp.float32) * D_MODEL ** -0.5,
        'w_down': nrm(ks[14], (DEPTH, FFN_HIDDEN, D_MODEL), jnp.float32) * FFN_HIDDEN ** -0.5,
        'norm_final': 1.0 + 0.05 * nrm(ks[15], (D_MODEL,), jnp.float32),
    }


def reference(x, norm_mix, w_in, conv_w, conv_b, dt_bias, a_log, d_skip, ssd_norm,
              pool_w, pool_scale, w_out, norm_ffn, w_gate_up, w_down, norm_final):
    for l in range(DEPTH):
        x = hybrid_layer(x, norm_mix[l], w_in[l], conv_w[l], conv_b[l], dt_bias[l], a_log[l],
                         d_skip[l], ssd_norm[l], pool_w[l], pool_scale[l], w_out[l],
                         norm_ffn[l], w_gate_up[l], w_down[l])
    return rmsnorm(x, norm_final)
```

```cpp
#include <hip/hip_runtime.h>
#include <hip/hip_cooperative_groups.h>
#include <cstdio>
#include <cstdint>
namespace cg = cooperative_groups;
namespace pg8 {
#define PG8_LAS __attribute__((address_space(3)))
typedef unsigned short bf16_t;
typedef short bf16x8 __attribute__((ext_vector_type(8)));
typedef float f32x4 __attribute__((ext_vector_type(4)));
typedef unsigned u32x4 __attribute__((ext_vector_type(4)));
constexpr int BM = 256, BK = 64, HALF = 128, HTB = HALF * BK * 2  , STAGE_BYTES = 8 * HTB, NXCD = 8, WGM = 8;

__host__ __device__ __forceinline__ int lds_byte(int r, int c) { const int st = (r >> 4) * 2 + (c >> 5), rr = r & 15, cc = c & 31, ob = rr * 64 + cc * 2; return st * 1024 + (ob ^ (((ob >> 9) & 1) << 5)); }
__host__ __device__ __forceinline__ void stage_rc(int b, int& R, int& C) { const int st = b / 1024, sb = b % 1024, swz = sb ^ (((sb >> 9) & 1) << 5); R = (st >> 1) * 16 + swz / 64; C = (st & 1) * 32 + (swz % 64) / 2; }
__host__ __device__ __forceinline__ int perm32(int rho) { const int n = rho >> 4, i = rho & 15; return 8 * (i >> 2) + 4 * n + (i & 3); }

struct Unit { int pm, pn; };
struct Gemm { const bf16_t* A; const bf16_t* Bt; int M, N, K; };

struct StaticOrder {
    int nM, nN, nwg, G, c;
    __host__ __device__ void init(int M, int N, int G_, int c_) { nM = M / BM; nN = N / BM; nwg = nM * nN; G = G_; c = c_; }
    __host__ __device__ bool next(int i, Unit& u) const {
        const long L = (long)i * G + c; if (L >= nwg) return false;
        int wgid = (int)L; { const int q = nwg / NXCD, r = nwg % NXCD, xcd = wgid % NXCD, off = wgid / NXCD; wgid = (xcd < r ? xcd * (q + 1) : r * (q + 1) + (xcd - r) * q) + off; }
        const int nig = WGM * nN, gid = wgid / nig, fm = gid * WGM, gsz = (nM - fm) < WGM ? (nM - fm) : WGM;
        u.pm = fm + ((wgid % nig) % gsz); u.pn = (wgid % nig) / gsz; return true;
    }
    __device__ __forceinline__ void a_ready(const Unit&) const {}
    __device__ __forceinline__ void done(const Unit&) const {}
};

__device__ __forceinline__ unsigned cvt_pk_bf16(float lo, float hi) { unsigned r; asm volatile("v_cvt_pk_bf16_f32 %0, %1, %2" : "=v"(r) : "v"(lo), "v"(hi)); return r; }
struct EpiStoreBf16 {
    static constexpr bool PERM = true, AFTER_DRAIN = false;
    bf16_t* O; int ldc;
    __device__ __forceinline__ void operator()(const f32x4 (&acc)[2][2][4][2], const Unit& u, int wr, int wc, int fr, int fq) const {
        const int row0 = u.pm * BM + wr * 64 + fr; const int col0 = u.pn * BM + wc * 32 + 8 * fq;
#pragma unroll
        for (int ai = 0; ai < 2; ++ai)
#pragma unroll
            for (int m = 0; m < 4; ++m) { bf16_t* rowp = O + (size_t)(row0 + ai * HALF + m * 16) * ldc + col0;
#pragma unroll
                for (int bj = 0; bj < 2; ++bj) { const f32x4 v0 = acc[ai][bj][m][0], v1 = acc[ai][bj][m][1];
                    u32x4 w; w.x = cvt_pk_bf16(v0[0], v0[1]); w.y = cvt_pk_bf16(v0[2], v0[3]); w.z = cvt_pk_bf16(v1[0], v1[1]); w.w = cvt_pk_bf16(v1[2], v1[3]);
                    *(u32x4*)(rowp + bj * HALF) = w; } }
    }
};
struct EpiResidual {
    static constexpr bool PERM = true, AFTER_DRAIN = false;
    const float* R; float* X; int ld;
    __device__ __forceinline__ void operator()(const f32x4 (&acc)[2][2][4][2], const Unit& u, int wr, int wc, int fr, int fq) const {
        const int row0 = u.pm * BM + wr * 64 + fr; const int col0 = u.pn * BM + wc * 32 + 8 * fq;
#pragma unroll
        for (int ai = 0; ai < 2; ++ai)
#pragma unroll
            for (int m = 0; m < 4; ++m) { const size_t off = (size_t)(row0 + ai * HALF + m * 16) * ld + col0;
#pragma unroll
                for (int bj = 0; bj < 2; ++bj) {
                    const f32x4 r0 = *(const f32x4*)(R + off + bj * HALF), r1 = *(const f32x4*)(R + off + bj * HALF + 4);
                    *(f32x4*)(X + off + bj * HALF) = r0 + acc[ai][bj][m][0]; *(f32x4*)(X + off + bj * HALF + 4) = r1 + acc[ai][bj][m][1]; } __builtin_amdgcn_sched_barrier(0); }
    }
};
__device__ __forceinline__ float silu_f(float g) { return g * __builtin_amdgcn_rcpf(1.f + __expf(-g)); }
struct EpiSwiGLU {
    static constexpr bool PERM = true, AFTER_DRAIN = false;
    bf16_t* O; int ldc;
    __device__ __forceinline__ void operator()(const f32x4 (&acc)[2][2][4][2], const Unit& u, int wr, int wc, int fr, int fq) const {
        const int row0 = u.pm * BM + wr * 64 + fr; const int col0 = u.pn * HALF + wc * 32 + 8 * fq;
#pragma unroll
        for (int ai = 0; ai < 2; ++ai)
#pragma unroll
            for (int m = 0; m < 4; ++m) { bf16_t* rowp = O + (size_t)(row0 + ai * HALF + m * 16) * ldc + col0;
                const f32x4 g0 = acc[ai][0][m][0], g1 = acc[ai][0][m][1], u0 = acc[ai][1][m][0], u1 = acc[ai][1][m][1];
                u32x4 w; w.x = cvt_pk_bf16(silu_f(g0[0]) * u0[0], silu_f(g0[1]) * u0[1]); w.y = cvt_pk_bf16(silu_f(g0[2]) * u0[2], silu_f(g0[3]) * u0[3]);
                w.z = cvt_pk_bf16(silu_f(g1[0]) * u1[0], silu_f(g1[1]) * u1[1]); w.w = cvt_pk_bf16(silu_f(g1[2]) * u1[2], silu_f(g1[3]) * u1[3]);
                *(u32x4*)rowp = w; __builtin_amdgcn_sched_barrier(0); }
    }
};
template <class Epi, class Sched, bool ALIGN_EPI = false, bool SP2 = false>
__device__ __forceinline__ void gemm_phase(PG8_LAS unsigned char* lds, const Gemm g, const Sched& S, const Epi& E, const int tid) {
    const int wid = __builtin_amdgcn_readfirstlane(tid >> 6), lane = tid & 63, wr = wid >> 2, wc = wid & 3, fr = lane & 15, fq = lane >> 4;
    const int K = g.K, nt = K / BK;
    unsigned voffA[2], voffB[2];
#pragma unroll
    for (int i = 0; i < 2; ++i) { int R, C; stage_rc(tid * 16 + i * 8192, R, C); const int Rb = Epi::PERM ? ((R & ~31) + perm32(R & 31)) : R;
        voffA[i] = (unsigned)(R * K + C) * 2u; voffB[i] = (unsigned)(Rb * K + C) * 2u; }
    const size_t kstep = (size_t)(BK * 2);
    const size_t hstep = (size_t)HALF * K * 2;
    const size_t tstep = 2 * hstep;
    const unsigned ldsw = (unsigned)wid * 1024u;
    const int aoff = lds_byte(wr * 64 + fr, fq * 8), boff = lds_byte(wc * 32 + fr, fq * 8);
#define PG8_SA(b, h) (((b) * 2 + (h)) * HTB)
#define PG8_SB(b, h) ((4 + (b) * 2 + (h)) * HTB)
#define PG8_STAGE(bufoff, gbase, voff) do { _Pragma("unroll") for (int _i = 0; _i < 2; ++_i) \
        __builtin_amdgcn_global_load_lds((const unsigned*)((const char*)(gbase) + (voff)[_i]), (PG8_LAS unsigned*)(lds + (bufoff) + ldsw + _i * 8192), 16, 0, 0); } while (0)
#define PG8_LDA(dst, b, h) do { _Pragma("unroll") for (int m = 0; m < 4; ++m) _Pragma("unroll") for (int k = 0; k < 2; ++k) dst[m][k] = *(const PG8_LAS bf16x8*)(lds + PG8_SA(b, h) + aoff + m * 2048 + k * 1024); } while (0)
#define PG8_LDB(dst, b, h) do { _Pragma("unroll") for (int n = 0; n < 2; ++n) _Pragma("unroll") for (int k = 0; k < 2; ++k) dst[n][k] = *(const PG8_LAS bf16x8*)(lds + PG8_SB(b, h) + boff + n * 2048 + k * 1024); } while (0)
#define PG8_MMA(ai, bj, At, Bt) do { __builtin_amdgcn_s_setprio(1); _Pragma("unroll") for (int m = 0; m < 4; ++m) _Pragma("unroll") for (int n = 0; n < 2; ++n) _Pragma("unroll") for (int k = 0; k < 2; ++k) \
        acc[ai][bj][m][n] = __builtin_amdgcn_mfma_f32_16x16x32_bf16(Bt[n][k], At[m][k], acc[ai][bj][m][n], 0, 0, 0); __builtin_amdgcn_s_setprio(0); } while (0)
#define PG8_WAIT_V(n) asm volatile("s_waitcnt vmcnt(" #n ")" ::: "memory")
#define PG8_WAIT_L(n) asm volatile("s_waitcnt lgkmcnt(" #n ")" ::: "memory")
#define PG8_BAR __builtin_amdgcn_s_barrier()
#define PG8_SCHED __builtin_amdgcn_sched_barrier(0)
    Unit cur, nxt; int ui = 0;
    if (!S.next(0, cur)) return;
    f32x4 acc[2][2][4][2];
#pragma unroll
    for (int a = 0; a < 2; ++a)
#pragma unroll
        for (int b = 0; b < 2; ++b)
#pragma unroll
            for (int m = 0; m < 4; ++m)
#pragma unroll
                for (int n = 0; n < 2; ++n) acc[a][b][m][n] = (f32x4){0.f, 0.f, 0.f, 0.f};
    bf16x8 At[4][2], B0[2][2], B1[2][2];
    const char* cA = (const char*)g.A + (size_t)cur.pm * tstep; const char* cB = (const char*)g.Bt + (size_t)cur.pn * tstep;
    S.a_ready(cur);
    if constexpr (SP2) {
        PG8_STAGE(PG8_SB(0, 0), cB, voffB); PG8_STAGE(PG8_SB(0, 1), cB + hstep, voffB); PG8_STAGE(PG8_SA(0, 0), cA, voffA); PG8_STAGE(PG8_SA(0, 1), cA + hstep, voffA);
        if (wr == 1) PG8_BAR;
        PG8_WAIT_V(2); PG8_BAR;
        PG8_STAGE(PG8_SB(1, 0), cB + kstep, voffB); PG8_STAGE(PG8_SA(1, 0), cA + kstep, voffA); PG8_STAGE(PG8_SB(1, 1), cB + hstep + kstep, voffB);
        PG8_WAIT_V(6); PG8_BAR;
    } else {
        PG8_STAGE(PG8_SB(0, 0), cB, voffB); PG8_STAGE(PG8_SA(0, 0), cA, voffA); PG8_STAGE(PG8_SB(0, 1), cB + hstep, voffB); PG8_STAGE(PG8_SA(0, 1), cA + hstep, voffA);
        if (wr == 1) PG8_BAR;
        PG8_WAIT_V(4); PG8_BAR;
        PG8_STAGE(PG8_SB(1, 0), cB + kstep, voffB); PG8_STAGE(PG8_SA(1, 0), cA + kstep, voffA); PG8_STAGE(PG8_SB(1, 1), cB + hstep + kstep, voffB);
        PG8_WAIT_V(6); PG8_BAR;
    }
    for (;;) {
        const bool has_next = S.next(ui + 1, nxt);
        const char* nA = has_next ? (const char*)g.A + (size_t)nxt.pm * tstep : cA; const char* nB = has_next ? (const char*)g.Bt + (size_t)nxt.pn * tstep : cB;
        for (int t = 0; t < nt; t += 2) {
            const bool last = (t == nt - 2);
            const char* a1 = cA + (size_t)(t + 1) * kstep;
            const char* a2 = last ? nA : cA + (size_t)(t + 2) * kstep; const char* b2 = last ? nB : cB + (size_t)(t + 2) * kstep;
            const char* a3 = a2 + kstep; const char* b3 = b2 + kstep;
            if (last && has_next) S.a_ready(nxt);
            if constexpr (SP2) {
            PG8_LDB(B0, 0, 0); PG8_LDB(B1, 0, 1); PG8_SCHED; PG8_LDA(At, 0, 0); PG8_STAGE(PG8_SA(1, 1), a1 + hstep, voffA);
            PG8_WAIT_V(8); PG8_WAIT_L(0); PG8_BAR; PG8_MMA(0, 0, At, B0); PG8_MMA(0, 1, At, B1); PG8_BAR; PG8_SCHED;
            PG8_LDA(At, 0, 1); PG8_STAGE(PG8_SB(0, 0), b2, voffB); PG8_STAGE(PG8_SB(0, 1), b2 + hstep, voffB); PG8_STAGE(PG8_SA(0, 0), a2, voffA);
            PG8_WAIT_V(8); PG8_WAIT_L(0); PG8_BAR; PG8_MMA(1, 0, At, B0); PG8_MMA(1, 1, At, B1); PG8_BAR; PG8_SCHED;
            PG8_LDB(B0, 1, 0); PG8_LDB(B1, 1, 1); PG8_SCHED; PG8_LDA(At, 1, 0); PG8_STAGE(PG8_SA(0, 1), a2 + hstep, voffA);
            PG8_WAIT_V(8); PG8_WAIT_L(0); PG8_BAR; PG8_MMA(0, 0, At, B0); PG8_MMA(0, 1, At, B1); PG8_BAR; PG8_SCHED;
            PG8_LDA(At, 1, 1); PG8_STAGE(PG8_SB(1, 0), b3, voffB); PG8_STAGE(PG8_SB(1, 1), b3 + hstep, voffB); PG8_STAGE(PG8_SA(1, 0), a3, voffA);
            PG8_WAIT_V(8); PG8_WAIT_L(0); PG8_BAR; PG8_MMA(1, 0, At, B0); PG8_MMA(1, 1, At, B1); PG8_BAR; PG8_SCHED;
            } else {
            PG8_LDB(B0, 0, 0); PG8_SCHED; PG8_LDA(At, 0, 0); PG8_STAGE(PG8_SA(1, 1), a1 + hstep, voffA);
            PG8_WAIT_L(8); PG8_BAR; PG8_WAIT_L(0); PG8_MMA(0, 0, At, B0); PG8_BAR; PG8_SCHED;
            PG8_LDB(B1, 0, 1); PG8_STAGE(PG8_SB(0, 0), b2, voffB);
            PG8_BAR; PG8_WAIT_L(0); PG8_MMA(0, 1, At, B1); PG8_BAR;
            PG8_LDA(At, 0, 1); PG8_STAGE(PG8_SA(0, 0), a2, voffA);
            PG8_BAR; PG8_WAIT_L(0); PG8_MMA(1, 0, At, B0); PG8_BAR; PG8_SCHED;
            PG8_STAGE(PG8_SB(0, 1), b2 + hstep, voffB);
            PG8_WAIT_V(6); PG8_BAR; PG8_MMA(1, 1, At, B1); PG8_BAR;
            PG8_LDB(B0, 1, 0); PG8_SCHED; PG8_LDA(At, 1, 0); PG8_STAGE(PG8_SA(0, 1), a2 + hstep, voffA);
            PG8_WAIT_L(8); PG8_BAR; PG8_WAIT_L(0); PG8_MMA(0, 0, At, B0); PG8_BAR; PG8_SCHED;
            PG8_LDB(B1, 1, 1); PG8_STAGE(PG8_SB(1, 0), b3, voffB);
            PG8_BAR; PG8_WAIT_L(0); PG8_MMA(0, 1, At, B1); PG8_BAR;
            PG8_LDA(At, 1, 1); PG8_STAGE(PG8_SA(1, 0), a3, voffA);
            PG8_BAR; PG8_WAIT_L(0); PG8_MMA(1, 0, At, B0); PG8_BAR; PG8_SCHED;
            PG8_STAGE(PG8_SB(1, 1), b3 + hstep, voffB);
            PG8_WAIT_V(6); PG8_BAR; PG8_MMA(1, 1, At, B1); PG8_BAR;
            }
        }
        if constexpr (ALIGN_EPI) { if (wr == 0) PG8_BAR; }
        if constexpr (!Epi::AFTER_DRAIN) { E(acc, cur, wr, wc, fr, fq); S.done(cur); }
        if (!has_next) break;
#pragma unroll
        for (int a = 0; a < 2; ++a)
#pragma unroll
            for (int b = 0; b < 2; ++b)
#pragma unroll
                for (int m = 0; m < 4; ++m)
#pragma unroll
                    for (int n = 0; n < 2; ++n) acc[a][b][m][n] = (f32x4){0.f, 0.f, 0.f, 0.f};
        cur = nxt; cA = nA; cB = nB; ++ui;
        if constexpr (ALIGN_EPI) { if (wr == 1) PG8_BAR; }
    }
    PG8_WAIT_V(0);
    if constexpr (!ALIGN_EPI) { if (wr == 0) PG8_BAR; }
    PG8_BAR;
    if constexpr (Epi::AFTER_DRAIN) { E.fused(acc, cur, wr, wc, fr, fq, lds, wid, lane); S.done(cur); }
#undef PG8_SA
#undef PG8_SB
#undef PG8_STAGE
#undef PG8_LDA
#undef PG8_LDB
#undef PG8_MMA
#undef PG8_WAIT_V
#undef PG8_WAIT_L
#undef PG8_BAR
#undef PG8_SCHED
}
}

#define LAS __attribute__((address_space(3)))
typedef unsigned short bf16;
typedef unsigned v4u __attribute__((ext_vector_type(4)));
typedef unsigned v2u __attribute__((ext_vector_type(2)));
typedef float f32x4 __attribute__((ext_vector_type(4)));
constexpr int BATCH = 8, SEQ = 2048, T = BATCH * SEQ, D = 1024, DEPTH = 4;
constexpr int INW = 2694, NIN = 2816, FF = 2816, NGU = 5632;
constexpr int UQ = 0, UK = 384, UV = 768, UZ = 1152, UXS = 1536, UP = 2432;
constexpr int XBC = 896;
constexpr float EPS = 1e-6f;
constexpr size_t MiB = 1u << 20;
constexpr size_t WS_CTL = 0;
constexpr size_t WS_WIN = 1 * MiB, WS_WOUT = 23 * MiB, WS_WGU = 31 * MiB, WS_WD = 75 * MiB;
constexpr size_t WS_DTW = 97 * MiB, WS_PWT = WS_DTW + 128 * 1024, WS_KM = WS_DTW + 256 * 1024, WS_CD = WS_DTW + 512 * 1024;
constexpr size_t WS_DT = 98 * MiB, WS_H = 99 * MiB, WS_U = 131 * MiB, WS_ST = 219 * MiB, WS_END = 243 * MiB;
constexpr int LDS_BYTES = 147456;
constexpr int NPH = 9;
constexpr int N_PHASES = 2 + DEPTH * NPH;

__device__ __forceinline__ float bf2f(unsigned short u) { return __builtin_bit_cast(float, (unsigned)u << 16); }
__device__ __forceinline__ unsigned f2bf(float f) { unsigned u = __builtin_bit_cast(unsigned, f); return (u + 0x7fffu + ((u >> 16) & 1u)) >> 16; }
__device__ __forceinline__ unsigned pk2(float lo, float hi) { return f2bf(lo) | (f2bf(hi) << 16); }
#define SWZ_XOR(v, m) __builtin_bit_cast(float, __builtin_amdgcn_ds_swizzle(__builtin_bit_cast(int, (v)), ((m) << 10) | 0x1f))
__device__ __forceinline__ float half_sum(float v) { v += SWZ_XOR(v, 1); v += SWZ_XOR(v, 2); v += SWZ_XOR(v, 4); v += SWZ_XOR(v, 8); v += SWZ_XOR(v, 16); return v; }
__device__ __forceinline__ float wave_sum(float v) {
    v = half_sum(v);
    return __builtin_bit_cast(float, __builtin_amdgcn_readlane(__builtin_bit_cast(int, v), 0)) + __builtin_bit_cast(float, __builtin_amdgcn_readlane(__builtin_bit_cast(int, v), 32));
}
__device__ __forceinline__ float wave_max(float v) {
    v = fmaxf(v, SWZ_XOR(v, 1)); v = fmaxf(v, SWZ_XOR(v, 2)); v = fmaxf(v, SWZ_XOR(v, 4)); v = fmaxf(v, SWZ_XOR(v, 8)); v = fmaxf(v, SWZ_XOR(v, 16));
    return fmaxf(__builtin_bit_cast(float, __builtin_amdgcn_readlane(__builtin_bit_cast(int, v), 0)), __builtin_bit_cast(float, __builtin_amdgcn_readlane(__builtin_bit_cast(int, v), 32)));
}
__device__ __forceinline__ float silu(float g) { return g / (1.f + __expf(-g)); }

struct Params { const float* in[16]; float* out; unsigned char* ws; int ph_lo, ph_hi; };
enum { I_X = 0, I_NMIX, I_WIN, I_CONVW, I_CONVB, I_DTB, I_ALOG, I_DSKIP, I_SSDN, I_POOLW, I_POOLS, I_WOUT, I_NFFN, I_WGU, I_WD, I_NFIN };

__device__ __forceinline__ void transpose_item(const float* W, int srcN, int c0, int k0, bf16* WT, int dstK, int n0, LAS float* scr, int lane) {
    if (c0 >= 0) {
#pragma unroll 8
        for (int i = 0; i < 32; ++i) { const int kk = 2 * i + (lane >> 5); scr[kk * 33 + (lane & 31)] = W[(size_t)(k0 + kk) * srcN + c0 + (lane & 31)]; }
    }
    asm volatile("s_waitcnt lgkmcnt(0)" ::: "memory");
    const int c = lane & 7;
#pragma unroll
    for (int j = 0; j < 4; ++j) { const int n = (lane >> 3) + 8 * j; const LAS float* s = scr + (8 * c) * 33 + n;
        v4u o = {0u, 0u, 0u, 0u};
        if (c0 >= 0) { o.x = pk2(s[0 * 33], s[1 * 33]); o.y = pk2(s[2 * 33], s[3 * 33]); o.z = pk2(s[4 * 33], s[5 * 33]); o.w = pk2(s[6 * 33], s[7 * 33]); }
        *(v4u*)(WT + (size_t)(n0 + n) * dstK + k0 + 8 * c) = o; }
    asm volatile("s_waitcnt lgkmcnt(0)" ::: "memory");
}
__device__ __forceinline__ void phase_prologue(const Params& P, LAS unsigned char* lds, int bid, int G, int tid, int wid, int lane) {
    LAS float* scr = (LAS float*)lds + wid * (64 * 33);
    const int gw = bid * 8 + wid, nw = G * 8;
    for (int it = gw; it < DEPTH * 6144; it += nw) {
        const int l = it / 6144; int r = it % 6144;
        if (r < 1408) { const int nb = r >> 4, kb = r & 15, n0 = nb * 32; const int c0 = n0 < 2432 ? n0 : (n0 < 2688 ? n0 + 6 : -1);
            transpose_item(P.in[I_WIN] + (size_t)l * D * INW, INW, c0, kb * 64, (bf16*)(P.ws + WS_WIN) + (size_t)l * NIN * D, D, n0, scr, lane); }
        else if (r < 1920) { r -= 1408; const int nb = r >> 4, kb = r & 15;
            transpose_item(P.in[I_WOUT] + (size_t)l * D * D, D, nb * 32, kb * 64, (bf16*)(P.ws + WS_WOUT) + (size_t)l * D * D, D, nb * 32, scr, lane); }
        else if (r < 4736) { r -= 1920; const int nb = r >> 4, kb = r & 15, n0 = nb * 32, pn = n0 >> 8, rr = n0 & 255; const int c0 = rr < 128 ? 128 * pn + rr : FF + 128 * pn + (rr - 128);
            transpose_item(P.in[I_WGU] + (size_t)l * D * NGU, NGU, c0, kb * 64, (bf16*)(P.ws + WS_WGU) + (size_t)l * NGU * D, D, n0, scr, lane); }
        else { r -= 4736; const int nb = r / 44, kb = r % 44;
            transpose_item(P.in[I_WD] + (size_t)l * FF * D, D, nb * 32, kb * 64, (bf16*)(P.ws + WS_WD) + (size_t)l * D * FF, FF, nb * 32, scr, lane); }
    }
    const int gt = bid * 512 + tid, nt = G * 512;
    float* dtw = (float*)(P.ws + WS_DTW);
    for (int i = gt; i < DEPTH * 8 * D; i += nt) { const int l = i / (8 * D), j = (i / D) & 7, k = i % D; dtw[i] = j < 6 ? P.in[I_WIN][((size_t)l * D + k) * INW + 2432 + j] : 0.f; }
    bf16* pwt = (bf16*)(P.ws + WS_PWT);
    for (int i = gt; i < DEPTH * 4 * 64 * 64; i += nt) { const int lg = i >> 12, d = (i >> 6) & 63, c = i & 63; pwt[i] = (bf16)f2bf(P.in[I_POOLW][(lg * 64 + c) * 64 + d]); }
}

__device__ __forceinline__ void phase_norm(const Params& P, int l, int mode, int bid, int G, int wid, int lane) {
    const float* X = (mode == 0 && l == 0) ? P.in[I_X] : P.out;
    const float* g = mode == 0 ? P.in[I_NMIX] + l * D : (mode == 1 ? P.in[I_NFFN] + l * D : P.in[I_NFIN]);
    bf16* H = (bf16*)(P.ws + WS_H);
    const float* dtw = (const float*)(P.ws + WS_DTW) + (size_t)l * 8 * D;
    float* DT = (float*)(P.ws + WS_DT);
    f32x4 gv[4];
#pragma unroll
    for (int j = 0; j < 4; ++j) gv[j] = *(const f32x4*)(g + 4 * lane + 256 * j);
    for (int row = bid * 8 + wid; row < T; row += G * 8) {
        const float* xr = X + (size_t)row * D + 4 * lane;
        f32x4 v[4]; float s = 0.f;
#pragma unroll
        for (int j = 0; j < 4; ++j) { v[j] = *(const f32x4*)(xr + 256 * j); s += (v[j].x * v[j].x + v[j].y * v[j].y) + (v[j].z * v[j].z + v[j].w * v[j].w); }
        const float rstd = rsqrtf(wave_sum(s) * (1.f / D) + EPS);
#pragma unroll
        for (int j = 0; j < 4; ++j) v[j] = (v[j] * rstd) * gv[j];
        if (mode == 2) {
#pragma unroll
            for (int j = 0; j < 4; ++j) *(f32x4*)(P.out + (size_t)row * D + 4 * lane + 256 * j) = v[j];
        } else {
            v2u* o8 = (v2u*)(H + (size_t)row * D + 4 * lane);
#pragma unroll
            for (int j = 0; j < 4; ++j) { v2u o; o.x = pk2(v[j].x, v[j].y); o.y = pk2(v[j].z, v[j].w); o8[64 * j] = o; }
            if (mode == 0) {
                float mine = 0.f;
#pragma unroll
                for (int q = 0; q < 6; ++q) { float a = 0.f;
#pragma unroll
                    for (int j = 0; j < 4; ++j) { const f32x4 w = *(const f32x4*)(dtw + q * D + 4 * lane + 256 * j); a += (v[j].x * w.x + v[j].y * w.y) + (v[j].z * w.z + v[j].w * w.w); }
                    a = wave_sum(a); if (lane == q) mine = a; }
                if (lane < 6) { const float z = mine + P.in[I_DTB][l * 6 + lane]; DT[(size_t)row * 8 + lane] = fmaxf(z, 0.f) + log1pf(__expf(-fabsf(z))); }
            }
        }
    }
}
__device__ __forceinline__ void naive_kmean(const Params& P, int bid, int tid) {
    const bf16* U = (const bf16*)(P.ws + WS_U); float* KM = (float*)(P.ws + WS_KM);
    const int i = bid * 512 + tid;
    if (i < BATCH * 6 * 8 * 64) { const int d = i & 63, j = (i >> 6) & 7, bh = i >> 9, b = bh / 6, h = bh % 6;
        float s = 0.f; for (int r = 0; r < 256; ++r) s += bf2f(U[(size_t)(b * SEQ + j * 256 + r) * NIN + UK + h * 64 + d]);
        KM[i] = s * (1.f / 256.f); }
}
__device__ __forceinline__ void naive_attn_query(const Params& P, int qi, int lane) {
    const bf16* U = (const bf16*)(P.ws + WS_U); const float* KM = (const float*)(P.ws + WS_KM); bf16* MIX = (bf16*)(P.ws + WS_H);
    const int t = qi & 2047, bh = qi >> 11, b = bh / 6, h = bh % 6, blk = t >> 8;
    float q[64];
    { const v4u* qp = (const v4u*)(U + (size_t)(b * SEQ + t) * NIN + UQ + h * 64);
#pragma unroll
      for (int c = 0; c < 8; ++c) { const v4u w = qp[c]; q[8*c] = bf2f(w.x & 0xffff); q[8*c+1] = bf2f(w.x >> 16); q[8*c+2] = bf2f(w.y & 0xffff); q[8*c+3] = bf2f(w.y >> 16);
          q[8*c+4] = bf2f(w.z & 0xffff); q[8*c+5] = bf2f(w.z >> 16); q[8*c+6] = bf2f(w.w & 0xffff); q[8*c+7] = bf2f(w.w >> 16); } }
    unsigned sel = 0;
    if (blk <= 3) sel = (1u << blk) - 1u;
    else {
        float gate[8];
        const float qd = bf2f(U[(size_t)(b * SEQ + t) * NIN + UQ + h * 64 + lane]);
#pragma unroll
        for (int j = 0; j < 8; ++j) { const float g = wave_sum(qd * KM[((size_t)bh * 8 + j) * 64 + lane]); gate[j] = j < blk ? g : -3e38f; }
#pragma unroll
        for (int r = 0; r < 3; ++r) { int best = 0; float bv = -3.4e38f;
#pragma unroll
            for (int j = 0; j < 8; ++j) { const bool ok = !((sel >> j) & 1u) && gate[j] > bv; bv = ok ? gate[j] : bv; best = ok ? j : best; }
            sel |= 1u << best; }
    }
#pragma unroll 1
    for (int dh = 0; dh < 2; ++dh) {
        float m = -1e30f, lsum = 0.f, o[32];
#pragma unroll
        for (int d = 0; d < 32; ++d) o[d] = 0.f;
        for (int jb = 0; jb <= blk; ++jb) {
            const bool own = jb == blk;
            if (!own && !((sel >> jb) & 1u)) continue;
            const int kend = own ? (t & 255) + 1 : 256;
            for (int kk = lane; kk < kend; kk += 64) {
                const v4u* kp = (const v4u*)(U + (size_t)(b * SEQ + jb * 256 + kk) * NIN + UK + h * 64);
                float s = 0.f;
#pragma unroll
                for (int c = 0; c < 8; ++c) { const v4u w = kp[c];
                    s += q[8*c] * bf2f(w.x & 0xffff) + q[8*c+1] * bf2f(w.x >> 16) + q[8*c+2] * bf2f(w.y & 0xffff) + q[8*c+3] * bf2f(w.y >> 16)
                       + q[8*c+4] * bf2f(w.z & 0xffff) + q[8*c+5] * bf2f(w.z >> 16) + q[8*c+6] * bf2f(w.w & 0xffff) + q[8*c+7] * bf2f(w.w >> 16); }
                s *= 0.125f;
                const float mn = fmaxf(m, s), a = __expf(m - mn), p = __expf(s - mn);
                lsum = lsum * a + p; m = mn;
                const v4u* vp = (const v4u*)((const bf16*)kp + 384 + dh * 32);
#pragma unroll
                for (int c = 0; c < 4; ++c) { const v4u w = vp[c];
                    o[8*c] = o[8*c] * a + p * bf2f(w.x & 0xffff); o[8*c+1] = o[8*c+1] * a + p * bf2f(w.x >> 16); o[8*c+2] = o[8*c+2] * a + p * bf2f(w.y & 0xffff); o[8*c+3] = o[8*c+3] * a + p * bf2f(w.y >> 16);
                    o[8*c+4] = o[8*c+4] * a + p * bf2f(w.z & 0xffff); o[8*c+5] = o[8*c+5] * a + p * bf2f(w.z >> 16); o[8*c+6] = o[8*c+6] * a + p * bf2f(w.w & 0xffff); o[8*c+7] = o[8*c+7] * a + p * bf2f(w.w >> 16); }
            }
        }
        const float M = wave_max(m), sc = __expf(m - M);
        const float L = wave_sum(lsum * sc);
        float outv = 0.f;
#pragma unroll
        for (int d = 0; d < 32; ++d) { const float s = wave_sum(o[d] * sc); outv = lane == d ? s : outv; }
        if (lane < 32) MIX[(size_t)(b * SEQ + t) * D + h * 64 + dh * 32 + lane] = (bf16)f2bf(outv / L);
    }
}
__device__ __forceinline__ void naive_ssd(const Params& P, int l, int bh, LAS unsigned char* lds, int tid) {
    const bf16* U = (const bf16*)(P.ws + WS_U); const float* DT = (const float*)(P.ws + WS_DT); float* YT = (float*)(P.ws + WS_ST);
    const int b = bh / 6, h = bh % 6, g = h / 3;
    LAS float* xs = (LAS float*)lds; LAS float* Bs = xs + 32 * 64; LAS float* Cs = Bs + 32 * 128; LAS float* dts = Cs + 32 * 128; LAS float* dAs = dts + 32;
    const float a = -__expf(P.in[I_ALOG][l * 6 + h]), Dk = P.in[I_DSKIP][l * 6 + h];
    const float* cw = P.in[I_CONVW] + (size_t)l * 4 * XBC; const float* cb = P.in[I_CONVB] + (size_t)l * XBC;
    const int p = tid >> 3, ns = (tid & 7) * 16;
    float hst[16];
#pragma unroll
    for (int i = 0; i < 16; ++i) hst[i] = 0.f;
    for (int t0 = 0; t0 < SEQ; t0 += 32) {
        __syncthreads();
        for (int idx = tid; idx < 32 * 320; idx += 512) {
            const int tt = idx / 320, c = idx % 320;
            const int ch = c < 64 ? h * 64 + c : (c < 192 ? 384 + g * 128 + (c - 64) : 640 + g * 128 + (c - 192));
            float acc = cb[ch];
#pragma unroll
            for (int k = 0; k < 4; ++k) { const int ts = t0 + tt - 3 + k; if (ts >= 0) acc += cw[k * XBC + ch] * bf2f(U[(size_t)(b * SEQ + ts) * NIN + UXS + ch]); }
            const float v = silu(acc);
            if (c < 64) xs[tt * 64 + c] = v; else if (c < 192) Bs[tt * 128 + c - 64] = v; else Cs[tt * 128 + c - 192] = v;
        }
        if (tid < 32) { const float dt = DT[(size_t)(b * SEQ + t0 + tid) * 8 + h]; dts[tid] = dt; dAs[tid] = __expf(dt * a); }
        __syncthreads();
        for (int tt = 0; tt < 32; ++tt) {
            const float xv = xs[tt * 64 + p], dA = dAs[tt], coef = dts[tt] * xv;
            float y = 0.f;
#pragma unroll
            for (int i = 0; i < 16; ++i) { hst[i] = hst[i] * dA + coef * Bs[tt * 128 + ns + i]; y += hst[i] * Cs[tt * 128 + ns + i]; }
            y += SWZ_XOR(y, 1); y += SWZ_XOR(y, 2); y += SWZ_XOR(y, 4);
            if ((tid & 7) == 0) { const size_t row = (size_t)(b * SEQ + t0 + tt);
                const float z = bf2f(U[row * NIN + UZ + h * 64 + p]);
                YT[row * 384 + h * 64 + p] = (y + Dk * xv) * silu(z); }
        }
    }
}
__device__ __forceinline__ void naive_ssd_norm(const Params& P, int l, int bid, int G, int wid, int lane) {
    const float* YT = (const float*)(P.ws + WS_ST); bf16* MIX = (bf16*)(P.ws + WS_H);
    for (int it = bid * 8 + wid; it < T * 2; it += G * 8) {
        const int row = it >> 1, g = it & 1;
        const float* y = YT + (size_t)row * 384 + g * 192;
        const float v0 = y[lane], v1 = y[lane + 64], v2 = y[lane + 128];
        const float r = rsqrtf(wave_sum(v0 * v0 + v1 * v1 + v2 * v2) * (1.f / 192.f) + EPS);
        const float* nw = P.in[I_SSDN] + l * 384 + g * 192;
        bf16* o = MIX + (size_t)row * D + 384 + g * 192;
        o[lane] = (bf16)f2bf(v0 * r * nw[lane]); o[lane + 64] = (bf16)f2bf(v1 * r * nw[lane + 64]); o[lane + 128] = (bf16)f2bf(v2 * r * nw[lane + 128]);
    }
}
__device__ __forceinline__ void naive_pool(const Params& P, int l, int item, LAS unsigned char* lds, int tid) {
    const bf16* U = (const bf16*)(P.ws + WS_U); bf16* MIX = (bf16*)(P.ws + WS_H);
    LAS float* diff = (LAS float*)lds;
    const int tok0 = item * 8;
    __syncthreads();
    for (int idx = tid; idx < 8 * 256; idx += 512) { const int tt = idx >> 8, c = idx & 255, g = c >> 6, W = 2 << g; const int row = tok0 + tt, pos = row & (SEQ - 1);
        const int cnt = pos + 1 < W ? pos + 1 : W; float s = 0.f;
        for (int i = 0; i < cnt; ++i) s += bf2f(U[(size_t)(row - i) * NIN + UP + c]);
        diff[idx] = s / (float)cnt - bf2f(U[(size_t)row * NIN + UP + c]); }
    __syncthreads();
    for (int idx = tid; idx < 8 * 256; idx += 512) { const int tt = idx >> 8, dc = idx & 255, g = dc >> 6, dd = dc & 63;
        const float* w = P.in[I_POOLW] + ((size_t)(l * 4 + g) * 64) * 64 + dd; float acc = 0.f;
        for (int c = 0; c < 64; ++c) acc += diff[tt * 256 + g * 64 + c] * w[c * 64];
        MIX[(size_t)(tok0 + tt) * D + 768 + dc] = (bf16)f2bf(acc * P.in[I_POOLS][l * 256 + dc]); }
}
__device__ __forceinline__ void grid_sync(unsigned* ctr, unsigned target, int wid0) {
    __builtin_amdgcn_fence(__ATOMIC_RELEASE, "agent");
    __syncthreads();
    if (wid0 == 0) {
        int lane; asm volatile("v_mbcnt_lo_u32_b32 %0, -1, 0\n\tv_mbcnt_hi_u32_b32 %0, -1, %0" : "=v"(lane));
        if (lane == 0) {
            __hip_atomic_fetch_add(ctr, 1u, __ATOMIC_RELEASE, __HIP_MEMORY_SCOPE_AGENT);
            while (__hip_atomic_load(ctr, __ATOMIC_RELAXED, __HIP_MEMORY_SCOPE_AGENT) < target) __builtin_amdgcn_s_sleep(2);
        }
    }
    __syncthreads();
    __builtin_amdgcn_fence(__ATOMIC_ACQUIRE, "agent");
}
template <int PH> __device__ __forceinline__ void run_phase(const Params& P0, LAS unsigned char* lds, const int wid0) {
    Params P = P0; asm volatile("" : "+s"(P.ws), "+s"(P.out));
    int lane_; asm volatile("v_mbcnt_lo_u32_b32 %0, -1, 0\n\tv_mbcnt_hi_u32_b32 %0, -1, %0" : "=v"(lane_));
    int wid_ = wid0; asm volatile("" : "+s"(wid_));
    const int tid = wid_ * 64 + lane_;
    int bid = blockIdx.x, G = gridDim.x; asm volatile("" : "+s"(bid), "+s"(G));
    const int lane = lane_, wid = wid_;
    if constexpr (PH == 0) phase_prologue(P, lds, bid, G, tid, wid, lane);
    else if constexpr (PH == N_PHASES - 1) phase_norm(P, 0, 2, bid, G, wid, lane);
    else {
        constexpr int l = (PH - 1) / NPH, s = (PH - 1) % NPH;
        if constexpr (s == 0) phase_norm(P, l, 0, bid, G, wid, lane);
        else if constexpr (s == 1) { pg8::Gemm g{(const pg8::bf16_t*)(P.ws + WS_H), (const pg8::bf16_t*)(P.ws + WS_WIN) + (size_t)l * NIN * D, T, NIN, D};
            pg8::StaticOrder S; S.init(T, NIN, G, bid); pg8::EpiStoreBf16 E{(pg8::bf16_t*)(P.ws + WS_U), NIN};
            pg8::gemm_phase<pg8::EpiStoreBf16, pg8::StaticOrder, true, true>(lds, g, S, E, tid); }
        else if constexpr (s == 2) naive_kmean(P, bid, tid);
        else if constexpr (s == 3) {
            for (int qi = bid * 8 + wid; qi < BATCH * 6 * SEQ; qi += G * 8) naive_attn_query(P, qi, lane);
            for (int it = bid; it < T / 8; it += G) naive_pool(P, l, it, lds, tid);
            for (int bh = bid; bh < BATCH * 6; bh += G) naive_ssd(P, l, bh, lds, tid);
        }
        else if constexpr (s == 4) naive_ssd_norm(P, l, bid, G, wid, lane);
        else if constexpr (s == 5) { pg8::Gemm g{(const pg8::bf16_t*)(P.ws + WS_H), (const pg8::bf16_t*)(P.ws + WS_WOUT) + (size_t)l * D * D, T, D, D};
            pg8::StaticOrder S; S.init(T, D, G, bid); pg8::EpiResidual E{l == 0 ? P.in[I_X] : P.out, P.out, D};
            pg8::gemm_phase<pg8::EpiResidual, pg8::StaticOrder, true, true>(lds, g, S, E, tid); }
        else if constexpr (s == 6) phase_norm(P, l, 1, bid, G, wid, lane);
        else if constexpr (s == 7) { pg8::Gemm g{(const pg8::bf16_t*)(P.ws + WS_H), (const pg8::bf16_t*)(P.ws + WS_WGU) + (size_t)l * NGU * D, T, NGU, D};
            pg8::StaticOrder S; S.init(T, NGU, G, bid); pg8::EpiSwiGLU E{(pg8::bf16_t*)(P.ws + WS_U), FF};
            pg8::gemm_phase<pg8::EpiSwiGLU, pg8::StaticOrder, true, true>(lds, g, S, E, tid); }
        else { pg8::Gemm g{(const pg8::bf16_t*)(P.ws + WS_U), (const pg8::bf16_t*)(P.ws + WS_WD) + (size_t)l * D * FF, T, D, FF};
            pg8::StaticOrder S; S.init(T, D, G, bid); pg8::EpiResidual E{P.out, P.out, D};
            pg8::gemm_phase<pg8::EpiResidual, pg8::StaticOrder, true, true>(lds, g, S, E, tid); }
    }
}
template <int PH> __device__ __forceinline__ void run_all(const Params& P0, LAS unsigned char* lds, const int wid0, const int lo, const int hi) {
    if constexpr (PH < N_PHASES) {
        if (PH >= lo && PH < hi) { run_phase<PH>(P0, lds, wid0); if (PH + 1 < hi) grid_sync((unsigned*)(P0.ws + WS_CTL), (unsigned)(PH + 1 - lo) * gridDim.x, wid0); }
        run_all<PH + 1>(P0, lds, wid0, lo, hi);
    }
}
__global__ void __launch_bounds__(512, 2) mega(Params P0) {
    extern __shared__ __attribute__((aligned(16))) unsigned char lds_raw[];
    LAS unsigned char* lds = (LAS unsigned char*)lds_raw;
    const int wid0 = __builtin_amdgcn_readfirstlane(threadIdx.x >> 6);
    run_all<0>(P0, lds, wid0, P0.ph_lo, P0.ph_hi);
}

#ifndef ONE_LAUNCH
#define ONE_LAUNCH 1
#endif
extern "C" void kernel_launch(void* const* d_in, const int* in_sizes, int n_in, void* d_out, int out_size, void* d_ws, size_t ws_size, hipStream_t stream) {
    static int grid = 0;
    if (grid == 0) {
        if (n_in != 16 || out_size != T * D || ws_size < WS_END) { fprintf(stderr, "kernel_launch: unexpected shapes n_in %d out %d ws %zu\n", n_in, out_size, ws_size); grid = -1; return; }
        int dev = 0, cus = 0, per_cu = 0;
        hipGetDevice(&dev); hipDeviceGetAttribute(&cus, hipDeviceAttributeMultiprocessorCount, dev);
        if (hipFuncSetAttribute((const void*)mega, hipFuncAttributeMaxDynamicSharedMemorySize, LDS_BYTES) != hipSuccess) { fprintf(stderr, "kernel_launch: hipFuncSetAttribute failed\n"); grid = -1; return; }
        hipOccupancyMaxActiveBlocksPerMultiprocessor(&per_cu, (const void*)mega, 512, LDS_BYTES);
        if (per_cu < 1) { fprintf(stderr, "kernel_launch: occupancy query says %d\n", per_cu); per_cu = 1; }
        (void)hipGetLastError();
        grid = cus * per_cu;
    }
    if (grid < 0) return;
    if (hipMemsetAsync((char*)d_ws + WS_CTL, 0, 256, stream) != hipSuccess) { fprintf(stderr, "kernel_launch: memset failed\n"); return; }
    Params p{};
    for (int i = 0; i < 16; ++i) p.in[i] = (const float*)d_in[i];
    p.out = (float*)d_out; p.ws = (unsigned char*)d_ws;
#if ONE_LAUNCH
    p.ph_lo = 0; p.ph_hi = N_PHASES;
    void* args[] = {&p};
    hipError_t e = hipLaunchCooperativeKernel((const void*)mega, dim3(grid), dim3(512), args, LDS_BYTES, stream);
    if (e != hipSuccess) fprintf(stderr, "cooperative launch failed: %s (grid %d)\n", hipGetErrorString(e), grid);
#else
    for (int ph = 0; ph < N_PHASES; ++ph) { p.ph_lo = ph; p.ph_hi = ph + 1; hipLaunchKernelGGL(mega, dim3(grid), dim3(512), LDS_BYTES, stream, p); }
#endif
}
```

```cpp
#include <hip/hip_runtime.h>
#include <hip/hip_cooperative_groups.h>
#include <cstdio>
#include <cstdint>
namespace cg = cooperative_groups;
namespace pg8 {
#define PG8_LAS __attribute__((address_space(3)))
typedef unsigned short bf16_t;
typedef short bf16x8 __attribute__((ext_vector_type(8)));
typedef float f32x4 __attribute__((ext_vector_type(4)));
typedef unsigned u32x4 __attribute__((ext_vector_type(4)));
constexpr int BM = 256, BK = 64, HALF = 128, HTB = HALF * BK * 2  , STAGE_BYTES = 8 * HTB, NXCD = 8, WGM = 8;

__host__ __device__ __forceinline__ int lds_byte(int r, int c) { const int st = (r >> 4) * 2 + (c >> 5), rr = r & 15, cc = c & 31, ob = rr * 64 + cc * 2; return st * 1024 + (ob ^ (((ob >> 9) & 1) << 5)); }
__host__ __device__ __forceinline__ void stage_rc(int b, int& R, int& C) { const int st = b / 1024, sb = b % 1024, swz = sb ^ (((sb >> 9) & 1) << 5); R = (st >> 1) * 16 + swz / 64; C = (st & 1) * 32 + (swz % 64) / 2; }
__host__ __device__ __forceinline__ int perm32(int rho) { const int n = rho >> 4, i = rho & 15; return 8 * (i >> 2) + 4 * n + (i & 3); }

struct Unit { int pm, pn; };
struct Gemm { const bf16_t* A; const bf16_t* Bt; int M, N, K; };

struct StaticOrder {
    int nM, nN, nwg, G, c;
    __host__ __device__ void init(int M, int N, int G_, int c_) { nM = M / BM; nN = N / BM; nwg = nM * nN; G = G_; c = c_; }
    __host__ __device__ bool next(int i, Unit& u) const {
        const long L = (long)i * G + c; if (L >= nwg) return false;
        int wgid = (int)L; { const int q = nwg / NXCD, r = nwg % NXCD, xcd = wgid % NXCD, off = wgid / NXCD; wgid = (xcd < r ? xcd * (q + 1) : r * (q + 1) + (xcd - r) * q) + off; }
        const int nig = WGM * nN, gid = wgid / nig, fm = gid * WGM, gsz = (nM - fm) < WGM ? (nM - fm) : WGM;
        u.pm = fm + ((wgid % nig) % gsz); u.pn = (wgid % nig) / gsz; return true;
    }
    __device__ __forceinline__ void a_ready(const Unit&) const {}
    __device__ __forceinline__ void done(const Unit&) const {}
};

__device__ __forceinline__ unsigned cvt_pk_bf16(float lo, float hi) { unsigned r; asm volatile("v_cvt_pk_bf16_f32 %0, %1, %2" : "=v"(r) : "v"(lo), "v"(hi)); return r; }
struct EpiStoreBf16 {
    static constexpr bool PERM = true, AFTER_DRAIN = false;
    bf16_t* O; int ldc;
    __device__ __forceinline__ void operator()(const f32x4 (&acc)[2][2][4][2], const Unit& u, int wr, int wc, int fr, int fq) const {
        const int row0 = u.pm * BM + wr * 64 + fr; const int col0 = u.pn * BM + wc * 32 + 8 * fq;
#pragma unroll
        for (int ai = 0; ai < 2; ++ai)
#pragma unroll
            for (int m = 0; m < 4; ++m) { bf16_t* rowp = O + (size_t)(row0 + ai * HALF + m * 16) * ldc + col0;
#pragma unroll
                for (int bj = 0; bj < 2; ++bj) { const f32x4 v0 = acc[ai][bj][m][0], v1 = acc[ai][bj][m][1];
                    u32x4 w; w.x = cvt_pk_bf16(v0[0], v0[1]); w.y = cvt_pk_bf16(v0[2], v0[3]); w.z = cvt_pk_bf16(v1[0], v1[1]); w.w = cvt_pk_bf16(v1[2], v1[3]);
                    *(u32x4*)(rowp + bj * HALF) = w; } }
    }
};
struct EpiResidual {
    static constexpr bool PERM = true, AFTER_DRAIN = false;
    const float* R; float* X; int ld;
    __device__ __forceinline__ void operator()(const f32x4 (&acc)[2][2][4][2], const Unit& u, int wr, int wc, int fr, int fq) const {
        const int row0 = u.pm * BM + wr * 64 + fr; const int col0 = u.pn * BM + wc * 32 + 8 * fq;
#pragma unroll
        for (int ai = 0; ai < 2; ++ai)
#pragma unroll
            for (int m = 0; m < 4; ++m) { const size_t off = (size_t)(row0 + ai * HALF + m * 16) * ld + col0;
#pragma unroll
                for (int bj = 0; bj < 2; ++bj) {
                    const f32x4 r0 = *(const f32x4*)(R + off + bj * HALF), r1 = *(const f32x4*)(R + off + bj * HALF + 4);
                    *(f32x4*)(X + off + bj * HALF) = r0 + acc[ai][bj][m][0]; *(f32x4*)(X + off + bj * HALF + 4) = r1 + acc[ai][bj][m][1]; } __builtin_amdgcn_sched_barrier(0); }
    }
};
__device__ __forceinline__ float silu_f(float g) { return g * __builtin_amdgcn_rcpf(1.f + __expf(-g)); }
struct EpiSwiGLU {
    static constexpr bool PERM = true, AFTER_DRAIN = false;
    bf16_t* O; int ldc;
    __device__ __forceinline__ void operator()(const f32x4 (&acc)[2][2][4][2], const Unit& u, int wr, int wc, int fr, int fq) const {
        const int row0 = u.pm * BM + wr * 64 + fr; const int col0 = u.pn * HALF + wc * 32 + 8 * fq;
#pragma unroll
        for (int ai = 0; ai < 2; ++ai)
#pragma unroll
            for (int m = 0; m < 4; ++m) { bf16_t* rowp = O + (size_t)(row0 + ai * HALF + m * 16) * ldc + col0;
                const f32x4 g0 = acc[ai][0][m][0], g1 = acc[ai][0][m][1], u0 = acc[ai][1][m][0], u1 = acc[ai][1][m][1];
                u32x4 w; w.x = cvt_pk_bf16(silu_f(g0[0]) * u0[0], silu_f(g0[1]) * u0[1]); w.y = cvt_pk_bf16(silu_f(g0[2]) * u0[2], silu_f(g0[3]) * u0[3]);
                w.z = cvt_pk_bf16(silu_f(g1[0]) * u1[0], silu_f(g1[1]) * u1[1]); w.w = cvt_pk_bf16(silu_f(g1[2]) * u1[2], silu_f(g1[3]) * u1[3]);
                *(u32x4*)rowp = w; __builtin_amdgcn_sched_barrier(0); }
    }
};
template <class Epi, class Sched, bool ALIGN_EPI = false, bool SP2 = false>
__device__ __forceinline__ void gemm_phase(PG8_LAS unsigned char* lds, const Gemm g, const Sched& S, const Epi& E, const int tid) {
    const int wid = __builtin_amdgcn_readfirstlane(tid >> 6), lane = tid & 63, wr = wid >> 2, wc = wid & 3, fr = lane & 15, fq = lane >> 4;
    const int K = g.K, nt = K / BK;
    unsigned voffA[2], voffB[2];
#pragma unroll
    for (int i = 0; i < 2; ++i) { int R, C; stage_rc(tid * 16 + i * 8192, R, C); const int Rb = Epi::PERM ? ((R & ~31) + perm32(R & 31)) : R;
        voffA[i] = (unsigned)(R * K + C) * 2u; voffB[i] = (unsigned)(Rb * K + C) * 2u; }
    const size_t kstep = (size_t)(BK * 2);
    const size_t hstep = (size_t)HALF * K * 2;
    const size_t tstep = 2 * hstep;
    const unsigned ldsw = (unsigned)wid * 1024u;
    const int aoff = lds_byte(wr * 64 + fr, fq * 8), boff = lds_byte(wc * 32 + fr, fq * 8);
#define PG8_SA(b, h) (((b) * 2 + (h)) * HTB)
#define PG8_SB(b, h) ((4 + (b) * 2 + (h)) * HTB)
#define PG8_STAGE(bufoff, gbase, voff) do { _Pragma("unroll") for (int _i = 0; _i < 2; ++_i) \
        __builtin_amdgcn_global_load_lds((const unsigned*)((const char*)(gbase) + (voff)[_i]), (PG8_LAS unsigned*)(lds + (bufoff) + ldsw + _i * 8192), 16, 0, 0); } while (0)
#define PG8_LDA(dst, b, h) do { _Pragma("unroll") for (int m = 0; m < 4; ++m) _Pragma("unroll") for (int k = 0; k < 2; ++k) dst[m][k] = *(const PG8_LAS bf16x8*)(lds + PG8_SA(b, h) + aoff + m * 2048 + k * 1024); } while (0)
#define PG8_LDB(dst, b, h) do { _Pragma("unroll") for (int n = 0; n < 2; ++n) _Pragma("unroll") for (int k = 0; k < 2; ++k) dst[n][k] = *(const PG8_LAS bf16x8*)(lds + PG8_SB(b, h) + boff + n * 2048 + k * 1024); } while (0)
#define PG8_MMA(ai, bj, At, Bt) do { __builtin_amdgcn_s_setprio(1); _Pragma("unroll") for (int m = 0; m < 4; ++m) _Pragma("unroll") for (int n = 0; n < 2; ++n) _Pragma("unroll") for (int k = 0; k < 2; ++k) \
        acc[ai][bj][m][n] = __builtin_amdgcn_mfma_f32_16x16x32_bf16(Bt[n][k], At[m][k], acc[ai][bj][m][n], 0, 0, 0); __builtin_amdgcn_s_setprio(0); } while (0)
#define PG8_WAIT_V(n) asm volatile("s_waitcnt vmcnt(" #n ")" ::: "memory")
#define PG8_WAIT_L(n) asm volatile("s_waitcnt lgkmcnt(" #n ")" ::: "memory")
#define PG8_BAR __builtin_amdgcn_s_barrier()
#define PG8_SCHED __builtin_amdgcn_sched_barrier(0)
    Unit cur, nxt; int ui = 0;
    if (!S.next(0, cur)) return;
    f32x4 acc[2][2][4][2];
#pragma unroll
    for (int a = 0; a < 2; ++a)
#pragma unroll
        for (int b = 0; b < 2; ++b)
#pragma unroll
            for (int m = 0; m < 4; ++m)
#pragma unroll
                for (int n = 0; n < 2; ++n) acc[a][b][m][n] = (f32x4){0.f, 0.f, 0.f, 0.f};
    bf16x8 At[4][2], B0[2][2], B1[2][2];
    const char* cA = (const char*)g.A + (size_t)cur.pm * tstep; const char* cB = (const char*)g.Bt + (size_t)cur.pn * tstep;
    S.a_ready(cur);
    if constexpr (SP2) {
        PG8_STAGE(PG8_SB(0, 0), cB, voffB); PG8_STAGE(PG8_SB(0, 1), cB + hstep, voffB); PG8_STAGE(PG8_SA(0, 0), cA, voffA); PG8_STAGE(PG8_SA(0, 1), cA + hstep, voffA);
        if (wr == 1) PG8_BAR;
        PG8_WAIT_V(2); PG8_BAR;
        PG8_STAGE(PG8_SB(1, 0), cB + kstep, voffB); PG8_STAGE(PG8_SA(1, 0), cA + kstep, voffA); PG8_STAGE(PG8_SB(1, 1), cB + hstep + kstep, voffB);
        PG8_WAIT_V(6); PG8_BAR;
    } else {
        PG8_STAGE(PG8_SB(0, 0), cB, voffB); PG8_STAGE(PG8_SA(0, 0), cA, voffA); PG8_STAGE(PG8_SB(0, 1), cB + hstep, voffB); PG8_STAGE(PG8_SA(0, 1), cA + hstep, voffA);
        if (wr == 1) PG8_BAR;
        PG8_WAIT_V(4); PG8_BAR;
        PG8_STAGE(PG8_SB(1, 0), cB + kstep, voffB); PG8_STAGE(PG8_SA(1, 0), cA + kstep, voffA); PG8_STAGE(PG8_SB(1, 1), cB + hstep + kstep, voffB);
        PG8_WAIT_V(6); PG8_BAR;
    }
    for (;;) {
        const bool has_next = S.next(ui + 1, nxt);
        const char* nA = has_next ? (const char*)g.A + (size_t)nxt.pm * tstep : cA; const char* nB = has_next ? (const char*)g.Bt + (size_t)nxt.pn * tstep : cB;
        for (int t = 0; t < nt; t += 2) {
            const bool last = (t == nt - 2);
            const char* a1 = cA + (size_t)(t + 1) * kstep;
            const char* a2 = last ? nA : cA + (size_t)(t + 2) * kstep; const char* b2 = last ? nB : cB + (size_t)(t + 2) * kstep;
            const char* a3 = a2 + kstep; const char* b3 = b2 + kstep;
            if (last && has_next) S.a_ready(nxt);
            if constexpr (SP2) {
            PG8_LDB(B0, 0, 0); PG8_LDB(B1, 0, 1); PG8_SCHED; PG8_LDA(At, 0, 0); PG8_STAGE(PG8_SA(1, 1), a1 + hstep, voffA);
            PG8_WAIT_V(8); PG8_WAIT_L(0); PG8_BAR; PG8_MMA(0, 0, At, B0); PG8_MMA(0, 1, At, B1); PG8_BAR; PG8_SCHED;
            PG8_LDA(At, 0, 1); PG8_STAGE(PG8_SB(0, 0), b2, voffB); PG8_STAGE(PG8_SB(0, 1), b2 + hstep, voffB); PG8_STAGE(PG8_SA(0, 0), a2, voffA);
            PG8_WAIT_V(8); PG8_WAIT_L(0); PG8_BAR; PG8_MMA(1, 0, At, B0); PG8_MMA(1, 1, At, B1); PG8_BAR; PG8_SCHED;
            PG8_LDB(B0, 1, 0); PG8_LDB(B1, 1, 1); PG8_SCHED; PG8_LDA(At, 1, 0); PG8_STAGE(PG8_SA(0, 1), a2 + hstep, voffA);
            PG8_WAIT_V(8); PG8_WAIT_L(0); PG8_BAR; PG8_MMA(0, 0, At, B0); PG8_MMA(0, 1, At, B1); PG8_BAR; PG8_SCHED;
            PG8_LDA(At, 1, 1); PG8_STAGE(PG8_SB(1, 0), b3, voffB); PG8_STAGE(PG8_SB(1, 1), b3 + hstep, voffB); PG8_STAGE(PG8_SA(1, 0), a3, voffA);
            PG8_WAIT_V(8); PG8_WAIT_L(0); PG8_BAR; PG8_MMA(1, 0, At, B0); PG8_MMA(1, 1, At, B1); PG8_BAR; PG8_SCHED;
            } else {
            PG8_LDB(B0, 0, 0); PG8_SCHED; PG8_LDA(At, 0, 0); PG8_STAGE(PG8_SA(1, 1), a1 + hstep, voffA);
            PG8_WAIT_L(8); PG8_BAR; PG8_WAIT_L(0); PG8_MMA(0, 0, At, B0); PG8_BAR; PG8_SCHED;
            PG8_LDB(B1, 0, 1); PG8_STAGE(PG8_SB(0, 0), b2, voffB);
            PG8_BAR; PG8_WAIT_L(0); PG8_MMA(0, 1, At, B1); PG8_BAR;
            PG8_LDA(At, 0, 1); PG8_STAGE(PG8_SA(0, 0), a2, voffA);
            PG8_BAR; PG8_WAIT_L(0); PG8_MMA(1, 0, At, B0); PG8_BAR; PG8_SCHED;
            PG8_STAGE(PG8_SB(0, 1), b2 + hstep, voffB);
            PG8_WAIT_V(6); PG8_BAR; PG8_MMA(1, 1, At, B1); PG8_BAR;
            PG8_LDB(B0, 1, 0); PG8_SCHED; PG8_LDA(At, 1, 0); PG8_STAGE(PG8_SA(0, 1), a2 + hstep, voffA);
            PG8_WAIT_L(8); PG8_BAR; PG8_WAIT_L(0); PG8_MMA(0, 0, At, B0); PG8_BAR; PG8_SCHED;
            PG8_LDB(B1, 1, 1); PG8_STAGE(PG8_SB(1, 0), b3, voffB);
            PG8_BAR; PG8_WAIT_L(0); PG8_MMA(0, 1, At, B1); PG8_BAR;
            PG8_LDA(At, 1, 1); PG8_STAGE(PG8_SA(1, 0), a3, voffA);
            PG8_BAR; PG8_WAIT_L(0); PG8_MMA(1, 0, At, B0); PG8_BAR; PG8_SCHED;
            PG8_STAGE(PG8_SB(1, 1), b3 + hstep, voffB);
            PG8_WAIT_V(6); PG8_BAR; PG8_MMA(1, 1, At, B1); PG8_BAR;
            }
        }
        if constexpr (ALIGN_EPI) { if (wr == 0) PG8_BAR; }
        if constexpr (!Epi::AFTER_DRAIN) { E(acc, cur, wr, wc, fr, fq); S.done(cur); }
        if (!has_next) break;
#pragma unroll
        for (int a = 0; a < 2; ++a)
#pragma unroll
            for (int b = 0; b < 2; ++b)
#pragma unroll
                for (int m = 0; m < 4; ++m)
#pragma unroll
                    for (int n = 0; n < 2; ++n) acc[a][b][m][n] = (f32x4){0.f, 0.f, 0.f, 0.f};
        cur = nxt; cA = nA; cB = nB; ++ui;
        if constexpr (ALIGN_EPI) { if (wr == 1) PG8_BAR; }
    }
    PG8_WAIT_V(0);
    if constexpr (!ALIGN_EPI) { if (wr == 0) PG8_BAR; }
    PG8_BAR;
    if constexpr (Epi::AFTER_DRAIN) { E.fused(acc, cur, wr, wc, fr, fq, lds, wid, lane); S.done(cur); }
#undef PG8_SA
#undef PG8_SB
#undef PG8_STAGE
#undef PG8_LDA
#undef PG8_LDB
#undef PG8_MMA
#undef PG8_WAIT_V
#undef PG8_WAIT_L
#undef PG8_BAR
#undef PG8_SCHED
}
}

#define LAS __attribute__((address_space(3)))
typedef unsigned short bf16;
typedef unsigned v4u __attribute__((ext_vector_type(4)));
typedef unsigned v2u __attribute__((ext_vector_type(2)));
typedef float f32x4 __attribute__((ext_vector_type(4)));
constexpr int BATCH = 8, SEQ = 2048, T = BATCH * SEQ, D = 1024, DEPTH = 4;
constexpr int INW = 2694, NIN = 2816, FF = 2816, NGU = 5632;
constexpr int UQ = 0, UK = 384, UV = 768, UZ = 1152, UXS = 1536, UP = 2432;
constexpr int XBC = 896;
constexpr float EPS = 1e-6f;
constexpr size_t MiB = 1u << 20;
constexpr size_t WS_CTL = 0;
constexpr size_t WS_WIN = 1 * MiB, WS_WOUT = 23 * MiB, WS_WGU = 31 * MiB, WS_WD = 75 * MiB;
constexpr size_t WS_DTW = 97 * MiB, WS_PWT = WS_DTW + 128 * 1024, WS_KM = WS_DTW + 256 * 1024, WS_CD = WS_DTW + 512 * 1024;
constexpr size_t WS_DT = 98 * MiB, WS_H = 99 * MiB, WS_U = 131 * MiB, WS_ST = 219 * MiB, WS_END = 243 * MiB;
constexpr int LDS_BYTES = 147456;
#ifndef NAIVE_ATTN
#define NAIVE_ATTN 0
#endif
#ifndef NAIVE_SSD
#define NAIVE_SSD 0
#endif
#ifndef NAIVE_POOL
#define NAIVE_POOL 0
#endif
constexpr int NPH = 9;
constexpr int N_PHASES = 2 + DEPTH * NPH;

__device__ __forceinline__ float bf2f(unsigned short u) { return __builtin_bit_cast(float, (unsigned)u << 16); }
__device__ __forceinline__ unsigned f2bf(float f) { unsigned u = __builtin_bit_cast(unsigned, f); return (u + 0x7fffu + ((u >> 16) & 1u)) >> 16; }
__device__ __forceinline__ unsigned pk2(float lo, float hi) { return f2bf(lo) | (f2bf(hi) << 16); }
#define SWZ_XOR(v, m) __builtin_bit_cast(float, __builtin_amdgcn_ds_swizzle(__builtin_bit_cast(int, (v)), ((m) << 10) | 0x1f))
__device__ __forceinline__ float half_sum(float v) { v += SWZ_XOR(v, 1); v += SWZ_XOR(v, 2); v += SWZ_XOR(v, 4); v += SWZ_XOR(v, 8); v += SWZ_XOR(v, 16); return v; }
__device__ __forceinline__ float wave_sum(float v) {
    v = half_sum(v);
    return __builtin_bit_cast(float, __builtin_amdgcn_readlane(__builtin_bit_cast(int, v), 0)) + __builtin_bit_cast(float, __builtin_amdgcn_readlane(__builtin_bit_cast(int, v), 32));
}
__device__ __forceinline__ float wave_max(float v) {
    v = fmaxf(v, SWZ_XOR(v, 1)); v = fmaxf(v, SWZ_XOR(v, 2)); v = fmaxf(v, SWZ_XOR(v, 4)); v = fmaxf(v, SWZ_XOR(v, 8)); v = fmaxf(v, SWZ_XOR(v, 16));
    return fmaxf(__builtin_bit_cast(float, __builtin_amdgcn_readlane(__builtin_bit_cast(int, v), 0)), __builtin_bit_cast(float, __builtin_amdgcn_readlane(__builtin_bit_cast(int, v), 32)));
}
__device__ __forceinline__ float silu(float g) { return g / (1.f + __expf(-g)); }

struct Params { const float* in[16]; float* out; unsigned char* ws; int ph_lo, ph_hi; };
enum { I_X = 0, I_NMIX, I_WIN, I_CONVW, I_CONVB, I_DTB, I_ALOG, I_DSKIP, I_SSDN, I_POOLW, I_POOLS, I_WOUT, I_NFFN, I_WGU, I_WD, I_NFIN };

__device__ __forceinline__ void transpose_item(const float* W, int srcN, int c0, int k0, bf16* WT, int dstK, int n0, LAS float* scr, int lane) {
    if (c0 >= 0) {
#pragma unroll 8
        for (int i = 0; i < 32; ++i) { const int kk = 2 * i + (lane >> 5); scr[kk * 33 + (lane & 31)] = W[(size_t)(k0 + kk) * srcN + c0 + (lane & 31)]; }
    }
    asm volatile("s_waitcnt lgkmcnt(0)" ::: "memory");
    const int c = lane & 7;
#pragma unroll
    for (int j = 0; j < 4; ++j) { const int n = (lane >> 3) + 8 * j; const LAS float* s = scr + (8 * c) * 33 + n;
        v4u o = {0u, 0u, 0u, 0u};
        if (c0 >= 0) { o.x = pk2(s[0 * 33], s[1 * 33]); o.y = pk2(s[2 * 33], s[3 * 33]); o.z = pk2(s[4 * 33], s[5 * 33]); o.w = pk2(s[6 * 33], s[7 * 33]); }
        *(v4u*)(WT + (size_t)(n0 + n) * dstK + k0 + 8 * c) = o; }
    asm volatile("s_waitcnt lgkmcnt(0)" ::: "memory");
}
__device__ __forceinline__ void phase_prologue(const Params& P, LAS unsigned char* lds, int bid, int G, int tid, int wid, int lane) {
    LAS float* scr = (LAS float*)lds + wid * (64 * 33);
    const int gw = bid * 8 + wid, nw = G * 8;
    for (int it = gw; it < DEPTH * 6144; it += nw) {
        const int l = it / 6144; int r = it % 6144;
        if (r < 1408) { const int nb = r >> 4, kb = r & 15, n0 = nb * 32; const int c0 = n0 < 2432 ? n0 : (n0 < 2688 ? n0 + 6 : -1);
            transpose_item(P.in[I_WIN] + (size_t)l * D * INW, INW, c0, kb * 64, (bf16*)(P.ws + WS_WIN) + (size_t)l * NIN * D, D, n0, scr, lane); }
        else if (r < 1920) { r -= 1408; const int nb = r >> 4, kb = r & 15;
            transpose_item(P.in[I_WOUT] + (size_t)l * D * D, D, nb * 32, kb * 64, (bf16*)(P.ws + WS_WOUT) + (size_t)l * D * D, D, nb * 32, scr, lane); }
        else if (r < 4736) { r -= 1920; const int nb = r >> 4, kb = r & 15, n0 = nb * 32, pn = n0 >> 8, rr = n0 & 255; const int c0 = rr < 128 ? 128 * pn + rr : FF + 128 * pn + (rr - 128);
            transpose_item(P.in[I_WGU] + (size_t)l * D * NGU, NGU, c0, kb * 64, (bf16*)(P.ws + WS_WGU) + (size_t)l * NGU * D, D, n0, scr, lane); }
        else { r -= 4736; const int nb = r / 44, kb = r % 44;
            transpose_item(P.in[I_WD] + (size_t)l * FF * D, D, nb * 32, kb * 64, (bf16*)(P.ws + WS_WD) + (size_t)l * D * FF, FF, nb * 32, scr, lane); }
    }
    const int gt = bid * 512 + tid, nt = G * 512;
    float* dtw = (float*)(P.ws + WS_DTW);
    for (int i = gt; i < DEPTH * 8 * D; i += nt) { const int l = i / (8 * D), j = (i / D) & 7, k = i % D; dtw[i] = j < 6 ? P.in[I_WIN][((size_t)l * D + k) * INW + 2432 + j] : 0.f; }
    bf16* pwt = (bf16*)(P.ws + WS_PWT);
    for (int i = gt; i < DEPTH * 4 * 64 * 64; i += nt) { const int lg = i >> 12, d = (i >> 6) & 63, c = i & 63; pwt[i] = (bf16)f2bf(P.in[I_POOLW][(lg * 64 + c) * 64 + d]); }
}

__device__ __forceinline__ void phase_norm(const Params& P, int l, int mode, int bid, int G, int wid, int lane) {
    const float* X = (mode == 0 && l == 0) ? P.in[I_X] : P.out;
    const float* g = mode == 0 ? P.in[I_NMIX] + l * D : (mode == 1 ? P.in[I_NFFN] + l * D : P.in[I_NFIN]);
    bf16* H = (bf16*)(P.ws + WS_H);
    const float* dtw = (const float*)(P.ws + WS_DTW) + (size_t)l * 8 * D;
    float* DT = (float*)(P.ws + WS_DT);
    f32x4 gv[4];
#pragma unroll
    for (int j = 0; j < 4; ++j) gv[j] = *(const f32x4*)(g + 4 * lane + 256 * j);
    for (int row = bid * 8 + wid; row < T; row += G * 8) {
        const float* xr = X + (size_t)row * D + 4 * lane;
        f32x4 v[4]; float s = 0.f;
#pragma unroll
        for (int j = 0; j < 4; ++j) { v[j] = *(const f32x4*)(xr + 256 * j); s += (v[j].x * v[j].x + v[j].y * v[j].y) + (v[j].z * v[j].z + v[j].w * v[j].w); }
        const float rstd = rsqrtf(wave_sum(s) * (1.f / D) + EPS);
#pragma unroll
        for (int j = 0; j < 4; ++j) v[j] = (v[j] * rstd) * gv[j];
        if (mode == 2) {
#pragma unroll
            for (int j = 0; j < 4; ++j) *(f32x4*)(P.out + (size_t)row * D + 4 * lane + 256 * j) = v[j];
        } else {
            v2u* o8 = (v2u*)(H + (size_t)row * D + 4 * lane);
#pragma unroll
            for (int j = 0; j < 4; ++j) { v2u o; o.x = pk2(v[j].x, v[j].y); o.y = pk2(v[j].z, v[j].w); o8[64 * j] = o; }
            if (mode == 0) {
                float mine = 0.f;
#pragma unroll
                for (int q = 0; q < 6; ++q) { float a = 0.f;
#pragma unroll
                    for (int j = 0; j < 4; ++j) { const f32x4 w = *(const f32x4*)(dtw + q * D + 4 * lane + 256 * j); a += (v[j].x * w.x + v[j].y * w.y) + (v[j].z * w.z + v[j].w * w.w); }
                    a = wave_sum(a); if (lane == q) mine = a; }
                if (lane < 6) { const float z = mine + P.in[I_DTB][l * 6 + lane]; DT[(size_t)row * 8 + lane] = fmaxf(z, 0.f) + log1pf(__expf(-fabsf(z))); }
            }
        }
    }
}
__device__ __forceinline__ void naive_kmean(const Params& P, int bid, int tid) {
    const bf16* U = (const bf16*)(P.ws + WS_U); float* KM = (float*)(P.ws + WS_KM);
    const int i = bid * 512 + tid;
    if (i < BATCH * 6 * 8 * 64) { const int d = i & 63, j = (i >> 6) & 7, bh = i >> 9, b = bh / 6, h = bh % 6;
        float s = 0.f; for (int r = 0; r < 256; ++r) s += bf2f(U[(size_t)(b * SEQ + j * 256 + r) * NIN + UK + h * 64 + d]);
        KM[i] = s * (1.f / 256.f); }
}
__device__ __forceinline__ void naive_attn_query(const Params& P, int qi, int lane) {
    const bf16* U = (const bf16*)(P.ws + WS_U); const float* KM = (const float*)(P.ws + WS_KM); bf16* MIX = (bf16*)(P.ws + WS_H);
    const int t = qi & 2047, bh = qi >> 11, b = bh / 6, h = bh % 6, blk = t >> 8;
    float q[64];
    { const v4u* qp = (const v4u*)(U + (size_t)(b * SEQ + t) * NIN + UQ + h * 64);
#pragma unroll
      for (int c = 0; c < 8; ++c) { const v4u w = qp[c]; q[8*c] = bf2f(w.x & 0xffff); q[8*c+1] = bf2f(w.x >> 16); q[8*c+2] = bf2f(w.y & 0xffff); q[8*c+3] = bf2f(w.y >> 16);
          q[8*c+4] = bf2f(w.z & 0xffff); q[8*c+5] = bf2f(w.z >> 16); q[8*c+6] = bf2f(w.w & 0xffff); q[8*c+7] = bf2f(w.w >> 16); } }
    unsigned sel = 0;
    if (blk <= 3) sel = (1u << blk) - 1u;
    else {
        float gate[8];
        const float qd = bf2f(U[(size_t)(b * SEQ + t) * NIN + UQ + h * 64 + lane]);
#pragma unroll
        for (int j = 0; j < 8; ++j) { const float g = wave_sum(qd * KM[((size_t)bh * 8 + j) * 64 + lane]); gate[j] = j < blk ? g : -3e38f; }
#pragma unroll
        for (int r = 0; r < 3; ++r) { int best = 0; float bv = -3.4e38f;
#pragma unroll
            for (int j = 0; j < 8; ++j) { const bool ok = !((sel >> j) & 1u) && gate[j] > bv; bv = ok ? gate[j] : bv; best = ok ? j : best; }
            sel |= 1u << best; }
    }
#pragma unroll 1
    for (int dh = 0; dh < 2; ++dh) {
        float m = -1e30f, lsum = 0.f, o[32];
#pragma unroll
        for (int d = 0; d < 32; ++d) o[d] = 0.f;
        for (int jb = 0; jb <= blk; ++jb) {
            const bool own = jb == blk;
            if (!own && !((sel >> jb) & 1u)) continue;
            const int kend = own ? (t & 255) + 1 : 256;
            for (int kk = lane; kk < kend; kk += 64) {
                const v4u* kp = (const v4u*)(U + (size_t)(b * SEQ + jb * 256 + kk) * NIN + UK + h * 64);
                float s = 0.f;
#pragma unroll
                for (int c = 0; c < 8; ++c) { const v4u w = kp[c];
                    s += q[8*c] * bf2f(w.x & 0xffff) + q[8*c+1] * bf2f(w.x >> 16) + q[8*c+2] * bf2f(w.y & 0xffff) + q[8*c+3] * bf2f(w.y >> 16)
                       + q[8*c+4] * bf2f(w.z & 0xffff) + q[8*c+5] * bf2f(w.z >> 16) + q[8*c+6] * bf2f(w.w & 0xffff) + q[8*c+7] * bf2f(w.w >> 16); }
                s *= 0.125f;
                const float mn = fmaxf(m, s), a = __expf(m - mn), p = __expf(s - mn);
                lsum = lsum * a + p; m = mn;
                const v4u* vp = (const v4u*)((const bf16*)kp + 384 + dh * 32);
#pragma unroll
                for (int c = 0; c < 4; ++c) { const v4u w = vp[c];
                    o[8*c] = o[8*c] * a + p * bf2f(w.x & 0xffff); o[8*c+1] = o[8*c+1] * a + p * bf2f(w.x >> 16); o[8*c+2] = o[8*c+2] * a + p * bf2f(w.y & 0xffff); o[8*c+3] = o[8*c+3] * a + p * bf2f(w.y >> 16);
                    o[8*c+4] = o[8*c+4] * a + p * bf2f(w.z & 0xffff); o[8*c+5] = o[8*c+5] * a + p * bf2f(w.z >> 16); o[8*c+6] = o[8*c+6] * a + p * bf2f(w.w & 0xffff); o[8*c+7] = o[8*c+7] * a + p * bf2f(w.w >> 16); }
            }
        }
        const float M = wave_max(m), sc = __expf(m - M);
        const float L = wave_sum(lsum * sc);
        float outv = 0.f;
#pragma unroll
        for (int d = 0; d < 32; ++d) { const float s = wave_sum(o[d] * sc); outv = lane == d ? s : outv; }
        if (lane < 32) MIX[(size_t)(b * SEQ + t) * D + h * 64 + dh * 32 + lane] = (bf16)f2bf(outv / L);
    }
}
__device__ __forceinline__ void naive_ssd(const Params& P, int l, int bh, LAS unsigned char* lds, int tid) {
    const bf16* U = (const bf16*)(P.ws + WS_U); const float* DT = (const float*)(P.ws + WS_DT); float* YT = (float*)(P.ws + WS_ST);
    const int b = bh / 6, h = bh % 6, g = h / 3;
    LAS float* xs = (LAS float*)lds; LAS float* Bs = xs + 32 * 64; LAS float* Cs = Bs + 32 * 128; LAS float* dts = Cs + 32 * 128; LAS float* dAs = dts + 32;
    const float a = -__expf(P.in[I_ALOG][l * 6 + h]), Dk = P.in[I_DSKIP][l * 6 + h];
    const float* cw = P.in[I_CONVW] + (size_t)l * 4 * XBC; const float* cb = P.in[I_CONVB] + (size_t)l * XBC;
    const int p = tid >> 3, ns = (tid & 7) * 16;
    float hst[16];
#pragma unroll
    for (int i = 0; i < 16; ++i) hst[i] = 0.f;
    for (int t0 = 0; t0 < SEQ; t0 += 32) {
        __syncthreads();
        for (int idx = tid; idx < 32 * 320; idx += 512) {
            const int tt = idx / 320, c = idx % 320;
            const int ch = c < 64 ? h * 64 + c : (c < 192 ? 384 + g * 128 + (c - 64) : 640 + g * 128 + (c - 192));
            float acc = cb[ch];
#pragma unroll
            for (int k = 0; k < 4; ++k) { const int ts = t0 + tt - 3 + k; if (ts >= 0) acc += cw[k * XBC + ch] * bf2f(U[(size_t)(b * SEQ + ts) * NIN + UXS + ch]); }
            const float v = silu(acc);
            if (c < 64) xs[tt * 64 + c] = v; else if (c < 192) Bs[tt * 128 + c - 64] = v; else Cs[tt * 128 + c - 192] = v;
        }
        if (tid < 32) { const float dt = DT[(size_t)(b * SEQ + t0 + tid) * 8 + h]; dts[tid] = dt; dAs[tid] = __expf(dt * a); }
        __syncthreads();
        for (int tt = 0; tt < 32; ++tt) {
            const float xv = xs[tt * 64 + p], dA = dAs[tt], coef = dts[tt] * xv;
            float y = 0.f;
#pragma unroll
            for (int i = 0; i < 16; ++i) { hst[i] = hst[i] * dA + coef * Bs[tt * 128 + ns + i]; y += hst[i] * Cs[tt * 128 + ns + i]; }
            y += SWZ_XOR(y, 1); y += SWZ_XOR(y, 2); y += SWZ_XOR(y, 4);
            if ((tid & 7) == 0) { const size_t row = (size_t)(b * SEQ + t0 + tt);
                const float z = bf2f(U[row * NIN + UZ + h * 64 + p]);
                YT[row * 384 + h * 64 + p] = (y + Dk * xv) * silu(z); }
        }
    }
}
__device__ __forceinline__ void naive_ssd_norm(const Params& P, int l, int bid, int G, int wid, int lane) {
    const float* YT = (const float*)(P.ws + WS_ST); bf16* MIX = (bf16*)(P.ws + WS_H);
    for (int it = bid * 8 + wid; it < T * 2; it += G * 8) {
        const int row = it >> 1, g = it & 1;
        const float* y = YT + (size_t)row * 384 + g * 192;
        const float v0 = y[lane], v1 = y[lane + 64], v2 = y[lane + 128];
        const float r = rsqrtf(wave_sum(v0 * v0 + v1 * v1 + v2 * v2) * (1.f / 192.f) + EPS);
        const float* nw = P.in[I_SSDN] + l * 384 + g * 192;
        bf16* o = MIX + (size_t)row * D + 384 + g * 192;
        o[lane] = (bf16)f2bf(v0 * r * nw[lane]); o[lane + 64] = (bf16)f2bf(v1 * r * nw[lane + 64]); o[lane + 128] = (bf16)f2bf(v2 * r * nw[lane + 128]);
    }
}
__device__ __forceinline__ void naive_pool(const Params& P, int l, int item, LAS unsigned char* lds, int tid) {
    const bf16* U = (const bf16*)(P.ws + WS_U); bf16* MIX = (bf16*)(P.ws + WS_H);
    LAS float* diff = (LAS float*)lds;
    const int tok0 = item * 8;
    __syncthreads();
    for (int idx = tid; idx < 8 * 256; idx += 512) { const int tt = idx >> 8, c = idx & 255, g = c >> 6, W = 2 << g; const int row = tok0 + tt, pos = row & (SEQ - 1);
        const int cnt = pos + 1 < W ? pos + 1 : W; float s = 0.f;
        for (int i = 0; i < cnt; ++i) s += bf2f(U[(size_t)(row - i) * NIN + UP + c]);
        diff[idx] = s / (float)cnt - bf2f(U[(size_t)row * NIN + UP + c]); }
    __syncthreads();
    for (int idx = tid; idx < 8 * 256; idx += 512) { const int tt = idx >> 8, dc = idx & 255, g = dc >> 6, dd = dc & 63;
        const float* w = P.in[I_POOLW] + ((size_t)(l * 4 + g) * 64) * 64 + dd; float acc = 0.f;
        for (int c = 0; c < 64; ++c) acc += diff[tt * 256 + g * 64 + c] * w[c * 64];
        MIX[(size_t)(tok0 + tt) * D + 768 + dc] = (bf16)f2bf(acc * P.in[I_POOLS][l * 256 + dc]); }
}
typedef float f32x16 __attribute__((ext_vector_type(16)));
typedef short s16x8 __attribute__((ext_vector_type(8)));
typedef short s16x4 __attribute__((ext_vector_type(4)));
typedef short v4i16_t __attribute__((ext_vector_type(4)));
#define MFMA32(a, b, c) __builtin_amdgcn_mfma_f32_32x32x16_bf16((a), (b), (c), 0, 0, 0)
__device__ __forceinline__ s16x4 lds_tr(LAS const unsigned char* p) { return __builtin_bit_cast(s16x4, __builtin_amdgcn_ds_read_tr16_b64_v4i16((LAS v4i16_t*)p)); }
__device__ __forceinline__ float xhalf_sum(float v) { float a = v, b = v; asm volatile("s_nop 1\n\tv_permlane32_swap_b32 %0, %1" : "+v"(a), "+v"(b)); return a + b; }
__device__ __forceinline__ float xhalf_max(float v) { float a = v, b = v; asm volatile("s_nop 1\n\tv_permlane32_swap_b32 %0, %1" : "+v"(a), "+v"(b)); return fmaxf(a, b); }
constexpr int AT_KS = 144;
constexpr int AT_TILE = 64 * AT_KS;
constexpr int AT_K0 = 0, AT_V0 = 2 * AT_TILE, AT_KM = 4 * AT_TILE, AT_PART = AT_KM + 8 * 64 * 4;
__device__ __forceinline__ void attn_unit(const Params& P, int b, int h, int blk, LAS unsigned char* lds, int tid, int wid, int lane) {
    const bf16* U = (const bf16*)(P.ws + WS_U); bf16* MIX = (bf16*)(P.ws + WS_H);
    const int r = lane & 31, hh = lane >> 5;
    const size_t row0 = (size_t)b * SEQ;
    LAS float* KM = (LAS float*)(lds + AT_KM);
    __syncthreads();
    if (blk >= 4) {
        LAS float* part = (LAS float*)(lds + AT_PART);
        const int d2 = tid & 31, kg = tid >> 5;
        for (int j = 0; j < blk; ++j) {
            const unsigned* kp = (const unsigned*)(U + (row0 + j * 256 + kg * 16) * NIN + UK + h * 64) + d2;
            float s0 = 0.f, s1 = 0.f;
#pragma unroll
            for (int i = 0; i < 16; ++i) { const unsigned w = kp[(size_t)i * (NIN / 2)]; s0 += bf2f(w & 0xffff); s1 += bf2f(w >> 16); }
            part[(j * 16 + kg) * 64 + 2 * d2] = s0; part[(j * 16 + kg) * 64 + 2 * d2 + 1] = s1;
        }
        __syncthreads();
        if (tid < blk * 64) { const int j = tid >> 6, d = tid & 63; float s = 0.f;
#pragma unroll
            for (int k = 0; k < 16; ++k) s += part[(j * 16 + k) * 64 + d];
            KM[j * 64 + d] = s * (1.f / 256.f); }
        __syncthreads();
    }
    const int qrow = blk * 256 + wid * 32 + r;
    s16x8 qf[4];
    { const v4u* qp = (const v4u*)(U + (row0 + qrow) * NIN + UQ + h * 64 + 8 * hh);
#pragma unroll
      for (int s = 0; s < 4; ++s) qf[s] = __builtin_bit_cast(s16x8, qp[2 * s]); }
    unsigned sel = (1u << blk) - 1u;
    if (blk >= 4) {
        float gate[8];
#pragma unroll
        for (int j = 0; j < 8; ++j) gate[j] = -3e38f;
#pragma unroll
        for (int j = 0; j < 7; ++j) if (j < blk) { float g = 0.f;
#pragma unroll
            for (int s = 0; s < 4; ++s) {
                const f32x4 k0 = *(LAS const f32x4*)(KM + j * 64 + 16 * s + 8 * hh), k1 = *(LAS const f32x4*)(KM + j * 64 + 16 * s + 8 * hh + 4);
                g += bf2f((unsigned short)qf[s][0]) * k0.x + bf2f((unsigned short)qf[s][1]) * k0.y + bf2f((unsigned short)qf[s][2]) * k0.z + bf2f((unsigned short)qf[s][3]) * k0.w
                   + bf2f((unsigned short)qf[s][4]) * k1.x + bf2f((unsigned short)qf[s][5]) * k1.y + bf2f((unsigned short)qf[s][6]) * k1.z + bf2f((unsigned short)qf[s][7]) * k1.w; }
            gate[j] = xhalf_sum(g); }
        sel = 0u;
#pragma unroll
        for (int t = 0; t < 3; ++t) { int best = 0; float bv = -3.4e38f;
#pragma unroll
            for (int j = 0; j < 8; ++j) { const bool ok = !((sel >> j) & 1u) && gate[j] > bv; bv = ok ? gate[j] : bv; best = ok ? j : best; }
            sel |= 1u << best; }
    }
    const int ntiles = 4 + 4 * blk;
    const int ldrow = tid >> 3, ldch = tid & 7;
    const bf16* kvbase = U + (row0 + ldrow) * NIN + UK + h * 64 + ldch * 8;
    const int ldoff = ldrow * AT_KS + ldch * 16;
    auto tile_key0 = [&](int i) { return i < 4 ? blk * 256 + i * 64 : (i - 4) * 64; };
    v4u kreg, vreg;
    { const bf16* p0 = kvbase + (size_t)tile_key0(0) * NIN; kreg = *(const v4u*)p0; vreg = *(const v4u*)(p0 + 384); }
    *(LAS v4u*)(lds + AT_K0 + ldoff) = kreg; *(LAS v4u*)(lds + AT_V0 + ldoff) = vreg;
    __syncthreads();
    f32x16 o0, o1;
#pragma unroll
    for (int i = 0; i < 16; ++i) { o0[i] = 0.f; o1[i] = 0.f; }
    float m = -1e30f, lsum = 0.f;
    const float SC = 0.125f * 1.44269504088896f;
    const int i16 = lane & 15, b16 = (lane >> 4) & 1;
    const int troff = (i16 >> 2) * AT_KS + (16 * b16) * 2 + 8 * (i16 & 3);
    for (int i = 0; i < ntiles; ++i) {
        const int buf = i & 1;
        if (i + 1 < ntiles) { const bf16* p1 = kvbase + (size_t)tile_key0(i + 1) * NIN; kreg = *(const v4u*)p1; vreg = *(const v4u*)(p1 + 384); }
        bool need; int jpast = -1, kt = i;
        if (i < 4) need = (64 * i <= 32 * wid + 31);
        else { jpast = (i - 4) >> 2; need = __builtin_amdgcn_ballot_w64((sel >> jpast) & 1u) != 0ull; }
        if (need) {
            LAS const unsigned char* Kt = lds + AT_K0 + buf * AT_TILE; LAS const unsigned char* Vt = lds + AT_V0 + buf * AT_TILE;
            f32x16 sA, sB;
#pragma unroll
            for (int e = 0; e < 16; ++e) { sA[e] = 0.f; sB[e] = 0.f; }
#pragma unroll
            for (int s = 0; s < 4; ++s) {
                const s16x8 ka = *(LAS const s16x8*)(Kt + r * AT_KS + 32 * s + 16 * hh);
                const s16x8 kb = *(LAS const s16x8*)(Kt + (32 + r) * AT_KS + 32 * s + 16 * hh);
                sA = MFMA32(ka, qf[s], sA); sB = MFMA32(kb, qf[s], sB);
            }
            const bool lane_on = (i < 4) || ((sel >> jpast) & 1u);
            const int qpos = 32 * wid + r;
            float mx = -1e30f;
#pragma unroll
            for (int e = 0; e < 16; ++e) {
                const int kr = (e & 3) + 8 * (e >> 2) + 4 * hh;
                float a = sA[e] * SC, c = sB[e] * SC;
                if (i < 4) { if (64 * kt + kr > qpos) a = -1e30f; if (64 * kt + 32 + kr > qpos) c = -1e30f; }
                if (!lane_on) { a = -1e30f; c = -1e30f; }
                sA[e] = a; sB[e] = c; mx = fmaxf(mx, fmaxf(a, c));
            }
            mx = xhalf_max(mx);
            const float mn = fmaxf(m, mx), alpha = __builtin_amdgcn_exp2f(m - mn);
            m = mn;
            float ps = 0.f;
#pragma unroll
            for (int e = 0; e < 16; ++e) { sA[e] = __builtin_amdgcn_exp2f(sA[e] - mn); sB[e] = __builtin_amdgcn_exp2f(sB[e] - mn); ps += sA[e] + sB[e]; }
            lsum = lsum * alpha + ps;
#pragma unroll
            for (int e = 0; e < 16; ++e) { o0[e] *= alpha; o1[e] *= alpha; }
#pragma unroll
            for (int sub = 0; sub < 2; ++sub)
#pragma unroll
                for (int s2 = 0; s2 < 2; ++s2) {
                    s16x8 pb;
#pragma unroll
                    for (int jj = 0; jj < 8; jj += 2) { const float x0 = sub ? sB[8 * s2 + jj] : sA[8 * s2 + jj], x1 = sub ? sB[8 * s2 + jj + 1] : sA[8 * s2 + jj + 1];
                        const unsigned w = pk2(x0, x1); pb[jj] = (short)(w & 0xffff); pb[jj + 1] = (short)(w >> 16); }
                    const int klo = 32 * sub + 16 * s2 + 4 * hh;
#pragma unroll
                    for (int db = 0; db < 2; ++db) {
                        const s16x4 lo = lds_tr(Vt + klo * AT_KS + troff + 64 * db), hi = lds_tr(Vt + (klo + 8) * AT_KS + troff + 64 * db);
                        const s16x8 va = __builtin_shufflevector(lo, hi, 0, 1, 2, 3, 4, 5, 6, 7);
                        if (db == 0) o0 = MFMA32(va, pb, o0); else o1 = MFMA32(va, pb, o1);
                    }
                }
        }
        if (i + 1 < ntiles) { *(LAS v4u*)(lds + AT_K0 + (buf ^ 1) * AT_TILE + ldoff) = kreg; *(LAS v4u*)(lds + AT_V0 + (buf ^ 1) * AT_TILE + ldoff) = vreg; }
        __syncthreads();
    }
    const float inv = 1.f / xhalf_sum(lsum);
    bf16* orow = MIX + (row0 + qrow) * D + h * 64 + 4 * hh;
#pragma unroll
    for (int g = 0; g < 4; ++g) {
        v2u w0, w1;
        w0.x = pk2(o0[4 * g] * inv, o0[4 * g + 1] * inv); w0.y = pk2(o0[4 * g + 2] * inv, o0[4 * g + 3] * inv);
        w1.x = pk2(o1[4 * g] * inv, o1[4 * g + 1] * inv); w1.y = pk2(o1[4 * g + 2] * inv, o1[4 * g + 3] * inv);
        *(v2u*)(orow + 8 * g) = w0; *(v2u*)(orow + 32 + 8 * g) = w1;
    }
}
constexpr int SX_S = 400, SB_S = 272;
constexpr int S_X = 0, S_B = 51200, S_C = 86016, S_PREV = 120832, S_DT = 138240, S_AC = S_DT + 1536, S_DA = S_AC + 1536;
__device__ __forceinline__ int crow16(int i, int hh) { return (i & 3) + 8 * (i >> 2) + 4 * hh; }
template <bool PHASE_A>
__device__ __forceinline__ void ssd_stage(const Params& P, int l, int b, int c, int g, LAS unsigned char* lds, int tid) {
    const bf16* U = (const bf16*)(P.ws + WS_U); const float* DT = (const float*)(P.ws + WS_DT);
    const float* alog = P.in[I_ALOG]; const float* convw = P.in[I_CONVW]; const float* convb = P.in[I_CONVB];
    asm volatile("" : "+s"(alog), "+s"(convw), "+s"(convb));
    const size_t row0 = (size_t)b * SEQ + c * 128;
    LAS float* dts = (LAS float*)(lds + S_DT); LAS float* acs = (LAS float*)(lds + S_AC); LAS float* das = (LAS float*)(lds + S_DA);
    if (tid < 384) { const int hh3 = tid >> 7, li = tid & 127, h = 3 * g + hh3; const float dt = DT[(row0 + li) * 8 + h]; dts[tid] = dt; das[tid] = dt * -__expf(alog[l * 6 + h]); }
    __syncthreads();
    if (tid < 384) { const int hh3 = tid >> 7, li = tid & 127; float s = 0.f; for (int i = 0; i <= li; ++i) s += das[hh3 * 128 + i]; acs[tid] = s; }
    __syncthreads();
    const int cc = tid & 63, tg = tid >> 6;
    if (cc < (PHASE_A ? 40 : 56)) {
        const int ch = cc < 24 ? g * 192 + cc * 8 : (cc < 40 ? 384 + g * 128 + (cc - 24) * 8 : 640 + g * 128 + (cc - 40) * 8);
        const float* cw = convw + (size_t)l * 4 * XBC + ch; const float* cb = convb + (size_t)l * XBC + ch;
        float w[4][8], bias[8], xw[3][8];
#pragma unroll
        for (int k = 0; k < 4; ++k) { const f32x4 a = *(const f32x4*)(cw + k * XBC), d = *(const f32x4*)(cw + k * XBC + 4);
            w[k][0] = a.x; w[k][1] = a.y; w[k][2] = a.z; w[k][3] = a.w; w[k][4] = d.x; w[k][5] = d.y; w[k][6] = d.z; w[k][7] = d.w; }
        { const f32x4 a = *(const f32x4*)cb, d = *(const f32x4*)(cb + 4); bias[0] = a.x; bias[1] = a.y; bias[2] = a.z; bias[3] = a.w; bias[4] = d.x; bias[5] = d.y; bias[6] = d.z; bias[7] = d.w; }
        const bf16* src = U + (row0 + tg * 16) * NIN + UXS + ch;
        const bool has_prev = !(c == 0 && tg == 0);
#pragma unroll
        for (int k = 0; k < 3; ++k) { v4u q = {0u, 0u, 0u, 0u}; if (has_prev) q = *(const v4u*)(src - (size_t)(3 - k) * NIN);
            xw[k][0] = bf2f(q.x & 0xffff); xw[k][1] = bf2f(q.x >> 16); xw[k][2] = bf2f(q.y & 0xffff); xw[k][3] = bf2f(q.y >> 16);
            xw[k][4] = bf2f(q.z & 0xffff); xw[k][5] = bf2f(q.z >> 16); xw[k][6] = bf2f(q.w & 0xffff); xw[k][7] = bf2f(q.w >> 16); }
        const int hh3 = cc >> 3;
        const float ac_end = acs[(cc < 24 ? hh3 : 0) * 128 + 127];
        LAS unsigned char* dst = lds + (cc < 24 ? S_X + cc * 16 : (cc < 40 ? S_B + (cc - 24) * 16 : S_C + (cc - 40) * 16));
        const int dstride = cc < 24 ? SX_S : SB_S;
#pragma unroll 1
        for (int t = 0; t < 16; ++t) {
            const v4u q = *(const v4u*)(src + (size_t)t * NIN);
            float cur[8] = {bf2f(q.x & 0xffff), bf2f(q.x >> 16), bf2f(q.y & 0xffff), bf2f(q.y >> 16), bf2f(q.z & 0xffff), bf2f(q.z >> 16), bf2f(q.w & 0xffff), bf2f(q.w >> 16)};
            const int tok = tg * 16 + t;
            float sc = 1.f;
            if (PHASE_A && cc < 24) sc = dts[hh3 * 128 + tok] * __expf(ac_end - acs[hh3 * 128 + tok]);
            float o[8];
#pragma unroll
            for (int j = 0; j < 8; ++j) { const float a = bias[j] + w[0][j] * xw[0][j] + w[1][j] * xw[1][j] + w[2][j] * xw[2][j] + w[3][j] * cur[j]; o[j] = silu(a) * sc;
                xw[0][j] = xw[1][j]; xw[1][j] = xw[2][j]; xw[2][j] = cur[j]; }
            v4u pk; pk.x = pk2(o[0], o[1]); pk.y = pk2(o[2], o[3]); pk.z = pk2(o[4], o[5]); pk.w = pk2(o[6], o[7]);
            *(LAS v4u*)(dst + tok * dstride) = pk;
        }
    }
    __syncthreads();
}
__device__ __forceinline__ void ssd_unit_a(const Params& P, int l, int b, int c, int g, LAS unsigned char* lds, int tid, int wid, int lane) {
    __syncthreads();
    ssd_stage<true>(P, l, b, c, g, lds, tid);
    LAS float* acs = (LAS float*)(lds + S_AC);
    if (tid < 3) ((float*)(P.ws + WS_CD))[(b * 16 + c) * 6 + 3 * g + tid] = __expf(acs[tid * 128 + 127]);
    const int r = lane & 31, hh = lane >> 5, nt = wid & 3, pt = wid >> 2, i16 = lane & 15, b16 = (lane >> 4) & 1;
    const int troffB = (i16 >> 2) * SB_S + (32 * nt + 16 * b16) * 2 + 8 * (i16 & 3);
    s16x8 bfr[8];
#pragma unroll
    for (int s = 0; s < 8; ++s) { const int k0 = 16 * s + 8 * hh;
        const s16x4 lo = lds_tr(lds + S_B + k0 * SB_S + troffB), hi = lds_tr(lds + S_B + (k0 + 4) * SB_S + troffB);
        bfr[s] = __builtin_shufflevector(lo, hi, 0, 1, 2, 3, 4, 5, 6, 7); }
    float* ST = (float*)(P.ws + WS_ST);
#pragma unroll
    for (int hh3 = 0; hh3 < 3; ++hh3) {
        const int troffX = (i16 >> 2) * SX_S + (hh3 * 64 + 32 * pt + 16 * b16) * 2 + 8 * (i16 & 3);
        f32x16 acc;
#pragma unroll
        for (int e = 0; e < 16; ++e) acc[e] = 0.f;
#pragma unroll
        for (int s = 0; s < 8; ++s) { const int k0 = 16 * s + 8 * hh;
            const s16x4 lo = lds_tr(lds + S_X + k0 * SX_S + troffX), hi = lds_tr(lds + S_X + (k0 + 4) * SX_S + troffX);
            const s16x8 xa = __builtin_shufflevector(lo, hi, 0, 1, 2, 3, 4, 5, 6, 7);
            acc = MFMA32(xa, bfr[s], acc); }
        float* S = ST + ((size_t)((b * 16 + c) * 6 + 3 * g + hh3)) * 8192;
#pragma unroll
        for (int e = 0; e < 16; ++e) S[(32 * pt + crow16(e, hh)) * 128 + 32 * nt + r] = acc[e];
    }
}
__device__ __forceinline__ void ssd_unit_b(const Params& P, int l, int b, int c, int g, LAS unsigned char* lds, int tid, int wid, int lane) {
    const float* dskip = P.in[I_DSKIP]; const float* ssdn = P.in[I_SSDN];
    asm volatile("" : "+s"(dskip), "+s"(ssdn));
    __syncthreads();
    ssd_stage<false>(P, l, b, c, g, lds, tid);
    const bf16* U = (const bf16*)(P.ws + WS_U); bf16* MIX = (bf16*)(P.ws + WS_H);
    const float* ST = (const float*)(P.ws + WS_ST); const float* CD = (const float*)(P.ws + WS_CD);
    LAS float* dts = (LAS float*)(lds + S_DT); LAS float* acs = (LAS float*)(lds + S_AC); LAS float* ssb = (LAS float*)(lds + S_DA);
    const size_t row0 = (size_t)b * SEQ + c * 128;
    const int r = lane & 31, hh = lane >> 5, lt = wid & 3, pb = wid >> 2, i16 = lane & 15, b16 = (lane >> 4) & 1;
#define CF(s) (*(LAS const s16x8*)(lds + S_C + (32 * lt + r) * SB_S + (16 * (s) + 8 * hh) * 2))
    f32x16 Y[3];
#pragma unroll
    for (int hh3 = 0; hh3 < 3; ++hh3) {
        const int h = 3 * g + hh3;
        __syncthreads();
        { f32x4 a0 = {0.f, 0.f, 0.f, 0.f}, a1 = a0, a2 = a0, a3 = a0;
          for (int cp = 0; cp < c; ++cp) { const float d = CD[(b * 16 + cp) * 6 + h]; const float* S = ST + ((size_t)((b * 16 + cp) * 6 + h)) * 8192 + tid * 4;
              a0 = a0 * d + *(const f32x4*)S; a1 = a1 * d + *(const f32x4*)(S + 2048); a2 = a2 * d + *(const f32x4*)(S + 4096); a3 = a3 * d + *(const f32x4*)(S + 6144); }
          const int p = tid >> 5, n = (tid & 31) * 4;
          v2u w; w.x = pk2(a0.x, a0.y); w.y = pk2(a0.z, a0.w); *(LAS v2u*)(lds + S_PREV + p * SB_S + n * 2) = w;
          w.x = pk2(a1.x, a1.y); w.y = pk2(a1.z, a1.w); *(LAS v2u*)(lds + S_PREV + (p + 16) * SB_S + n * 2) = w;
          w.x = pk2(a2.x, a2.y); w.y = pk2(a2.z, a2.w); *(LAS v2u*)(lds + S_PREV + (p + 32) * SB_S + n * 2) = w;
          w.x = pk2(a3.x, a3.y); w.y = pk2(a3.z, a3.w); *(LAS v2u*)(lds + S_PREV + (p + 48) * SB_S + n * 2) = w; }
        __syncthreads();
        f32x16 acc;
#pragma unroll
        for (int e = 0; e < 16; ++e) acc[e] = 0.f;
#pragma unroll
        for (int s = 0; s < 8; ++s) { const s16x8 a = *(LAS const s16x8*)(lds + S_PREV + (32 * pb + r) * SB_S + (16 * s + 8 * hh) * 2); acc = MFMA32(a, CF(s), acc); }
        const float el = __expf(acs[hh3 * 128 + 32 * lt + r]);
#pragma unroll
        for (int e = 0; e < 16; ++e) Y[hh3][e] = acc[e] * el;
    }
    for (int st = 0; st <= lt; ++st) {
        f32x16 Gt;
#pragma unroll
        for (int e = 0; e < 16; ++e) Gt[e] = 0.f;
#pragma unroll
        for (int s = 0; s < 8; ++s) { const s16x8 a = *(LAS const s16x8*)(lds + S_B + (32 * st + r) * SB_S + (16 * s + 8 * hh) * 2); Gt = MFMA32(a, CF(s), Gt); }
#pragma unroll
        for (int hh3 = 0; hh3 < 3; ++hh3) {
            const float acl = acs[hh3 * 128 + 32 * lt + r];
            const int troffX = (i16 >> 2) * SX_S + (hh3 * 64 + 32 * pb + 16 * b16) * 2 + 8 * (i16 & 3);
#pragma unroll
            for (int s2 = 0; s2 < 2; ++s2) {
                s16x8 pbk;
#pragma unroll
                for (int jj = 0; jj < 8; jj += 2) {
                    float mv[2];
#pragma unroll
                    for (int t = 0; t < 2; ++t) { const int e = 8 * s2 + jj + t, kr = crow16(e, hh), stok = 32 * st + kr;
                        const bool valid = (st < lt) || (kr <= r);
                        const float v = Gt[e] * __expf(fminf(acl - acs[hh3 * 128 + stok], 0.f)) * dts[hh3 * 128 + stok];
                        mv[t] = valid ? v : 0.f; }
                    const unsigned w = pk2(mv[0], mv[1]); pbk[jj] = (short)(w & 0xffff); pbk[jj + 1] = (short)(w >> 16); }
                const int klo = 32 * st + 16 * s2 + 4 * hh;
                const s16x4 lo = lds_tr(lds + S_X + klo * SX_S + troffX), hi = lds_tr(lds + S_X + (klo + 8) * SX_S + troffX);
                const s16x8 xa = __builtin_shufflevector(lo, hi, 0, 1, 2, 3, 4, 5, 6, 7);
                Y[hh3] = MFMA32(xa, pbk, Y[hh3]);
                __builtin_amdgcn_sched_barrier(0);
            }
        }
    }
    float ssq = 0.f;
    const size_t grow = row0 + 32 * lt + r;
#pragma unroll
    for (int hh3 = 0; hh3 < 3; ++hh3) { const int h = 3 * g + hh3; const float Dk = dskip[l * 6 + h];
#pragma unroll
        for (int q4 = 0; q4 < 4; ++q4) { const int p0 = 32 * pb + 8 * q4 + 4 * hh;
            const v2u xr = *(LAS const v2u*)(lds + S_X + (32 * lt + r) * SX_S + (hh3 * 64 + p0) * 2);
            const v2u zr = *(const v2u*)(U + grow * NIN + UZ + h * 64 + p0);
            const f32x4 xv = {bf2f(xr.x & 0xffff), bf2f(xr.x >> 16), bf2f(xr.y & 0xffff), bf2f(xr.y >> 16)};
            const f32x4 zv = {bf2f(zr.x & 0xffff), bf2f(zr.x >> 16), bf2f(zr.y & 0xffff), bf2f(zr.y >> 16)};
#pragma unroll
            for (int e = 0; e < 4; ++e) { const float y = (Y[hh3][4 * q4 + e] + Dk * xv[e]) * silu(zv[e]); Y[hh3][4 * q4 + e] = y; ssq += y * y; } } }
    ssq = xhalf_sum(ssq);
    if (hh == 0) ssb[pb * 128 + 32 * lt + r] = ssq;
    __syncthreads();
    const float rs = rsqrtf((ssb[32 * lt + r] + ssb[128 + 32 * lt + r]) * (1.f / 192.f) + EPS);
#pragma unroll
    for (int hh3 = 0; hh3 < 3; ++hh3)
#pragma unroll
        for (int q4 = 0; q4 < 4; ++q4) { const int p0 = 32 * pb + 8 * q4 + 4 * hh, chn = g * 192 + hh3 * 64 + p0;
            const f32x4 nw = *(const f32x4*)(ssdn + l * 384 + chn);
            v2u w; w.x = pk2(Y[hh3][4 * q4] * rs * nw.x, Y[hh3][4 * q4 + 1] * rs * nw.y); w.y = pk2(Y[hh3][4 * q4 + 2] * rs * nw.z, Y[hh3][4 * q4 + 3] * rs * nw.w);
            *(v2u*)(MIX + grow * D + 384 + chn) = w; }
}
constexpr int PL_S = 528;
__device__ __forceinline__ void pool_unit(const Params& P, int l, int unit, LAS unsigned char* lds, int tid, int wid, int lane) {
    const bf16* U = (const bf16*)(P.ws + WS_U); bf16* MIX = (bf16*)(P.ws + WS_H);
    const bf16* pwt = (const bf16*)(P.ws + WS_PWT) + (size_t)l * 4 * 4096;
    const float* pscale = P.in[I_POOLS]; asm volatile("" : "+s"(pscale));
    const size_t row0 = (size_t)unit * 64;
    __syncthreads();
    { const int cc = tid & 31, ts = tid >> 5, g = cc >> 3, W = 2 << g;
      const bf16* src = U + row0 * NIN + UP + cc * 8;
      f32x4 s0 = {0.f, 0.f, 0.f, 0.f}, s1 = s0;
      const int t0 = ts * 4, pos0 = (int)((row0 + t0) & (SEQ - 1));
      for (int i = 1; i < W; ++i) if (i <= pos0) { const v4u q = *(const v4u*)(src + (ptrdiff_t)(t0 - i) * NIN);
          s0.x += bf2f(q.x & 0xffff); s0.y += bf2f(q.x >> 16); s0.z += bf2f(q.y & 0xffff); s0.w += bf2f(q.y >> 16);
          s1.x += bf2f(q.z & 0xffff); s1.y += bf2f(q.z >> 16); s1.z += bf2f(q.w & 0xffff); s1.w += bf2f(q.w >> 16); }
#pragma unroll
      for (int t = 0; t < 4; ++t) {
          const int tok = t0 + t, pos = pos0 + t;
          const v4u q = *(const v4u*)(src + (size_t)tok * NIN);
          const f32x4 x0 = {bf2f(q.x & 0xffff), bf2f(q.x >> 16), bf2f(q.y & 0xffff), bf2f(q.y >> 16)}, x1 = {bf2f(q.z & 0xffff), bf2f(q.z >> 16), bf2f(q.w & 0xffff), bf2f(q.w >> 16)};
          s0 += x0; s1 += x1;
          if (t > 0 && pos - W >= 0) { const v4u o = *(const v4u*)(src + (ptrdiff_t)(tok - W) * NIN);
              const f32x4 y0 = {bf2f(o.x & 0xffff), bf2f(o.x >> 16), bf2f(o.y & 0xffff), bf2f(o.y >> 16)}, y1 = {bf2f(o.z & 0xffff), bf2f(o.z >> 16), bf2f(o.w & 0xffff), bf2f(o.w >> 16)};
              s0 -= y0; s1 -= y1; }
          const float inv = 1.f / (float)(pos + 1 < W ? pos + 1 : W);
          const f32x4 d0 = s0 * inv - x0, d1 = s1 * inv - x1;
          v4u pk; pk.x = pk2(d0.x, d0.y); pk.y = pk2(d0.z, d0.w); pk.z = pk2(d1.x, d1.y); pk.w = pk2(d1.z, d1.w);
          *(LAS v4u*)(lds + tok * PL_S + cc * 16) = pk;
      } }
    __syncthreads();
    const int r = lane & 31, hh = lane >> 5, g = wid >> 1, dt = wid & 1;
    s16x8 wa[4];
#pragma unroll
    for (int s = 0; s < 4; ++s) wa[s] = __builtin_bit_cast(s16x8, *(const v4u*)(pwt + (size_t)g * 4096 + (32 * dt + r) * 64 + 16 * s + 8 * hh));
#pragma unroll
    for (int tt = 0; tt < 2; ++tt) {
        f32x16 acc;
#pragma unroll
        for (int e = 0; e < 16; ++e) acc[e] = 0.f;
#pragma unroll
        for (int s = 0; s < 4; ++s) { const s16x8 bq = *(LAS const s16x8*)(lds + (32 * tt + r) * PL_S + (g * 64 + 16 * s + 8 * hh) * 2); acc = MFMA32(wa[s], bq, acc); }
        bf16* orow = MIX + (row0 + 32 * tt + r) * D + 768 + g * 64 + 32 * dt + 4 * hh;
#pragma unroll
        for (int q4 = 0; q4 < 4; ++q4) { const f32x4 sc = *(const f32x4*)(pscale + l * 256 + g * 64 + 32 * dt + 4 * hh + 8 * q4);
            v2u w; w.x = pk2(acc[4 * q4] * sc.x, acc[4 * q4 + 1] * sc.y); w.y = pk2(acc[4 * q4 + 2] * sc.z, acc[4 * q4 + 3] * sc.w);
            *(v2u*)(orow + 8 * q4) = w; }
    }
}
__device__ __forceinline__ void grid_sync(unsigned* ctr, unsigned target, int wid0) {
    __builtin_amdgcn_fence(__ATOMIC_RELEASE, "agent");
    __syncthreads();
    if (wid0 == 0) {
        int lane; asm volatile("v_mbcnt_lo_u32_b32 %0, -1, 0\n\tv_mbcnt_hi_u32_b32 %0, -1, %0" : "=v"(lane));
        if (lane == 0) {
            __hip_atomic_fetch_add(ctr, 1u, __ATOMIC_RELEASE, __HIP_MEMORY_SCOPE_AGENT);
            while (__hip_atomic_load(ctr, __ATOMIC_RELAXED, __HIP_MEMORY_SCOPE_AGENT) < target) __builtin_amdgcn_s_sleep(2);
        }
    }
    __syncthreads();
    __builtin_amdgcn_fence(__ATOMIC_ACQUIRE, "agent");
}
template <int PH> __device__ __forceinline__ void run_phase(const Params& P0, LAS unsigned char* lds, const int wid0) {
    Params P = P0; asm volatile("" : "+s"(P.ws), "+s"(P.out));
#pragma unroll
    for (int i = 0; i < 16; ++i) asm volatile("" : "+s"(P.in[i]));
    int lane_; asm volatile("v_mbcnt_lo_u32_b32 %0, -1, 0\n\tv_mbcnt_hi_u32_b32 %0, -1, %0" : "=v"(lane_));
    int wid_ = wid0; asm volatile("" : "+s"(wid_));
    const int tid = wid_ * 64 + lane_;
    int bid = blockIdx.x, G = gridDim.x; asm volatile("" : "+s"(bid), "+s"(G));
    const int lane = lane_, wid = wid_;
    if constexpr (PH == 0) phase_prologue(P, lds, bid, G, tid, wid, lane);
    else if constexpr (PH == N_PHASES - 1) phase_norm(P, 0, 2, bid, G, wid, lane);
    else {
        constexpr int l = (PH - 1) / NPH, s = (PH - 1) % NPH;
        if constexpr (s == 0) phase_norm(P, l, 0, bid, G, wid, lane);
        else if constexpr (s == 1) { pg8::Gemm g{(const pg8::bf16_t*)(P.ws + WS_H), (const pg8::bf16_t*)(P.ws + WS_WIN) + (size_t)l * NIN * D, T, NIN, D};
            pg8::StaticOrder S; S.init(T, NIN, G, bid); pg8::EpiStoreBf16 E{(pg8::bf16_t*)(P.ws + WS_U), NIN};
            pg8::gemm_phase<pg8::EpiStoreBf16, pg8::StaticOrder, true, true>(lds, g, S, E, tid); }
        else if constexpr (s == 2) naive_kmean(P, bid, tid);
        else if constexpr (s == 3) {
#if NAIVE_ATTN
            for (int qi = bid * 8 + wid; qi < BATCH * 6 * SEQ; qi += G * 8) naive_attn_query(P, qi, lane);
#else
            if (G == 256) {
                for (int k = 0; k < 2; ++k) { const int u = k == 0 ? bid : 383 - bid;
                    if (k == 1 && bid >= 128) continue;
                    int t2 = tid; asm volatile("" : "+v"(t2));
                    attn_unit(P, (u % 48) / 6, (u % 48) % 6, 7 - u / 48, lds, t2, wid, t2 & 63); }
            } else for (int u = bid; u < 384; u += G) attn_unit(P, (u % 48) / 6, (u % 48) % 6, 7 - u / 48, lds, tid, wid, lane);
#endif
#if NAIVE_POOL
            for (int it = bid; it < T / 8; it += G) naive_pool(P, l, it, lds, tid);
#else
            for (int u = bid; u < T / 64; u += G) { int t2 = tid; asm volatile("" : "+v"(t2)); pool_unit(P, l, u, lds, t2, wid, t2 & 63); }
#endif
#if NAIVE_SSD
            for (int bh = bid; bh < BATCH * 6; bh += G) naive_ssd(P, l, bh, lds, tid);
#else
            for (int u = bid; u < 256; u += G) if (((u >> 1) & 15) != 15) { int t2 = tid; asm volatile("" : "+v"(t2)); ssd_unit_a(P, l, u >> 5, (u >> 1) & 15, u & 1, lds, t2, wid, t2 & 63); }
#endif
        }
        else if constexpr (s == 4) {
#if NAIVE_SSD
            naive_ssd_norm(P, l, bid, G, wid, lane);
#else
            for (int u = bid; u < 256; u += G) { int t2 = tid; asm volatile("" : "+v"(t2)); ssd_unit_b(P, l, u >> 5, (u >> 1) & 15, u & 1, lds, t2, wid, t2 & 63); }
#endif
        }
        else if constexpr (s == 5) { pg8::Gemm g{(const pg8::bf16_t*)(P.ws + WS_H), (const pg8::bf16_t*)(P.ws + WS_WOUT) + (size_t)l * D * D, T, D, D};
            pg8::StaticOrder S; S.init(T, D, G, bid); pg8::EpiResidual E{l == 0 ? P.in[I_X] : P.out, P.out, D};
            pg8::gemm_phase<pg8::EpiResidual, pg8::StaticOrder, true, true>(lds, g, S, E, tid); }
        else if constexpr (s == 6) phase_norm(P, l, 1, bid, G, wid, lane);
        else if constexpr (s == 7) { pg8::Gemm g{(const pg8::bf16_t*)(P.ws + WS_H), (const pg8::bf16_t*)(P.ws + WS_WGU) + (size_t)l * NGU * D, T, NGU, D};
            pg8::StaticOrder S; S.init(T, NGU, G, bid); pg8::EpiSwiGLU E{(pg8::bf16_t*)(P.ws + WS_U), FF};
            pg8::gemm_phase<pg8::EpiSwiGLU, pg8::StaticOrder, true, true>(lds, g, S, E, tid); }
        else { pg8::Gemm g{(const pg8::bf16_t*)(P.ws + WS_U), (const pg8::bf16_t*)(P.ws + WS_WD) + (size_t)l * D * FF, T, D, FF};
            pg8::StaticOrder S; S.init(T, D, G, bid); pg8::EpiResidual E{P.out, P.out, D};
            pg8::gemm_phase<pg8::EpiResidual, pg8::StaticOrder, true, true>(lds, g, S, E, tid); }
    }
}
template <int PH> __device__ __forceinline__ void run_all(const Params& P0, LAS unsigned char* lds, const int wid0, const int lo, const int hi) {
    if constexpr (PH < N_PHASES) {
        if (PH >= lo && PH < hi) { run_phase<PH>(P0, lds, wid0); if (PH + 1 < hi) grid_sync((unsigned*)(P0.ws + WS_CTL), (unsigned)(PH + 1 - lo) * gridDim.x, wid0); }
        run_all<PH + 1>(P0, lds, wid0, lo, hi);
    }
}
__global__ void __launch_bounds__(512, 2) mega(Params P0) {
    extern __shared__ __attribute__((aligned(16))) unsigned char lds_raw[];
    LAS unsigned char* lds = (LAS unsigned char*)lds_raw;
    const int wid0 = __builtin_amdgcn_readfirstlane(threadIdx.x >> 6);
    run_all<0>(P0, lds, wid0, P0.ph_lo, P0.ph_hi);
}

#ifndef ONE_LAUNCH
#define ONE_LAUNCH 1
#endif
extern "C" void kernel_launch(void* const* d_in, const int* in_sizes, int n_in, void* d_out, int out_size, void* d_ws, size_t ws_size, hipStream_t stream) {
    static int grid = 0;
    if (grid == 0) {
        if (n_in != 16 || out_size != T * D || ws_size < WS_END) { fprintf(stderr, "kernel_launch: unexpected shapes n_in %d out %d ws %zu\n", n_in, out_size, ws_size); grid = -1; return; }
        int dev = 0, cus = 0, per_cu = 0;
        hipGetDevice(&dev); hipDeviceGetAttribute(&cus, hipDeviceAttributeMultiprocessorCount, dev);
        if (hipFuncSetAttribute((const void*)mega, hipFuncAttributeMaxDynamicSharedMemorySize, LDS_BYTES) != hipSuccess) { fprintf(stderr, "kernel_launch: hipFuncSetAttribute failed\n"); grid = -1; return; }
        hipOccupancyMaxActiveBlocksPerMultiprocessor(&per_cu, (const void*)mega, 512, LDS_BYTES);
        if (per_cu < 1) { fprintf(stderr, "kernel_launch: occupancy query says %d\n", per_cu); per_cu = 1; }
        (void)hipGetLastError();
        grid = cus * per_cu;
    }
    if (grid < 0) return;
    if (hipMemsetAsync((char*)d_ws + WS_CTL, 0, 256, stream) != hipSuccess) { fprintf(stderr, "kernel_launch: memset failed\n"); return; }
    Params p{};
    for (int i = 0; i < 16; ++i) p.in[i] = (const float*)d_in[i];
    p.out = (float*)d_out; p.ws = (unsigned char*)d_ws;
#if ONE_LAUNCH
    p.ph_lo = 0; p.ph_hi = N_PHASES;
    void* args[] = {&p};
    hipError_t e = hipLaunchCooperativeKernel((const void*)mega, dim3(grid), dim3(512), args, LDS_BYTES, stream);
    if (e != hipSuccess) fprintf(stderr, "cooperative launch failed: %s (grid %d)\n", hipGetErrorString(e), grid);
#else
    for (int ph = 0; ph < N_PHASES; ++ph) { p.ph_lo = ph; p.ph_hi = ph + 1; hipLaunchKernelGGL(mega, dim3(grid), dim3(512), LDS_BYTES, stream, p); }
#endif
}
```

```cpp
#include <hip/hip_runtime.h>
#include <hip/hip_cooperative_groups.h>
#include <cstdio>
#include <cstdint>
namespace cg = cooperative_groups;
namespace pg8 {
#define PG8_LAS __attribute__((address_space(3)))
typedef unsigned short bf16_t;
typedef short bf16x8 __attribute__((ext_vector_type(8)));
typedef float f32x4 __attribute__((ext_vector_type(4)));
typedef unsigned u32x4 __attribute__((ext_vector_type(4)));
constexpr int BM = 256, BK = 64, HALF = 128, HTB = HALF * BK * 2  , STAGE_BYTES = 8 * HTB, NXCD = 8, WGM = 8;

__host__ __device__ __forceinline__ int lds_byte(int r, int c) { const int st = (r >> 4) * 2 + (c >> 5), rr = r & 15, cc = c & 31, ob = rr * 64 + cc * 2; return st * 1024 + (ob ^ (((ob >> 9) & 1) << 5)); }
__host__ __device__ __forceinline__ void stage_rc(int b, int& R, int& C) { const int st = b / 1024, sb = b % 1024, swz = sb ^ (((sb >> 9) & 1) << 5); R = (st >> 1) * 16 + swz / 64; C = (st & 1) * 32 + (swz % 64) / 2; }
__host__ __device__ __forceinline__ int perm32(int rho) { const int n = rho >> 4, i = rho & 15; return 8 * (i >> 2) + 4 * n + (i & 3); }

struct Unit { int pm, pn; };
struct Gemm { const bf16_t* A; const bf16_t* Bt; int M, N, K; };

struct StaticOrder {
    int nM, nN, nwg, G, c;
    __host__ __device__ void init(int M, int N, int G_, int c_) { nM = M / BM; nN = N / BM; nwg = nM * nN; G = G_; c = c_; }
    __host__ __device__ bool next(int i, Unit& u) const {
        const long L = (long)i * G + c; if (L >= nwg) return false;
        int wgid = (int)L; { const int q = nwg / NXCD, r = nwg % NXCD, xcd = wgid % NXCD, off = wgid / NXCD; wgid = (xcd < r ? xcd * (q + 1) : r * (q + 1) + (xcd - r) * q) + off; }
        const int nig = WGM * nN, gid = wgid / nig, fm = gid * WGM, gsz = (nM - fm) < WGM ? (nM - fm) : WGM;
        u.pm = fm + ((wgid % nig) % gsz); u.pn = (wgid % nig) / gsz; return true;
    }
    __device__ __forceinline__ void a_ready(const Unit&) const {}
    __device__ __forceinline__ void done(const Unit&) const {}
};

__device__ __forceinline__ unsigned cvt_pk_bf16(float lo, float hi) { unsigned r; asm volatile("v_cvt_pk_bf16_f32 %0, %1, %2" : "=v"(r) : "v"(lo), "v"(hi)); return r; }
struct EpiStoreBf16 {
    static constexpr bool PERM = true, AFTER_DRAIN = false;
    bf16_t* O; int ldc;
    __device__ __forceinline__ void operator()(const f32x4 (&acc)[2][2][4][2], const Unit& u, int wr, int wc, int fr, int fq) const {
        const int row0 = u.pm * BM + wr * 64 + fr; const int col0 = u.pn * BM + wc * 32 + 8 * fq;
#pragma unroll
        for (int ai = 0; ai < 2; ++ai)
#pragma unroll
            for (int m = 0; m < 4; ++m) { bf16_t* rowp = O + (size_t)(row0 + ai * HALF + m * 16) * ldc + col0;
#pragma unroll
                for (int bj = 0; bj < 2; ++bj) { const f32x4 v0 = acc[ai][bj][m][0], v1 = acc[ai][bj][m][1];
                    u32x4 w; w.x = cvt_pk_bf16(v0[0], v0[1]); w.y = cvt_pk_bf16(v0[2], v0[3]); w.z = cvt_pk_bf16(v1[0], v1[1]); w.w = cvt_pk_bf16(v1[2], v1[3]);
                    *(u32x4*)(rowp + bj * HALF) = w; } }
    }
};
struct EpiResidual {
    static constexpr bool PERM = true, AFTER_DRAIN = false;
    const float* R; float* X; int ld;
    __device__ __forceinline__ void operator()(const f32x4 (&acc)[2][2][4][2], const Unit& u, int wr, int wc, int fr, int fq) const {
        const int row0 = u.pm * BM + wr * 64 + fr; const int col0 = u.pn * BM + wc * 32 + 8 * fq;
#pragma unroll
        for (int ai = 0; ai < 2; ++ai)
#pragma unroll
            for (int m = 0; m < 4; ++m) { const size_t off = (size_t)(row0 + ai * HALF + m * 16) * ld + col0;
#pragma unroll
                for (int bj = 0; bj < 2; ++bj) {
                    const f32x4 r0 = *(const f32x4*)(R + off + bj * HALF), r1 = *(const f32x4*)(R + off + bj * HALF + 4);
                    *(f32x4*)(X + off + bj * HALF) = r0 + acc[ai][bj][m][0]; *(f32x4*)(X + off + bj * HALF + 4) = r1 + acc[ai][bj][m][1]; } __builtin_amdgcn_sched_barrier(0); }
    }
};
__device__ __forceinline__ float silu_f(float g) { return g * __builtin_amdgcn_rcpf(1.f + __expf(-g)); }
struct EpiSwiGLU {
    static constexpr bool PERM = true, AFTER_DRAIN = false;
    bf16_t* O; int ldc;
    __device__ __forceinline__ void operator()(const f32x4 (&acc)[2][2][4][2], const Unit& u, int wr, int wc, int fr, int fq) const {
        const int row0 = u.pm * BM + wr * 64 + fr; const int col0 = u.pn * HALF + wc * 32 + 8 * fq;
#pragma unroll
        for (int ai = 0; ai < 2; ++ai)
#pragma unroll
            for (int m = 0; m < 4; ++m) { bf16_t* rowp = O + (size_t)(row0 + ai * HALF + m * 16) * ldc + col0;
                const f32x4 g0 = acc[ai][0][m][0], g1 = acc[ai][0][m][1], u0 = acc[ai][1][m][0], u1 = acc[ai][1][m][1];
                u32x4 w; w.x = cvt_pk_bf16(silu_f(g0[0]) * u0[0], silu_f(g0[1]) * u0[1]); w.y = cvt_pk_bf16(silu_f(g0[2]) * u0[2], silu_f(g0[3]) * u0[3]);
                w.z = cvt_pk_bf16(silu_f(g1[0]) * u1[0], silu_f(g1[1]) * u1[1]); w.w = cvt_pk_bf16(silu_f(g1[2]) * u1[2], silu_f(g1[3]) * u1[3]);
                *(u32x4*)rowp = w; __builtin_amdgcn_sched_barrier(0); }
    }
};
template <class Epi, class Sched, bool ALIGN_EPI = false, bool SP2 = false>
__device__ __forceinline__ void gemm_phase(PG8_LAS unsigned char* lds, const Gemm g, const Sched& S, const Epi& E, const int tid) {
    const int wid = __builtin_amdgcn_readfirstlane(tid >> 6), lane = tid & 63, wr = wid >> 2, wc = wid & 3, fr = lane & 15, fq = lane >> 4;
    const int K = g.K, nt = K / BK;
    unsigned voffA[2], voffB[2];
#pragma unroll
    for (int i = 0; i < 2; ++i) { int R, C; stage_rc(tid * 16 + i * 8192, R, C); const int Rb = Epi::PERM ? ((R & ~31) + perm32(R & 31)) : R;
        voffA[i] = (unsigned)(R * K + C) * 2u; voffB[i] = (unsigned)(Rb * K + C) * 2u; }
    const size_t kstep = (size_t)(BK * 2);
    const size_t hstep = (size_t)HALF * K * 2;
    const size_t tstep = 2 * hstep;
    const unsigned ldsw = (unsigned)wid * 1024u;
    const int aoff = lds_byte(wr * 64 + fr, fq * 8), boff = lds_byte(wc * 32 + fr, fq * 8);
#define PG8_SA(b, h) (((b) * 2 + (h)) * HTB)
#define PG8_SB(b, h) ((4 + (b) * 2 + (h)) * HTB)
#define PG8_STAGE(bufoff, gbase, voff) do { _Pragma("unroll") for (int _i = 0; _i < 2; ++_i) \
        __builtin_amdgcn_global_load_lds((const unsigned*)((const char*)(gbase) + (voff)[_i]), (PG8_LAS unsigned*)(lds + (bufoff) + ldsw + _i * 8192), 16, 0, 0); } while (0)
#define PG8_LDA(dst, b, h) do { _Pragma("unroll") for (int m = 0; m < 4; ++m) _Pragma("unroll") for (int k = 0; k < 2; ++k) dst[m][k] = *(const PG8_LAS bf16x8*)(lds + PG8_SA(b, h) + aoff + m * 2048 + k * 1024); } while (0)
#define PG8_LDB(dst, b, h) do { _Pragma("unroll") for (int n = 0; n < 2; ++n) _Pragma("unroll") for (int k = 0; k < 2; ++k) dst[n][k] = *(const PG8_LAS bf16x8*)(lds + PG8_SB(b, h) + boff + n * 2048 + k * 1024); } while (0)
#define PG8_MMA(ai, bj, At, Bt) do { __builtin_amdgcn_s_setprio(1); _Pragma("unroll") for (int m = 0; m < 4; ++m) _Pragma("unroll") for (int n = 0; n < 2; ++n) _Pragma("unroll") for (int k = 0; k < 2; ++k) \
        acc[ai][bj][m][n] = __builtin_amdgcn_mfma_f32_16x16x32_bf16(Bt[n][k], At[m][k], acc[ai][bj][m][n], 0, 0, 0); __builtin_amdgcn_s_setprio(0); } while (0)
#define PG8_WAIT_V(n) asm volatile("s_waitcnt vmcnt(" #n ")" ::: "memory")
#define PG8_WAIT_L(n) asm volatile("s_waitcnt lgkmcnt(" #n ")" ::: "memory")
#define PG8_BAR __builtin_amdgcn_s_barrier()
#define PG8_SCHED __builtin_amdgcn_sched_barrier(0)
    Unit cur, nxt; int ui = 0;
    if (!S.next(0, cur)) return;
    f32x4 acc[2][2][4][2];
#pragma unroll
    for (int a = 0; a < 2; ++a)
#pragma unroll
        for (int b = 0; b < 2; ++b)
#pragma unroll
            for (int m = 0; m < 4; ++m)
#pragma unroll
                for (int n = 0; n < 2; ++n) acc[a][b][m][n] = (f32x4){0.f, 0.f, 0.f, 0.f};
    bf16x8 At[4][2], B0[2][2], B1[2][2];
    const char* cA = (const char*)g.A + (size_t)cur.pm * tstep; const char* cB = (const char*)g.Bt + (size_t)cur.pn * tstep;
    S.a_ready(cur);
    if constexpr (SP2) {
        PG8_STAGE(PG8_SB(0, 0), cB, voffB); PG8_STAGE(PG8_SB(0, 1), cB + hstep, voffB); PG8_STAGE(PG8_SA(0, 0), cA, voffA); PG8_STAGE(PG8_SA(0, 1), cA + hstep, voffA);
        if (wr == 1) PG8_BAR;
        PG8_WAIT_V(2); PG8_BAR;
        PG8_STAGE(PG8_SB(1, 0), cB + kstep, voffB); PG8_STAGE(PG8_SA(1, 0), cA + kstep, voffA); PG8_STAGE(PG8_SB(1, 1), cB + hstep + kstep, voffB);
        PG8_WAIT_V(6); PG8_BAR;
    } else {
        PG8_STAGE(PG8_SB(0, 0), cB, voffB); PG8_STAGE(PG8_SA(0, 0), cA, voffA); PG8_STAGE(PG8_SB(0, 1), cB + hstep, voffB); PG8_STAGE(PG8_SA(0, 1), cA + hstep, voffA);
        if (wr == 1) PG8_BAR;
        PG8_WAIT_V(4); PG8_BAR;
        PG8_STAGE(PG8_SB(1, 0), cB + kstep, voffB); PG8_STAGE(PG8_SA(1, 0), cA + kstep, voffA); PG8_STAGE(PG8_SB(1, 1), cB + hstep + kstep, voffB);
        PG8_WAIT_V(6); PG8_BAR;
    }
    for (;;) {
        const bool has_next = S.next(ui + 1, nxt);
        const char* nA = has_next ? (const char*)g.A + (size_t)nxt.pm * tstep : cA; const char* nB = has_next ? (const char*)g.Bt + (size_t)nxt.pn * tstep : cB;
        for (int t = 0; t < nt; t += 2) {
            const bool last = (t == nt - 2);
            const char* a1 = cA + (size_t)(t + 1) * kstep;
            const char* a2 = last ? nA : cA + (size_t)(t + 2) * kstep; const char* b2 = last ? nB : cB + (size_t)(t + 2) * kstep;
            const char* a3 = a2 + kstep; const char* b3 = b2 + kstep;
            if (last && has_next) S.a_ready(nxt);
            if constexpr (SP2) {
            PG8_LDB(B0, 0, 0); PG8_LDB(B1, 0, 1); PG8_SCHED; PG8_LDA(At, 0, 0); PG8_STAGE(PG8_SA(1, 1), a1 + hstep, voffA);
            PG8_WAIT_V(8); PG8_WAIT_L(0); PG8_BAR; PG8_MMA(0, 0, At, B0); PG8_MMA(0, 1, At, B1); PG8_BAR; PG8_SCHED;
            PG8_LDA(At, 0, 1); PG8_STAGE(PG8_SB(0, 0), b2, voffB); PG8_STAGE(PG8_SB(0, 1), b2 + hstep, voffB); PG8_STAGE(PG8_SA(0, 0), a2, voffA);
            PG8_WAIT_V(8); PG8_WAIT_L(0); PG8_BAR; PG8_MMA(1, 0, At, B0); PG8_MMA(1, 1, At, B1); PG8_BAR; PG8_SCHED;
            PG8_LDB(B0, 1, 0); PG8_LDB(B1, 1, 1); PG8_SCHED; PG8_LDA(At, 1, 0); PG8_STAGE(PG8_SA(0, 1), a2 + hstep, voffA);
            PG8_WAIT_V(8); PG8_WAIT_L(0); PG8_BAR; PG8_MMA(0, 0, At, B0); PG8_MMA(0, 1, At, B1); PG8_BAR; PG8_SCHED;
            PG8_LDA(At, 1, 1); PG8_STAGE(PG8_SB(1, 0), b3, voffB); PG8_STAGE(PG8_SB(1, 1), b3 + hstep, voffB); PG8_STAGE(PG8_SA(1, 0), a3, voffA);
            PG8_WAIT_V(8); PG8_WAIT_L(0); PG8_BAR; PG8_MMA(1, 0, At, B0); PG8_MMA(1, 1, At, B1); PG8_BAR; PG8_SCHED;
            } else {
            PG8_LDB(B0, 0, 0); PG8_SCHED; PG8_LDA(At, 0, 0); PG8_STAGE(PG8_SA(1, 1), a1 + hstep, voffA);
            PG8_WAIT_L(8); PG8_BAR; PG8_WAIT_L(0); PG8_MMA(0, 0, At, B0); PG8_BAR; PG8_SCHED;
            PG8_LDB(B1, 0, 1); PG8_STAGE(PG8_SB(0, 0), b2, voffB);
            PG8_BAR; PG8_WAIT_L(0); PG8_MMA(0, 1, At, B1); PG8_BAR;
            PG8_LDA(At, 0, 1); PG8_STAGE(PG8_SA(0, 0), a2, voffA);
            PG8_BAR; PG8_WAIT_L(0); PG8_MMA(1, 0, At, B0); PG8_BAR; PG8_SCHED;
            PG8_STAGE(PG8_SB(0, 1), b2 + hstep, voffB);
            PG8_WAIT_V(6); PG8_BAR; PG8_MMA(1, 1, At, B1); PG8_BAR;
            PG8_LDB(B0, 1, 0); PG8_SCHED; PG8_LDA(At, 1, 0); PG8_STAGE(PG8_SA(0, 1), a2 + hstep, voffA);
            PG8_WAIT_L(8); PG8_BAR; PG8_WAIT_L(0); PG8_MMA(0, 0, At, B0); PG8_BAR; PG8_SCHED;
            PG8_LDB(B1, 1, 1); PG8_STAGE(PG8_SB(1, 0), b3, voffB);
            PG8_BAR; PG8_WAIT_L(0); PG8_MMA(0, 1, At, B1); PG8_BAR;
            PG8_LDA(At, 1, 1); PG8_STAGE(PG8_SA(1, 0), a3, voffA);
            PG8_BAR; PG8_WAIT_L(0); PG8_MMA(1, 0, At, B0); PG8_BAR; PG8_SCHED;
            PG8_STAGE(PG8_SB(1, 1), b3 + hstep, voffB);
            PG8_WAIT_V(6); PG8_BAR; PG8_MMA(1, 1, At, B1); PG8_BAR;
            }
        }
        if constexpr (ALIGN_EPI) { if (wr == 0) PG8_BAR; }
        if constexpr (!Epi::AFTER_DRAIN) { E(acc, cur, wr, wc, fr, fq); S.done(cur); }
        if (!has_next) break;
#pragma unroll
        for (int a = 0; a < 2; ++a)
#pragma unroll
            for (int b = 0; b < 2; ++b)
#pragma unroll
                for (int m = 0; m < 4; ++m)
#pragma unroll
                    for (int n = 0; n < 2; ++n) acc[a][b][m][n] = (f32x4){0.f, 0.f, 0.f, 0.f};
        cur = nxt; cA = nA; cB = nB; ++ui;
        if constexpr (ALIGN_EPI) { if (wr == 1) PG8_BAR; }
    }
    PG8_WAIT_V(0);
    if constexpr (!ALIGN_EPI) { if (wr == 0) PG8_BAR; }
    PG8_BAR;
    if constexpr (Epi::AFTER_DRAIN) { E.fused(acc, cur, wr, wc, fr, fq, lds, wid, lane); S.done(cur); }
#undef PG8_SA
#undef PG8_SB
#undef PG8_STAGE
#undef PG8_LDA
#undef PG8_LDB
#undef PG8_MMA
#undef PG8_WAIT_V
#undef PG8_WAIT_L
#undef PG8_BAR
#undef PG8_SCHED
}
}

#define LAS __attribute__((address_space(3)))
typedef unsigned short bf16;
typedef unsigned v4u __attribute__((ext_vector_type(4)));
typedef unsigned v2u __attribute__((ext_vector_type(2)));
typedef float f32x4 __attribute__((ext_vector_type(4)));
constexpr int BATCH = 8, SEQ = 2048, T = BATCH * SEQ, D = 1024, DEPTH = 4;
constexpr int INW = 2694, NIN = 2816, FF = 2816, NGU = 5632;
constexpr int UQ = 0, UK = 384, UV = 768, UZ = 1152, UXS = 1536, UP = 2432;
constexpr int XBC = 896;
constexpr float EPS = 1e-6f;
constexpr size_t MiB = 1u << 20;
constexpr size_t WS_CTL = 0;
constexpr size_t WS_WIN = 1 * MiB, WS_WOUT = 23 * MiB, WS_WGU = 31 * MiB, WS_WD = 75 * MiB;
constexpr size_t WS_DTW = 97 * MiB, WS_PWT = WS_DTW + 128 * 1024, WS_KM = WS_DTW + 256 * 1024, WS_CD = WS_DTW + 512 * 1024;
constexpr size_t WS_DT = 98 * MiB, WS_H = 99 * MiB, WS_U = 131 * MiB, WS_ST = 219 * MiB, WS_END = 243 * MiB;
constexpr int LDS_BYTES = 147456;
#ifndef NAIVE_ATTN
#define NAIVE_ATTN 0
#endif
#ifndef NAIVE_SSD
#define NAIVE_SSD 0
#endif
#ifndef NAIVE_POOL
#define NAIVE_POOL 0
#endif
#ifndef DUP_S
#define DUP_S 0
#endif
#ifndef SYNC_REP
#define SYNC_REP 1
#endif
constexpr int NPH = 9;
constexpr int N_PHASES = 2 + DEPTH * NPH;

__device__ __forceinline__ float bf2f(unsigned short u) { return __builtin_bit_cast(float, (unsigned)u << 16); }
__device__ __forceinline__ unsigned f2bf(float f) { unsigned u = __builtin_bit_cast(unsigned, f); return (u + 0x7fffu + ((u >> 16) & 1u)) >> 16; }
__device__ __forceinline__ unsigned pk2(float lo, float hi) { return f2bf(lo) | (f2bf(hi) << 16); }
#define SWZ_XOR(v, m) __builtin_bit_cast(float, __builtin_amdgcn_ds_swizzle(__builtin_bit_cast(int, (v)), ((m) << 10) | 0x1f))
__device__ __forceinline__ float half_sum(float v) { v += SWZ_XOR(v, 1); v += SWZ_XOR(v, 2); v += SWZ_XOR(v, 4); v += SWZ_XOR(v, 8); v += SWZ_XOR(v, 16); return v; }
__device__ __forceinline__ float wave_sum(float v) {
    v = half_sum(v);
    return __builtin_bit_cast(float, __builtin_amdgcn_readlane(__builtin_bit_cast(int, v), 0)) + __builtin_bit_cast(float, __builtin_amdgcn_readlane(__builtin_bit_cast(int, v), 32));
}
__device__ __forceinline__ float wave_max(float v) {
    v = fmaxf(v, SWZ_XOR(v, 1)); v = fmaxf(v, SWZ_XOR(v, 2)); v = fmaxf(v, SWZ_XOR(v, 4)); v = fmaxf(v, SWZ_XOR(v, 8)); v = fmaxf(v, SWZ_XOR(v, 16));
    return fmaxf(__builtin_bit_cast(float, __builtin_amdgcn_readlane(__builtin_bit_cast(int, v), 0)), __builtin_bit_cast(float, __builtin_amdgcn_readlane(__builtin_bit_cast(int, v), 32)));
}
__device__ __forceinline__ float silu(float g) { return g / (1.f + __expf(-g)); }

struct Params { const float* in[16]; float* out; unsigned char* ws; int ph_lo, ph_hi; };
enum { I_X = 0, I_NMIX, I_WIN, I_CONVW, I_CONVB, I_DTB, I_ALOG, I_DSKIP, I_SSDN, I_POOLW, I_POOLS, I_WOUT, I_NFFN, I_WGU, I_WD, I_NFIN };

__device__ __forceinline__ void transpose_item(const float* W, int srcN, int c0, int k0, bf16* WT, int dstK, int n0, LAS float* scr, int lane) {
    if (c0 >= 0) {
#pragma unroll 8
        for (int i = 0; i < 32; ++i) { const int kk = 2 * i + (lane >> 5); scr[kk * 33 + (lane & 31)] = W[(size_t)(k0 + kk) * srcN + c0 + (lane & 31)]; }
    }
    asm volatile("s_waitcnt lgkmcnt(0)" ::: "memory");
    const int c = lane & 7;
#pragma unroll
    for (int j = 0; j < 4; ++j) { const int n = (lane >> 3) + 8 * j; const LAS float* s = scr + (8 * c) * 33 + n;
        v4u o = {0u, 0u, 0u, 0u};
        if (c0 >= 0) { o.x = pk2(s[0 * 33], s[1 * 33]); o.y = pk2(s[2 * 33], s[3 * 33]); o.z = pk2(s[4 * 33], s[5 * 33]); o.w = pk2(s[6 * 33], s[7 * 33]); }
        *(v4u*)(WT + (size_t)(n0 + n) * dstK + k0 + 8 * c) = o; }
    asm volatile("s_waitcnt lgkmcnt(0)" ::: "memory");
}
__device__ __forceinline__ void phase_prologue(const Params& P, LAS unsigned char* lds, int bid, int G, int tid, int wid, int lane) {
    LAS float* scr = (LAS float*)lds + wid * (64 * 33);
    const int gw = bid * 8 + wid, nw = G * 8;
    for (int it = gw; it < DEPTH * 6144; it += nw) {
        const int l = it / 6144; int r = it % 6144;
        if (r < 1408) { const int nb = r >> 4, kb = r & 15, n0 = nb * 32; const int c0 = n0 < 2432 ? n0 : (n0 < 2688 ? n0 + 6 : -1);
            transpose_item(P.in[I_WIN] + (size_t)l * D * INW, INW, c0, kb * 64, (bf16*)(P.ws + WS_WIN) + (size_t)l * NIN * D, D, n0, scr, lane); }
        else if (r < 1920) { r -= 1408; const int nb = r >> 4, kb = r & 15;
            transpose_item(P.in[I_WOUT] + (size_t)l * D * D, D, nb * 32, kb * 64, (bf16*)(P.ws + WS_WOUT) + (size_t)l * D * D, D, nb * 32, scr, lane); }
        else if (r < 4736) { r -= 1920; const int nb = r >> 4, kb = r & 15, n0 = nb * 32, pn = n0 >> 8, rr = n0 & 255; const int c0 = rr < 128 ? 128 * pn + rr : FF + 128 * pn + (rr - 128);
            transpose_item(P.in[I_WGU] + (size_t)l * D * NGU, NGU, c0, kb * 64, (bf16*)(P.ws + WS_WGU) + (size_t)l * NGU * D, D, n0, scr, lane); }
        else { r -= 4736; const int nb = r / 44, kb = r % 44;
            transpose_item(P.in[I_WD] + (size_t)l * FF * D, D, nb * 32, kb * 64, (bf16*)(P.ws + WS_WD) + (size_t)l * D * FF, FF, nb * 32, scr, lane); }
    }
    const int gt = bid * 512 + tid, nt = G * 512;
    float* dtw = (float*)(P.ws + WS_DTW);
    for (int i = gt; i < DEPTH * 8 * D; i += nt) { const int l = i / (8 * D), j = (i / D) & 7, k = i % D; dtw[i] = j < 6 ? P.in[I_WIN][((size_t)l * D + k) * INW + 2432 + j] : 0.f; }
    bf16* pwt = (bf16*)(P.ws + WS_PWT);
    for (int i = gt; i < DEPTH * 4 * 64 * 64; i += nt) { const int lg = i >> 12, d = (i >> 6) & 63, c = i & 63; pwt[i] = (bf16)f2bf(P.in[I_POOLW][(lg * 64 + c) * 64 + d]); }
}

__device__ __forceinline__ void phase_norm(const Params& P, int l, int mode, int bid, int G, int wid, int lane) {
    const float* X = (mode == 0 && l == 0) ? P.in[I_X] : P.out;
    const float* g = mode == 0 ? P.in[I_NMIX] + l * D : (mode == 1 ? P.in[I_NFFN] + l * D : P.in[I_NFIN]);
    bf16* H = (bf16*)(P.ws + WS_H);
    const float* dtw = (const float*)(P.ws + WS_DTW) + (size_t)l * 8 * D;
    float* DT = (float*)(P.ws + WS_DT);
    f32x4 gv[4];
#pragma unroll
    for (int j = 0; j < 4; ++j) gv[j] = *(const f32x4*)(g + 4 * lane + 256 * j);
    for (int row = bid * 8 + wid; row < T; row += G * 8) {
        const float* xr = X + (size_t)row * D + 4 * lane;
        f32x4 v[4]; float s = 0.f;
#pragma unroll
        for (int j = 0; j < 4; ++j) { v[j] = *(const f32x4*)(xr + 256 * j); s += (v[j].x * v[j].x + v[j].y * v[j].y) + (v[j].z * v[j].z + v[j].w * v[j].w); }
        const float rstd = rsqrtf(wave_sum(s) * (1.f / D) + EPS);
#pragma unroll
        for (int j = 0; j < 4; ++j) v[j] = (v[j] * rstd) * gv[j];
        if (mode == 2) {
#pragma unroll
            for (int j = 0; j < 4; ++j) *(f32x4*)(P.out + (size_t)row * D + 4 * lane + 256 * j) = v[j];
        } else {
            v2u* o8 = (v2u*)(H + (size_t)row * D + 4 * lane);
#pragma unroll
            for (int j = 0; j < 4; ++j) { v2u o; o.x = pk2(v[j].x, v[j].y); o.y = pk2(v[j].z, v[j].w); o8[64 * j] = o; }
            if (mode == 0) {
                float mine = 0.f;
#pragma unroll
                for (int q = 0; q < 6; ++q) { float a = 0.f;
#pragma unroll
                    for (int j = 0; j < 4; ++j) { const f32x4 w = *(const f32x4*)(dtw + q * D + 4 * lane + 256 * j); a += (v[j].x * w.x + v[j].y * w.y) + (v[j].z * w.z + v[j].w * w.w); }
                    a = wave_sum(a); if (lane == q) mine = a; }
                if (lane < 6) { const float z = mine + P.in[I_DTB][l * 6 + lane]; DT[(size_t)row * 8 + lane] = fmaxf(z, 0.f) + log1pf(__expf(-fabsf(z))); }
            }
        }
    }
}
__device__ __forceinline__ void naive_kmean(const Params& P, int bid, int tid) {
    const bf16* U = (const bf16*)(P.ws + WS_U); float* KM = (float*)(P.ws + WS_KM);
    const int i = bid * 512 + tid;
    if (i < BATCH * 6 * 8 * 64) { const int d = i & 63, j = (i >> 6) & 7, bh = i >> 9, b = bh / 6, h = bh % 6;
        float s = 0.f; for (int r = 0; r < 256; ++r) s += bf2f(U[(size_t)(b * SEQ + j * 256 + r) * NIN + UK + h * 64 + d]);
        KM[i] = s * (1.f / 256.f); }
}
__device__ __forceinline__ void naive_attn_query(const Params& P, int qi, int lane) {
    const bf16* U = (const bf16*)(P.ws + WS_U); const float* KM = (const float*)(P.ws + WS_KM); bf16* MIX = (bf16*)(P.ws + WS_H);
    const int t = qi & 2047, bh = qi >> 11, b = bh / 6, h = bh % 6, blk = t >> 8;
    float q[64];
    { const v4u* qp = (const v4u*)(U + (size_t)(b * SEQ + t) * NIN + UQ + h * 64);
#pragma unroll
      for (int c = 0; c < 8; ++c) { const v4u w = qp[c]; q[8*c] = bf2f(w.x & 0xffff); q[8*c+1] = bf2f(w.x >> 16); q[8*c+2] = bf2f(w.y & 0xffff); q[8*c+3] = bf2f(w.y >> 16);
          q[8*c+4] = bf2f(w.z & 0xffff); q[8*c+5] = bf2f(w.z >> 16); q[8*c+6] = bf2f(w.w & 0xffff); q[8*c+7] = bf2f(w.w >> 16); } }
    unsigned sel = 0;
    if (blk <= 3) sel = (1u << blk) - 1u;
    else {
        float gate[8];
        const float qd = bf2f(U[(size_t)(b * SEQ + t) * NIN + UQ + h * 64 + lane]);
#pragma unroll
        for (int j = 0; j < 8; ++j) { const float g = wave_sum(qd * KM[((size_t)bh * 8 + j) * 64 + lane]); gate[j] = j < blk ? g : -3e38f; }
#pragma unroll
        for (int r = 0; r < 3; ++r) { int best = 0; float bv = -3.4e38f;
#pragma unroll
            for (int j = 0; j < 8; ++j) { const bool ok = !((sel >> j) & 1u) && gate[j] > bv; bv = ok ? gate[j] : bv; best = ok ? j : best; }
            sel |= 1u << best; }
    }
#pragma unroll 1
    for (int dh = 0; dh < 2; ++dh) {
        float m = -1e30f, lsum = 0.f, o[32];
#pragma unroll
        for (int d = 0; d < 32; ++d) o[d] = 0.f;
        for (int jb = 0; jb <= blk; ++jb) {
            const bool own = jb == blk;
            if (!own && !((sel >> jb) & 1u)) continue;
            const int kend = own ? (t & 255) + 1 : 256;
            for (int kk = lane; kk < kend; kk += 64) {
                const v4u* kp = (const v4u*)(U + (size_t)(b * SEQ + jb * 256 + kk) * NIN + UK + h * 64);
                float s = 0.f;
#pragma unroll
                for (int c = 0; c < 8; ++c) { const v4u w = kp[c];
                    s += q[8*c] * bf2f(w.x & 0xffff) + q[8*c+1] * bf2f(w.x >> 16) + q[8*c+2] * bf2f(w.y & 0xffff) + q[8*c+3] * bf2f(w.y >> 16)
                       + q[8*c+4] * bf2f(w.z & 0xffff) + q[8*c+5] * bf2f(w.z >> 16) + q[8*c+6] * bf2f(w.w & 0xffff) + q[8*c+7] * bf2f(w.w >> 16); }
                s *= 0.125f;
                const float mn = fmaxf(m, s), a = __expf(m - mn), p = __expf(s - mn);
                lsum = lsum * a + p; m = mn;
                const v4u* vp = (const v4u*)((const bf16*)kp + 384 + dh * 32);
#pragma unroll
                for (int c = 0; c < 4; ++c) { const v4u w = vp[c];
                    o[8*c] = o[8*c] * a + p * bf2f(w.x & 0xffff); o[8*c+1] = o[8*c+1] * a + p * bf2f(w.x >> 16); o[8*c+2] = o[8*c+2] * a + p * bf2f(w.y & 0xffff); o[8*c+3] = o[8*c+3] * a + p * bf2f(w.y >> 16);
                    o[8*c+4] = o[8*c+4] * a + p * bf2f(w.z & 0xffff); o[8*c+5] = o[8*c+5] * a + p * bf2f(w.z >> 16); o[8*c+6] = o[8*c+6] * a + p * bf2f(w.w & 0xffff); o[8*c+7] = o[8*c+7] * a + p * bf2f(w.w >> 16); }
            }
        }
        const float M = wave_max(m), sc = __expf(m - M);
        const float L = wave_sum(lsum * sc);
        float outv = 0.f;
#pragma unroll
        for (int d = 0; d < 32; ++d) { const float s = wave_sum(o[d] * sc); outv = lane == d ? s : outv; }
        if (lane < 32) MIX[(size_t)(b * SEQ + t) * D + h * 64 + dh * 32 + lane] = (bf16)f2bf(outv / L);
    }
}
__device__ __forceinline__ void naive_ssd(const Params& P, int l, int bh, LAS unsigned char* lds, int tid) {
    const bf16* U = (const bf16*)(P.ws + WS_U); const float* DT = (const float*)(P.ws + WS_DT); float* YT = (float*)(P.ws + WS_ST);
    const int b = bh / 6, h = bh % 6, g = h / 3;
    LAS float* xs = (LAS float*)lds; LAS float* Bs = xs + 32 * 64; LAS float* Cs = Bs + 32 * 128; LAS float* dts = Cs + 32 * 128; LAS float* dAs = dts + 32;
    const float a = -__expf(P.in[I_ALOG][l * 6 + h]), Dk = P.in[I_DSKIP][l * 6 + h];
    const float* cw = P.in[I_CONVW] + (size_t)l * 4 * XBC; const float* cb = P.in[I_CONVB] + (size_t)l * XBC;
    const int p = tid >> 3, ns = (tid & 7) * 16;
    float hst[16];
#pragma unroll
    for (int i = 0; i < 16; ++i) hst[i] = 0.f;
    for (int t0 = 0; t0 < SEQ; t0 += 32) {
        __syncthreads();
        for (int idx = tid; idx < 32 * 320; idx += 512) {
            const int tt = idx / 320, c = idx % 320;
            const int ch = c < 64 ? h * 64 + c : (c < 192 ? 384 + g * 128 + (c - 64) : 640 + g * 128 + (c - 192));
            float acc = cb[ch];
#pragma unroll
            for (int k = 0; k < 4; ++k) { const int ts = t0 + tt - 3 + k; if (ts >= 0) acc += cw[k * XBC + ch] * bf2f(U[(size_t)(b * SEQ + ts) * NIN + UXS + ch]); }
            const float v = silu(acc);
            if (c < 64) xs[tt * 64 + c] = v; else if (c < 192) Bs[tt * 128 + c - 64] = v; else Cs[tt * 128 + c - 192] = v;
        }
        if (tid < 32) { const float dt = DT[(size_t)(b * SEQ + t0 + tid) * 8 + h]; dts[tid] = dt; dAs[tid] = __expf(dt * a); }
        __syncthreads();
        for (int tt = 0; tt < 32; ++tt) {
            const float xv = xs[tt * 64 + p], dA = dAs[tt], coef = dts[tt] * xv;
            float y = 0.f;
#pragma unroll
            for (int i = 0; i < 16; ++i) { hst[i] = hst[i] * dA + coef * Bs[tt * 128 + ns + i]; y += hst[i] * Cs[tt * 128 + ns + i]; }
            y += SWZ_XOR(y, 1); y += SWZ_XOR(y, 2); y += SWZ_XOR(y, 4);
            if ((tid & 7) == 0) { const size_t row = (size_t)(b * SEQ + t0 + tt);
                const float z = bf2f(U[row * NIN + UZ + h * 64 + p]);
                YT[row * 384 + h * 64 + p] = (y + Dk * xv) * silu(z); }
        }
    }
}
__device__ __forceinline__ void naive_ssd_norm(const Params& P, int l, int bid, int G, int wid, int lane) {
    const float* YT = (const float*)(P.ws + WS_ST); bf16* MIX = (bf16*)(P.ws + WS_H);
    for (int it = bid * 8 + wid; it < T * 2; it += G * 8) {
        const int row = it >> 1, g = it & 1;
        const float* y = YT + (size_t)row * 384 + g * 192;
        const float v0 = y[lane], v1 = y[lane + 64], v2 = y[lane + 128];
        const float r = rsqrtf(wave_sum(v0 * v0 + v1 * v1 + v2 * v2) * (1.f / 192.f) + EPS);
        const float* nw = P.in[I_SSDN] + l * 384 + g * 192;
        bf16* o = MIX + (size_t)row * D + 384 + g * 192;
        o[lane] = (bf16)f2bf(v0 * r * nw[lane]); o[lane + 64] = (bf16)f2bf(v1 * r * nw[lane + 64]); o[lane + 128] = (bf16)f2bf(v2 * r * nw[lane + 128]);
    }
}
__device__ __forceinline__ void naive_pool(const Params& P, int l, int item, LAS unsigned char* lds, int tid) {
    const bf16* U = (const bf16*)(P.ws + WS_U); bf16* MIX = (bf16*)(P.ws + WS_H);
    LAS float* diff = (LAS float*)lds;
    const int tok0 = item * 8;
    __syncthreads();
    for (int idx = tid; idx < 8 * 256; idx += 512) { const int tt = idx >> 8, c = idx & 255, g = c >> 6, W = 2 << g; const int row = tok0 + tt, pos = row & (SEQ - 1);
        const int cnt = pos + 1 < W ? pos + 1 : W; float s = 0.f;
        for (int i = 0; i < cnt; ++i) s += bf2f(U[(size_t)(row - i) * NIN + UP + c]);
        diff[idx] = s / (float)cnt - bf2f(U[(size_t)row * NIN + UP + c]); }
    __syncthreads();
    for (int idx = tid; idx < 8 * 256; idx += 512) { const int tt = idx >> 8, dc = idx & 255, g = dc >> 6, dd = dc & 63;
        const float* w = P.in[I_POOLW] + ((size_t)(l * 4 + g) * 64) * 64 + dd; float acc = 0.f;
        for (int c = 0; c < 64; ++c) acc += diff[tt * 256 + g * 64 + c] * w[c * 64];
        MIX[(size_t)(tok0 + tt) * D + 768 + dc] = (bf16)f2bf(acc * P.in[I_POOLS][l * 256 + dc]); }
}
typedef float f32x16 __attribute__((ext_vector_type(16)));
typedef short s16x8 __attribute__((ext_vector_type(8)));
typedef short s16x4 __attribute__((ext_vector_type(4)));
typedef short v4i16_t __attribute__((ext_vector_type(4)));
#define MFMA32(a, b, c) __builtin_amdgcn_mfma_f32_32x32x16_bf16((a), (b), (c), 0, 0, 0)
__device__ __forceinline__ s16x4 lds_tr(LAS const unsigned char* p) { return __builtin_bit_cast(s16x4, __builtin_amdgcn_ds_read_tr16_b64_v4i16((LAS v4i16_t*)p)); }
__device__ __forceinline__ float xhalf_sum(float v) { float a = v, b = v; asm volatile("s_nop 1\n\tv_permlane32_swap_b32 %0, %1" : "+v"(a), "+v"(b)); return a + b; }
__device__ __forceinline__ float xhalf_max(float v) { float a = v, b = v; asm volatile("s_nop 1\n\tv_permlane32_swap_b32 %0, %1" : "+v"(a), "+v"(b)); return fmaxf(a, b); }
constexpr int AT_KS = 144;
constexpr int AT_TILE = 64 * AT_KS;
constexpr int AT_K0 = 0, AT_V0 = 2 * AT_TILE, AT_KM = 4 * AT_TILE, AT_PART = AT_KM + 8 * 64 * 4;
__device__ __forceinline__ void attn_unit(const Params& P, int b, int h, int blk, LAS unsigned char* lds, int tid, int wid, int lane) {
    const bf16* U = (const bf16*)(P.ws + WS_U); bf16* MIX = (bf16*)(P.ws + WS_H);
    const int r = lane & 31, hh = lane >> 5;
    const size_t row0 = (size_t)b * SEQ;
    LAS float* KM = (LAS float*)(lds + AT_KM);
    __syncthreads();
    if (blk >= 4) {
        LAS float* part = (LAS float*)(lds + AT_PART);
        const int d2 = tid & 31, kg = tid >> 5;
        for (int j = 0; j < blk; ++j) {
            const unsigned* kp = (const unsigned*)(U + (row0 + j * 256 + kg * 16) * NIN + UK + h * 64) + d2;
            float s0 = 0.f, s1 = 0.f;
#pragma unroll
            for (int i = 0; i < 16; ++i) { const unsigned w = kp[(size_t)i * (NIN / 2)]; s0 += bf2f(w & 0xffff); s1 += bf2f(w >> 16); }
            part[(j * 16 + kg) * 64 + 2 * d2] = s0; part[(j * 16 + kg) * 64 + 2 * d2 + 1] = s1;
        }
        __syncthreads();
        if (tid < blk * 64) { const int j = tid >> 6, d = tid & 63; float s = 0.f;
#pragma unroll
            for (int k = 0; k < 16; ++k) s += part[(j * 16 + k) * 64 + d];
            KM[j * 64 + d] = s * (1.f / 256.f); }
        __syncthreads();
    }
    const int qrow = blk * 256 + wid * 32 + r;
    s16x8 qf[4];
    { const v4u* qp = (const v4u*)(U + (row0 + qrow) * NIN + UQ + h * 64 + 8 * hh);
#pragma unroll
      for (int s = 0; s < 4; ++s) qf[s] = __builtin_bit_cast(s16x8, qp[2 * s]); }
    unsigned sel = (1u << blk) - 1u;
    if (blk >= 4) {
        float gate[8];
#pragma unroll
        for (int j = 0; j < 8; ++j) gate[j] = -3e38f;
#pragma unroll
        for (int j = 0; j < 7; ++j) if (j < blk) { float g = 0.f;
#pragma unroll
            for (int s = 0; s < 4; ++s) {
                const f32x4 k0 = *(LAS const f32x4*)(KM + j * 64 + 16 * s + 8 * hh), k1 = *(LAS const f32x4*)(KM + j * 64 + 16 * s + 8 * hh + 4);
                g += bf2f((unsigned short)qf[s][0]) * k0.x + bf2f((unsigned short)qf[s][1]) * k0.y + bf2f((unsigned short)qf[s][2]) * k0.z + bf2f((unsigned short)qf[s][3]) * k0.w
                   + bf2f((unsigned short)qf[s][4]) * k1.x + bf2f((unsigned short)qf[s][5]) * k1.y + bf2f((unsigned short)qf[s][6]) * k1.z + bf2f((unsigned short)qf[s][7]) * k1.w; }
            gate[j] = xhalf_sum(g); }
        sel = 0u;
#pragma unroll
        for (int t = 0; t < 3; ++t) { int best = 0; float bv = -3.4e38f;
#pragma unroll
            for (int j = 0; j < 8; ++j) { const bool ok = !((sel >> j) & 1u) && gate[j] > bv; bv = ok ? gate[j] : bv; best = ok ? j : best; }
            sel |= 1u << best; }
    }
    const int ntiles = 4 + 4 * blk;
    const int ldrow = tid >> 3, ldch = tid & 7;
    const bf16* kvbase = U + (row0 + ldrow) * NIN + UK + h * 64 + ldch * 8;
    const int ldoff = ldrow * AT_KS + ldch * 16;
    auto tile_key0 = [&](int i) { return i < 4 ? blk * 256 + i * 64 : (i - 4) * 64; };
    v4u kreg, vreg;
    { const bf16* p0 = kvbase + (size_t)tile_key0(0) * NIN; kreg = *(const v4u*)p0; vreg = *(const v4u*)(p0 + 384); }
    *(LAS v4u*)(lds + AT_K0 + ldoff) = kreg; *(LAS v4u*)(lds + AT_V0 + ldoff) = vreg;
    __syncthreads();
    f32x16 o0, o1;
#pragma unroll
    for (int i = 0; i < 16; ++i) { o0[i] = 0.f; o1[i] = 0.f; }
    float m = -1e30f, lsum = 0.f;
    const float SC = 0.125f * 1.44269504088896f;
    const int i16 = lane & 15, b16 = (lane >> 4) & 1;
    const int troff = (i16 >> 2) * AT_KS + (16 * b16) * 2 + 8 * (i16 & 3);
    for (int i = 0; i < ntiles; ++i) {
        const int buf = i & 1;
        if (i + 1 < ntiles) { const bf16* p1 = kvbase + (size_t)tile_key0(i + 1) * NIN; kreg = *(const v4u*)p1; vreg = *(const v4u*)(p1 + 384); }
        bool need; int jpast = -1, kt = i;
        if (i < 4) need = (64 * i <= 32 * wid + 31);
        else { jpast = (i - 4) >> 2; need = __builtin_amdgcn_ballot_w64((sel >> jpast) & 1u) != 0ull; }
        if (need) {
            LAS const unsigned char* Kt = lds + AT_K0 + buf * AT_TILE; LAS const unsigned char* Vt = lds + AT_V0 + buf * AT_TILE;
            f32x16 sA, sB;
#pragma unroll
            for (int e = 0; e < 16; ++e) { sA[e] = 0.f; sB[e] = 0.f; }
#pragma unroll
            for (int s = 0; s < 4; ++s) {
                const s16x8 ka = *(LAS const s16x8*)(Kt + r * AT_KS + 32 * s + 16 * hh);
                const s16x8 kb = *(LAS const s16x8*)(Kt + (32 + r) * AT_KS + 32 * s + 16 * hh);
                sA = MFMA32(ka, qf[s], sA); sB = MFMA32(kb, qf[s], sB);
            }
            const bool lane_on = (i < 4) || ((sel >> jpast) & 1u);
            const int qpos = 32 * wid + r;
            float mx = -1e30f;
#pragma unroll
            for (int e = 0; e < 16; ++e) {
                const int kr = (e & 3) + 8 * (e >> 2) + 4 * hh;
                float a = sA[e] * SC, c = sB[e] * SC;
                if (i < 4) { if (64 * kt + kr > qpos) a = -1e30f; if (64 * kt + 32 + kr > qpos) c = -1e30f; }
                if (!lane_on) { a = -1e30f; c = -1e30f; }
                sA[e] = a; sB[e] = c; mx = fmaxf(mx, fmaxf(a, c));
            }
            mx = xhalf_max(mx);
            const float mn = fmaxf(m, mx), alpha = __builtin_amdgcn_exp2f(m - mn);
            m = mn;
            float ps = 0.f;
#pragma unroll
            for (int e = 0; e < 16; ++e) { sA[e] = __builtin_amdgcn_exp2f(sA[e] - mn); sB[e] = __builtin_amdgcn_exp2f(sB[e] - mn); ps += sA[e] + sB[e]; }
            lsum = lsum * alpha + ps;
#pragma unroll
            for (int e = 0; e < 16; ++e) { o0[e] *= alpha; o1[e] *= alpha; }
#pragma unroll
            for (int sub = 0; sub < 2; ++sub)
#pragma unroll
                for (int s2 = 0; s2 < 2; ++s2) {
                    s16x8 pb;
#pragma unroll
                    for (int jj = 0; jj < 8; jj += 2) { const float x0 = sub ? sB[8 * s2 + jj] : sA[8 * s2 + jj], x1 = sub ? sB[8 * s2 + jj + 1] : sA[8 * s2 + jj + 1];
                        const unsigned w = pk2(x0, x1); pb[jj] = (short)(w & 0xffff); pb[jj + 1] = (short)(w >> 16); }
                    const int klo = 32 * sub + 16 * s2 + 4 * hh;
#pragma unroll
                    for (int db = 0; db < 2; ++db) {
                        const s16x4 lo = lds_tr(Vt + klo * AT_KS + troff + 64 * db), hi = lds_tr(Vt + (klo + 8) * AT_KS + troff + 64 * db);
                        const s16x8 va = __builtin_shufflevector(lo, hi, 0, 1, 2, 3, 4, 5, 6, 7);
                        if (db == 0) o0 = MFMA32(va, pb, o0); else o1 = MFMA32(va, pb, o1);
                    }
                }
        }
        if (i + 1 < ntiles) { *(LAS v4u*)(lds + AT_K0 + (buf ^ 1) * AT_TILE + ldoff) = kreg; *(LAS v4u*)(lds + AT_V0 + (buf ^ 1) * AT_TILE + ldoff) = vreg; }
        __syncthreads();
    }
    const float inv = 1.f / xhalf_sum(lsum);
    bf16* orow = MIX + (row0 + qrow) * D + h * 64 + 4 * hh;
#pragma unroll
    for (int g = 0; g < 4; ++g) {
        v2u w0, w1;
        w0.x = pk2(o0[4 * g] * inv, o0[4 * g + 1] * inv); w0.y = pk2(o0[4 * g + 2] * inv, o0[4 * g + 3] * inv);
        w1.x = pk2(o1[4 * g] * inv, o1[4 * g + 1] * inv); w1.y = pk2(o1[4 * g + 2] * inv, o1[4 * g + 3] * inv);
        *(v2u*)(orow + 8 * g) = w0; *(v2u*)(orow + 32 + 8 * g) = w1;
    }
}
constexpr int SX_S = 400, SB_S = 272;
constexpr int S_X = 0, S_B = 51200, S_C = 86016, S_PREV = 120832, S_DT = 138240, S_AC = S_DT + 1536, S_DA = S_AC + 1536;
__device__ __forceinline__ int crow16(int i, int hh) { return (i & 3) + 8 * (i >> 2) + 4 * hh; }
template <bool PHASE_A>
__device__ __forceinline__ void ssd_stage(const Params& P, int l, int b, int c, int g, LAS unsigned char* lds, int tid) {
    const bf16* U = (const bf16*)(P.ws + WS_U); const float* DT = (const float*)(P.ws + WS_DT);
    const float* alog = P.in[I_ALOG]; const float* convw = P.in[I_CONVW]; const float* convb = P.in[I_CONVB];
    asm volatile("" : "+s"(alog), "+s"(convw), "+s"(convb));
    const size_t row0 = (size_t)b * SEQ + c * 128;
    LAS float* dts = (LAS float*)(lds + S_DT); LAS float* acs = (LAS float*)(lds + S_AC); LAS float* das = (LAS float*)(lds + S_DA);
    if (tid < 384) { const int hh3 = tid >> 7, li = tid & 127, h = 3 * g + hh3; const float dt = DT[(row0 + li) * 8 + h]; dts[tid] = dt; das[tid] = dt * -__expf(alog[l * 6 + h]); }
    __syncthreads();
    if (tid < 384) { const int hh3 = tid >> 7, li = tid & 127; float s = 0.f; for (int i = 0; i <= li; ++i) s += das[hh3 * 128 + i]; acs[tid] = s; }
    __syncthreads();
    const int cc = tid & 63, tg = tid >> 6;
    if (cc < (PHASE_A ? 40 : 56)) {
        const int ch = cc < 24 ? g * 192 + cc * 8 : (cc < 40 ? 384 + g * 128 + (cc - 24) * 8 : 640 + g * 128 + (cc - 40) * 8);
        const float* cw = convw + (size_t)l * 4 * XBC + ch; const float* cb = convb + (size_t)l * XBC + ch;
        float w[4][8], bias[8], xw[3][8];
#pragma unroll
        for (int k = 0; k < 4; ++k) { const f32x4 a = *(const f32x4*)(cw + k * XBC), d = *(const f32x4*)(cw + k * XBC + 4);
            w[k][0] = a.x; w[k][1] = a.y; w[k][2] = a.z; w[k][3] = a.w; w[k][4] = d.x; w[k][5] = d.y; w[k][6] = d.z; w[k][7] = d.w; }
        { const f32x4 a = *(const f32x4*)cb, d = *(const f32x4*)(cb + 4); bias[0] = a.x; bias[1] = a.y; bias[2] = a.z; bias[3] = a.w; bias[4] = d.x; bias[5] = d.y; bias[6] = d.z; bias[7] = d.w; }
        const bf16* src = U + (row0 + tg * 16) * NIN + UXS + ch;
        const bool has_prev = !(c == 0 && tg == 0);
#pragma unroll
        for (int k = 0; k < 3; ++k) { v4u q = {0u, 0u, 0u, 0u}; if (has_prev) q = *(const v4u*)(src - (size_t)(3 - k) * NIN);
            xw[k][0] = bf2f(q.x & 0xffff); xw[k][1] = bf2f(q.x >> 16); xw[k][2] = bf2f(q.y & 0xffff); xw[k][3] = bf2f(q.y >> 16);
            xw[k][4] = bf2f(q.z & 0xffff); xw[k][5] = bf2f(q.z >> 16); xw[k][6] = bf2f(q.w & 0xffff); xw[k][7] = bf2f(q.w >> 16); }
        const int hh3 = cc >> 3;
        const float ac_end = acs[(cc < 24 ? hh3 : 0) * 128 + 127];
        LAS unsigned char* dst = lds + (cc < 24 ? S_X + cc * 16 : (cc < 40 ? S_B + (cc - 24) * 16 : S_C + (cc - 40) * 16));
        const int dstride = cc < 24 ? SX_S : SB_S;
#pragma unroll 1
        for (int t = 0; t < 16; ++t) {
            const v4u q = *(const v4u*)(src + (size_t)t * NIN);
            float cur[8] = {bf2f(q.x & 0xffff), bf2f(q.x >> 16), bf2f(q.y & 0xffff), bf2f(q.y >> 16), bf2f(q.z & 0xffff), bf2f(q.z >> 16), bf2f(q.w & 0xffff), bf2f(q.w >> 16)};
            const int tok = tg * 16 + t;
            float sc = 1.f;
            if (PHASE_A && cc < 24) sc = dts[hh3 * 128 + tok] * __expf(ac_end - acs[hh3 * 128 + tok]);
            float o[8];
#pragma unroll
            for (int j = 0; j < 8; ++j) { const float a = bias[j] + w[0][j] * xw[0][j] + w[1][j] * xw[1][j] + w[2][j] * xw[2][j] + w[3][j] * cur[j]; o[j] = silu(a) * sc;
                xw[0][j] = xw[1][j]; xw[1][j] = xw[2][j]; xw[2][j] = cur[j]; }
            v4u pk; pk.x = pk2(o[0], o[1]); pk.y = pk2(o[2], o[3]); pk.z = pk2(o[4], o[5]); pk.w = pk2(o[6], o[7]);
            *(LAS v4u*)(dst + tok * dstride) = pk;
        }
    }
    __syncthreads();
}
__device__ __forceinline__ void ssd_unit_a(const Params& P, int l, int b, int c, int g, LAS unsigned char* lds, int tid, int wid, int lane) {
    __syncthreads();
    ssd_stage<true>(P, l, b, c, g, lds, tid);
    LAS float* acs = (LAS float*)(lds + S_AC);
    if (tid < 3) ((float*)(P.ws + WS_CD))[(b * 16 + c) * 6 + 3 * g + tid] = __expf(acs[tid * 128 + 127]);
    const int r = lane & 31, hh = lane >> 5, nt = wid & 3, pt = wid >> 2, i16 = lane & 15, b16 = (lane >> 4) & 1;
    const int troffB = (i16 >> 2) * SB_S + (32 * nt + 16 * b16) * 2 + 8 * (i16 & 3);
    s16x8 bfr[8];
#pragma unroll
    for (int s = 0; s < 8; ++s) { const int k0 = 16 * s + 8 * hh;
        const s16x4 lo = lds_tr(lds + S_B + k0 * SB_S + troffB), hi = lds_tr(lds + S_B + (k0 + 4) * SB_S + troffB);
        bfr[s] = __builtin_shufflevector(lo, hi, 0, 1, 2, 3, 4, 5, 6, 7); }
    float* ST = (float*)(P.ws + WS_ST);
#pragma unroll
    for (int hh3 = 0; hh3 < 3; ++hh3) {
        const int troffX = (i16 >> 2) * SX_S + (hh3 * 64 + 32 * pt + 16 * b16) * 2 + 8 * (i16 & 3);
        f32x16 acc;
#pragma unroll
        for (int e = 0; e < 16; ++e) acc[e] = 0.f;
#pragma unroll
        for (int s = 0; s < 8; ++s) { const int k0 = 16 * s + 8 * hh;
            const s16x4 lo = lds_tr(lds + S_X + k0 * SX_S + troffX), hi = lds_tr(lds + S_X + (k0 + 4) * SX_S + troffX);
            const s16x8 xa = __builtin_shufflevector(lo, hi, 0, 1, 2, 3, 4, 5, 6, 7);
            acc = MFMA32(xa, bfr[s], acc); }
        float* S = ST + ((size_t)((b * 16 + c) * 6 + 3 * g + hh3)) * 8192;
#pragma unroll
        for (int e = 0; e < 16; ++e) S[(32 * pt + crow16(e, hh)) * 128 + 32 * nt + r] = acc[e];
    }
}
__device__ __forceinline__ void ssd_unit_b(const Params& P, int l, int b, int c, int g, LAS unsigned char* lds, int tid, int wid, int lane) {
    const float* dskip = P.in[I_DSKIP]; const float* ssdn = P.in[I_SSDN];
    asm volatile("" : "+s"(dskip), "+s"(ssdn));
    __syncthreads();
    ssd_stage<false>(P, l, b, c, g, lds, tid);
    const bf16* U = (const bf16*)(P.ws + WS_U); bf16* MIX = (bf16*)(P.ws + WS_H);
    const float* ST = (const float*)(P.ws + WS_ST); const float* CD = (const float*)(P.ws + WS_CD);
    LAS float* dts = (LAS float*)(lds + S_DT); LAS float* acs = (LAS float*)(lds + S_AC); LAS float* ssb = (LAS float*)(lds + S_DA);
    const size_t row0 = (size_t)b * SEQ + c * 128;
    const int r = lane & 31, hh = lane >> 5, lt = wid & 3, pb = wid >> 2, i16 = lane & 15, b16 = (lane >> 4) & 1;
#define CF(s) (*(LAS const s16x8*)(lds + S_C + (32 * lt + r) * SB_S + (16 * (s) + 8 * hh) * 2))
    f32x16 Y[3];
#pragma unroll
    for (int hh3 = 0; hh3 < 3; ++hh3) {
        const int h = 3 * g + hh3;
        __syncthreads();
        { f32x4 a0 = {0.f, 0.f, 0.f, 0.f}, a1 = a0, a2 = a0, a3 = a0;
          for (int cp = 0; cp < c; ++cp) { const float d = CD[(b * 16 + cp) * 6 + h]; const float* S = ST + ((size_t)((b * 16 + cp) * 6 + h)) * 8192 + tid * 4;
              a0 = a0 * d + *(const f32x4*)S; a1 = a1 * d + *(const f32x4*)(S + 2048); a2 = a2 * d + *(const f32x4*)(S + 4096); a3 = a3 * d + *(const f32x4*)(S + 6144); }
          const int p = tid >> 5, n = (tid & 31) * 4;
          v2u w; w.x = pk2(a0.x, a0.y); w.y = pk2(a0.z, a0.w); *(LAS v2u*)(lds + S_PREV + p * SB_S + n * 2) = w;
          w.x = pk2(a1.x, a1.y); w.y = pk2(a1.z, a1.w); *(LAS v2u*)(lds + S_PREV + (p + 16) * SB_S + n * 2) = w;
          w.x = pk2(a2.x, a2.y); w.y = pk2(a2.z, a2.w); *(LAS v2u*)(lds + S_PREV + (p + 32) * SB_S + n * 2) = w;
          w.x = pk2(a3.x, a3.y); w.y = pk2(a3.z, a3.w); *(LAS v2u*)(lds + S_PREV + (p + 48) * SB_S + n * 2) = w; }
        __syncthreads();
        f32x16 acc;
#pragma unroll
        for (int e = 0; e < 16; ++e) acc[e] = 0.f;
#pragma unroll
        for (int s = 0; s < 8; ++s) { const s16x8 a = *(LAS const s16x8*)(lds + S_PREV + (32 * pb + r) * SB_S + (16 * s + 8 * hh) * 2); acc = MFMA32(a, CF(s), acc); }
        const float el = __expf(acs[hh3 * 128 + 32 * lt + r]);
#pragma unroll
        for (int e = 0; e < 16; ++e) Y[hh3][e] = acc[e] * el;
    }
    for (int st = 0; st <= lt; ++st) {
        f32x16 Gt;
#pragma unroll
        for (int e = 0; e < 16; ++e) Gt[e] = 0.f;
#pragma unroll
        for (int s = 0; s < 8; ++s) { const s16x8 a = *(LAS const s16x8*)(lds + S_B + (32 * st + r) * SB_S + (16 * s + 8 * hh) * 2); Gt = MFMA32(a, CF(s), Gt); }
#pragma unroll
        for (int hh3 = 0; hh3 < 3; ++hh3) {
            const float acl = acs[hh3 * 128 + 32 * lt + r];
            const int troffX = (i16 >> 2) * SX_S + (hh3 * 64 + 32 * pb + 16 * b16) * 2 + 8 * (i16 & 3);
#pragma unroll
            for (int s2 = 0; s2 < 2; ++s2) {
                s16x8 pbk;
#pragma unroll
                for (int jj = 0; jj < 8; jj += 2) {
                    float mv[2];
#pragma unroll
                    for (int t = 0; t < 2; ++t) { const int e = 8 * s2 + jj + t, kr = crow16(e, hh), stok = 32 * st + kr;
                        const bool valid = (st < lt) || (kr <= r);
                        const float v = Gt[e] * __expf(fminf(acl - acs[hh3 * 128 + stok], 0.f)) * dts[hh3 * 128 + stok];
                        mv[t] = valid ? v : 0.f; }
                    const unsigned w = pk2(mv[0], mv[1]); pbk[jj] = (short)(w & 0xffff); pbk[jj + 1] = (short)(w >> 16); }
                const int klo = 32 * st + 16 * s2 + 4 * hh;
                const s16x4 lo = lds_tr(lds + S_X + klo * SX_S + troffX), hi = lds_tr(lds + S_X + (klo + 8) * SX_S + troffX);
                const s16x8 xa = __builtin_shufflevector(lo, hi, 0, 1, 2, 3, 4, 5, 6, 7);
                Y[hh3] = MFMA32(xa, pbk, Y[hh3]);
                __builtin_amdgcn_sched_barrier(0);
            }
        }
    }
    float ssq = 0.f;
    const size_t grow = row0 + 32 * lt + r;
#pragma unroll
    for (int hh3 = 0; hh3 < 3; ++hh3) { const int h = 3 * g + hh3; const float Dk = dskip[l * 6 + h];
#pragma unroll
        for (int q4 = 0; q4 < 4; ++q4) { const int p0 = 32 * pb + 8 * q4 + 4 * hh;
            const v2u xr = *(LAS const v2u*)(lds + S_X + (32 * lt + r) * SX_S + (hh3 * 64 + p0) * 2);
            const v2u zr = *(const v2u*)(U + grow * NIN + UZ + h * 64 + p0);
            const f32x4 xv = {bf2f(xr.x & 0xffff), bf2f(xr.x >> 16), bf2f(xr.y & 0xffff), bf2f(xr.y >> 16)};
            const f32x4 zv = {bf2f(zr.x & 0xffff), bf2f(zr.x >> 16), bf2f(zr.y & 0xffff), bf2f(zr.y >> 16)};
#pragma unroll
            for (int e = 0; e < 4; ++e) { const float y = (Y[hh3][4 * q4 + e] + Dk * xv[e]) * silu(zv[e]); Y[hh3][4 * q4 + e] = y; ssq += y * y; } } }
    ssq = xhalf_sum(ssq);
    if (hh == 0) ssb[pb * 128 + 32 * lt + r] = ssq;
    __syncthreads();
    const float rs = rsqrtf((ssb[32 * lt + r] + ssb[128 + 32 * lt + r]) * (1.f / 192.f) + EPS);
#pragma unroll
    for (int hh3 = 0; hh3 < 3; ++hh3)
#pragma unroll
        for (int q4 = 0; q4 < 4; ++q4) { const int p0 = 32 * pb + 8 * q4 + 4 * hh, chn = g * 192 + hh3 * 64 + p0;
            const f32x4 nw = *(const f32x4*)(ssdn + l * 384 + chn);
            v2u w; w.x = pk2(Y[hh3][4 * q4] * rs * nw.x, Y[hh3][4 * q4 + 1] * rs * nw.y); w.y = pk2(Y[hh3][4 * q4 + 2] * rs * nw.z, Y[hh3][4 * q4 + 3] * rs * nw.w);
            *(v2u*)(MIX + grow * D + 384 + chn) = w; }
}
constexpr int PL_S = 528;
__device__ __forceinline__ void pool_unit(const Params& P, int l, int unit, LAS unsigned char* lds, int tid, int wid, int lane) {
    const bf16* U = (const bf16*)(P.ws + WS_U); bf16* MIX = (bf16*)(P.ws + WS_H);
    const bf16* pwt = (const bf16*)(P.ws + WS_PWT) + (size_t)l * 4 * 4096;
    const float* pscale = P.in[I_POOLS]; asm volatile("" : "+s"(pscale));
    const size_t row0 = (size_t)unit * 64;
    __syncthreads();
    { const int cc = tid & 31, ts = tid >> 5, g = cc >> 3, W = 2 << g;
      const bf16* src = U + row0 * NIN + UP + cc * 8;
      f32x4 s0 = {0.f, 0.f, 0.f, 0.f}, s1 = s0;
      const int t0 = ts * 4, pos0 = (int)((row0 + t0) & (SEQ - 1));
      for (int i = 1; i < W; ++i) if (i <= pos0) { const v4u q = *(const v4u*)(src + (ptrdiff_t)(t0 - i) * NIN);
          s0.x += bf2f(q.x & 0xffff); s0.y += bf2f(q.x >> 16); s0.z += bf2f(q.y & 0xffff); s0.w += bf2f(q.y >> 16);
          s1.x += bf2f(q.z & 0xffff); s1.y += bf2f(q.z >> 16); s1.z += bf2f(q.w & 0xffff); s1.w += bf2f(q.w >> 16); }
#pragma unroll
      for (int t = 0; t < 4; ++t) {
          const int tok = t0 + t, pos = pos0 + t;
          const v4u q = *(const v4u*)(src + (size_t)tok * NIN);
          const f32x4 x0 = {bf2f(q.x & 0xffff), bf2f(q.x >> 16), bf2f(q.y & 0xffff), bf2f(q.y >> 16)}, x1 = {bf2f(q.z & 0xffff), bf2f(q.z >> 16), bf2f(q.w & 0xffff), bf2f(q.w >> 16)};
          s0 += x0; s1 += x1;
          if (t > 0 && pos - W >= 0) { const v4u o = *(const v4u*)(src + (ptrdiff_t)(tok - W) * NIN);
              const f32x4 y0 = {bf2f(o.x & 0xffff), bf2f(o.x >> 16), bf2f(o.y & 0xffff), bf2f(o.y >> 16)}, y1 = {bf2f(o.z & 0xffff), bf2f(o.z >> 16), bf2f(o.w & 0xffff), bf2f(o.w >> 16)};
              s0 -= y0; s1 -= y1; }
          const float inv = 1.f / (float)(pos + 1 < W ? pos + 1 : W);
          const f32x4 d0 = s0 * inv - x0, d1 = s1 * inv - x1;
          v4u pk; pk.x = pk2(d0.x, d0.y); pk.y = pk2(d0.z, d0.w); pk.z = pk2(d1.x, d1.y); pk.w = pk2(d1.z, d1.w);
          *(LAS v4u*)(lds + tok * PL_S + cc * 16) = pk;
      } }
    __syncthreads();
    const int r = lane & 31, hh = lane >> 5, g = wid >> 1, dt = wid & 1;
    s16x8 wa[4];
#pragma unroll
    for (int s = 0; s < 4; ++s) wa[s] = __builtin_bit_cast(s16x8, *(const v4u*)(pwt + (size_t)g * 4096 + (32 * dt + r) * 64 + 16 * s + 8 * hh));
#pragma unroll
    for (int tt = 0; tt < 2; ++tt) {
        f32x16 acc;
#pragma unroll
        for (int e = 0; e < 16; ++e) acc[e] = 0.f;
#pragma unroll
        for (int s = 0; s < 4; ++s) { const s16x8 bq = *(LAS const s16x8*)(lds + (32 * tt + r) * PL_S + (g * 64 + 16 * s + 8 * hh) * 2); acc = MFMA32(wa[s], bq, acc); }
        bf16* orow = MIX + (row0 + 32 * tt + r) * D + 768 + g * 64 + 32 * dt + 4 * hh;
#pragma unroll
        for (int q4 = 0; q4 < 4; ++q4) { const f32x4 sc = *(const f32x4*)(pscale + l * 256 + g * 64 + 32 * dt + 4 * hh + 8 * q4);
            v2u w; w.x = pk2(acc[4 * q4] * sc.x, acc[4 * q4 + 1] * sc.y); w.y = pk2(acc[4 * q4 + 2] * sc.z, acc[4 * q4 + 3] * sc.w);
            *(v2u*)(orow + 8 * q4) = w; }
    }
}
#define XB_TMO      128
#define XB_XCNT(j)  (256  + 64 * (j))
#define XB_XSUB(j)  (1280 + 64 * (j))
#define XB_XGEN(j)  (2304 + 64 * (j))
#define XB_TOP      3328
#define XB_TOPGEN   3392
#define XCD_BAR_WORDS 3456
#define XB_SPIN_CAP (1u << 18)

__device__ __forceinline__ unsigned xb_ld(unsigned* p)              { return __hip_atomic_load(p, __ATOMIC_RELAXED, __HIP_MEMORY_SCOPE_AGENT); }
__device__ __forceinline__ unsigned xb_add(unsigned* p, unsigned v) { return __hip_atomic_fetch_add(p, v, __ATOMIC_RELAXED, __HIP_MEMORY_SCOPE_AGENT); }
__device__ __forceinline__ unsigned xb_xcc_id() { return (unsigned)__builtin_amdgcn_s_getreg((3 << 11) | 20) & 0xFu; }
#define XB_SPIN(cond, bar) do { unsigned _sp = 0; while (cond) { __builtin_amdgcn_s_sleep(1); \
    if ((++_sp & 255u) == 0u) { if (xb_ld(&(bar)[XB_TMO])) break; if (_sp > XB_SPIN_CAP) { atomicAdd(&(bar)[XB_TMO], 1u); break; } } } } while (0)

struct XcdBarrier {
    unsigned* bar; unsigned x;
    volatile LAS unsigned* st;
};

__device__ __forceinline__ XcdBarrier xcd_barrier_post(unsigned* bar, volatile LAS unsigned* st, const bool leader) {
    XcdBarrier b; b.bar = bar; b.x = xb_xcc_id(); b.st = st;
    if (leader) (void)xb_add(&bar[XB_XCNT(b.x)], 1u);
    return b;
}
__device__ __forceinline__ void xcd_barrier_complete(unsigned* bar, unsigned x, unsigned& nloc, unsigned& nx) {
    const unsigned G = gridDim.x * gridDim.y * gridDim.z;
    unsigned sum, cnt, mine, sp = 0u;
    for (;;) {
        sum = 0u; cnt = 0u; mine = 0u;
#pragma unroll
        for (unsigned j = 0; j < 16; ++j) { const unsigned c = xb_ld(&bar[XB_XCNT(j)]); sum += c; cnt += (c > 0u) ? 1u : 0u; mine = (j == x) ? c : mine; }
        if (sum == G) break;
        __builtin_amdgcn_s_sleep(1);
        if ((++sp & 255u) == 0u) { if (xb_ld(&bar[XB_TMO])) break; if (sp > XB_SPIN_CAP) { atomicAdd(&bar[XB_TMO], 1u); break; } }
    }
    nloc = mine > 0u ? mine : 1u; nx = cnt > 0u ? cnt : 1u;
}

__device__ __forceinline__ void xcd_barrier(const XcdBarrier& b, const bool leader) {
    asm volatile("s_waitcnt vmcnt(0)" ::: "memory");
    __syncthreads();
    if (leader) {
        unsigned* bar = b.bar;
        __builtin_amdgcn_s_waitcnt(0);
        unsigned nloc = b.st[0], nx = b.st[1];
        if (nloc == 0u) { xcd_barrier_complete(bar, b.x, nloc, nx); b.st[0] = nloc; b.st[1] = nx; }
        const unsigned old = xb_add(&bar[XB_XSUB(b.x)], 1u);
        const unsigned gen = old / nloc;
        if (old + 1u == (gen + 1u) * nloc) {
            __builtin_amdgcn_fence(__ATOMIC_RELEASE, "agent");
            asm volatile("s_waitcnt vmcnt(0)" ::: "memory");
            const unsigned og = xb_add(&bar[XB_TOP], 1u);
            const unsigned tg = og / nx;
            if (og + 1u == (tg + 1u) * nx) xb_add(&bar[XB_TOPGEN], 1u);
            else XB_SPIN(xb_ld(&bar[XB_TOPGEN]) == tg, bar);
            __builtin_amdgcn_fence(__ATOMIC_ACQUIRE, "agent");
            xb_add(&bar[XB_XGEN(b.x)], 1u);
            asm volatile("s_waitcnt vmcnt(0)" ::: "memory");
        } else {
            XB_SPIN(xb_ld(&bar[XB_XGEN(b.x)]) == gen, bar);
            __builtin_amdgcn_fence(__ATOMIC_ACQUIRE, "agent");
            asm volatile("s_waitcnt vmcnt(0)" ::: "memory");
        }
    }
    __syncthreads();
}
constexpr int BAR_LDS_OFF = LDS_BYTES - 16;
constexpr size_t WS_BAR = 65536;
__device__ __forceinline__ bool is_leader(int wid0) { int lane; asm volatile("v_mbcnt_lo_u32_b32 %0, -1, 0\n\tv_mbcnt_hi_u32_b32 %0, -1, %0" : "=v"(lane)); return wid0 == 0 && lane == 0; }
__device__ __forceinline__ void grid_sync(unsigned char* ws, LAS unsigned char* lds, int wid0) {
    XcdBarrier b; b.bar = (unsigned*)(ws + WS_BAR); b.x = xb_xcc_id(); b.st = (volatile LAS unsigned*)(lds + BAR_LDS_OFF);
    xcd_barrier(b, is_leader(wid0));
}
template <int PH> __device__ __forceinline__ void run_phase(const Params& P0, LAS unsigned char* lds, const int wid0) {
    Params P = P0; asm volatile("" : "+s"(P.ws), "+s"(P.out));
#pragma unroll
    for (int i = 0; i < 16; ++i) asm volatile("" : "+s"(P.in[i]));
    int lane_; asm volatile("v_mbcnt_lo_u32_b32 %0, -1, 0\n\tv_mbcnt_hi_u32_b32 %0, -1, %0" : "=v"(lane_));
    int wid_ = wid0; asm volatile("" : "+s"(wid_));
    const int tid = wid_ * 64 + lane_;
    int bid = blockIdx.x, G = gridDim.x; asm volatile("" : "+s"(bid), "+s"(G));
    const int lane = lane_, wid = wid_;
    if constexpr (PH == 0) phase_prologue(P, lds, bid, G, tid, wid, lane);
    else if constexpr (PH == N_PHASES - 1) phase_norm(P, 0, 2, bid, G, wid, lane);
    else {
        constexpr int l = (PH - 1) / NPH, s = (PH - 1) % NPH;
        if constexpr (s == 0) phase_norm(P, l, 0, bid, G, wid, lane);
        else if constexpr (s == 1) { pg8::Gemm g{(const pg8::bf16_t*)(P.ws + WS_H), (const pg8::bf16_t*)(P.ws + WS_WIN) + (size_t)l * NIN * D, T, NIN, D};
            pg8::StaticOrder S; S.init(T, NIN, G, bid); pg8::EpiStoreBf16 E{(pg8::bf16_t*)(P.ws + WS_U), NIN};
            pg8::gemm_phase<pg8::EpiStoreBf16, pg8::StaticOrder, true, true>(lds, g, S, E, tid); }
        else if constexpr (s == 2) naive_kmean(P, bid, tid);
        else if constexpr (s == 3) {
#if NAIVE_ATTN
            for (int qi = bid * 8 + wid; qi < BATCH * 6 * SEQ; qi += G * 8) naive_attn_query(P, qi, lane);
#else
            if (G == 256) {
                for (int k = 0; k < 2; ++k) { const int u = k == 0 ? bid : 383 - bid;
                    if (k == 1 && bid >= 128) continue;
                    int t2 = tid; asm volatile("" : "+v"(t2));
                    attn_unit(P, (u % 48) / 6, (u % 48) % 6, 7 - u / 48, lds, t2, wid, t2 & 63); }
            } else for (int u = bid; u < 384; u += G) attn_unit(P, (u % 48) / 6, (u % 48) % 6, 7 - u / 48, lds, tid, wid, lane);
#endif
#if NAIVE_POOL
            for (int it = bid; it < T / 8; it += G) naive_pool(P, l, it, lds, tid);
#else
            for (int u = bid; u < T / 64; u += G) { int t2 = tid; asm volatile("" : "+v"(t2)); pool_unit(P, l, u, lds, t2, wid, t2 & 63); }
#endif
#if NAIVE_SSD
            for (int bh = bid; bh < BATCH * 6; bh += G) naive_ssd(P, l, bh, lds, tid);
#else
            for (int u = bid; u < 256; u += G) if (((u >> 1) & 15) != 15) { int t2 = tid; asm volatile("" : "+v"(t2)); ssd_unit_a(P, l, u >> 5, (u >> 1) & 15, u & 1, lds, t2, wid, t2 & 63); }
#endif
        }
        else if constexpr (s == 4) {
#if NAIVE_SSD
            naive_ssd_norm(P, l, bid, G, wid, lane);
#else
            for (int u = bid; u < 256; u += G) { int t2 = tid; asm volatile("" : "+v"(t2)); ssd_unit_b(P, l, u >> 5, (u >> 1) & 15, u & 1, lds, t2, wid, t2 & 63); }
#endif
        }
        else if constexpr (s == 5) { pg8::Gemm g{(const pg8::bf16_t*)(P.ws + WS_H), (const pg8::bf16_t*)(P.ws + WS_WOUT) + (size_t)l * D * D, T, D, D};
            pg8::StaticOrder S; S.init(T, D, G, bid); pg8::EpiResidual E{l == 0 ? P.in[I_X] : P.out, P.out, D};
            pg8::gemm_phase<pg8::EpiResidual, pg8::StaticOrder, true, true>(lds, g, S, E, tid); }
        else if constexpr (s == 6) phase_norm(P, l, 1, bid, G, wid, lane);
        else if constexpr (s == 7) { pg8::Gemm g{(const pg8::bf16_t*)(P.ws + WS_H), (const pg8::bf16_t*)(P.ws + WS_WGU) + (size_t)l * NGU * D, T, NGU, D};
            pg8::StaticOrder S; S.init(T, NGU, G, bid); pg8::EpiSwiGLU E{(pg8::bf16_t*)(P.ws + WS_U), FF};
            pg8::gemm_phase<pg8::EpiSwiGLU, pg8::StaticOrder, true, true>(lds, g, S, E, tid); }
        else { pg8::Gemm g{(const pg8::bf16_t*)(P.ws + WS_U), (const pg8::bf16_t*)(P.ws + WS_WD) + (size_t)l * D * FF, T, D, FF};
            pg8::StaticOrder S; S.init(T, D, G, bid); pg8::EpiResidual E{P.out, P.out, D};
            pg8::gemm_phase<pg8::EpiResidual, pg8::StaticOrder, true, true>(lds, g, S, E, tid); }
    }
}
template <int PH> __device__ __forceinline__ void run_all(const Params& P0, LAS unsigned char* lds, const int wid0, const int lo, const int hi) {
    if constexpr (PH < N_PHASES) {
        if (PH >= lo && PH < hi) { run_phase<PH>(P0, lds, wid0);
#if DUP_S
            if constexpr (PH >= 1 && PH < N_PHASES - 1 && ((DUP_S >> ((PH - 1) % NPH)) & 1)) { __syncthreads(); run_phase<PH>(P0, lds, wid0); }
            if constexpr (PH == 0 && ((DUP_S >> 30) & 1)) { __syncthreads(); run_phase<PH>(P0, lds, wid0); }
#endif
            if (PH + 1 < hi) {
#pragma unroll
                for (int rep = 0; rep < SYNC_REP; ++rep) grid_sync(P0.ws, lds, wid0); } }
        run_all<PH + 1>(P0, lds, wid0, lo, hi);
    }
}
__global__ void __launch_bounds__(512, 2) mega(Params P0) {
    extern __shared__ __attribute__((aligned(16))) unsigned char lds_raw[];
    LAS unsigned char* lds = (LAS unsigned char*)lds_raw;
    const int wid0 = __builtin_amdgcn_readfirstlane(threadIdx.x >> 6);
    { const bool leader = is_leader(wid0);
      if (leader) { ((volatile LAS unsigned*)(lds + BAR_LDS_OFF))[0] = 0u; ((volatile LAS unsigned*)(lds + BAR_LDS_OFF))[1] = 0u; }
      __syncthreads();
      if (P0.ph_hi - P0.ph_lo > 1) (void)xcd_barrier_post((unsigned*)(P0.ws + WS_BAR), (volatile LAS unsigned*)(lds + BAR_LDS_OFF), leader); }
    run_all<0>(P0, lds, wid0, P0.ph_lo, P0.ph_hi);
}

#ifndef ONE_LAUNCH
#define ONE_LAUNCH 1
#endif
extern "C" void kernel_launch(void* const* d_in, const int* in_sizes, int n_in, void* d_out, int out_size, void* d_ws, size_t ws_size, hipStream_t stream) {
    static int grid = 0;
    if (grid == 0) {
        if (n_in != 16 || out_size != T * D || ws_size < WS_END) { fprintf(stderr, "kernel_launch: unexpected shapes n_in %d out %d ws %zu\n", n_in, out_size, ws_size); grid = -1; return; }
        int dev = 0, cus = 0, per_cu = 0;
        hipGetDevice(&dev); hipDeviceGetAttribute(&cus, hipDeviceAttributeMultiprocessorCount, dev);
        if (hipFuncSetAttribute((const void*)mega, hipFuncAttributeMaxDynamicSharedMemorySize, LDS_BYTES) != hipSuccess) { fprintf(stderr, "kernel_launch: hipFuncSetAttribute failed\n"); grid = -1; return; }
        hipOccupancyMaxActiveBlocksPerMultiprocessor(&per_cu, (const void*)mega, 512, LDS_BYTES);
        if (per_cu < 1) { fprintf(stderr, "kernel_launch: occupancy query says %d\n", per_cu); per_cu = 1; }
        (void)hipGetLastError();
        grid = cus * per_cu;
    }
    if (grid < 0) return;
    if (hipMemsetAsync((char*)d_ws + WS_CTL, 0, 131072, stream) != hipSuccess) { fprintf(stderr, "kernel_launch: memset failed\n"); return; }
    Params p{};
    for (int i = 0; i < 16; ++i) p.in[i] = (const float*)d_in[i];
    p.out = (float*)d_out; p.ws = (unsigned char*)d_ws;
#if ONE_LAUNCH
    p.ph_lo = 0; p.ph_hi = N_PHASES;
    void* args[] = {&p};
    hipError_t e = hipLaunchCooperativeKernel((const void*)mega, dim3(grid), dim3(512), args, LDS_BYTES, stream);
    if (e != hipSuccess) fprintf(stderr, "cooperative launch failed: %s (grid %d)\n", hipGetErrorString(e), grid);
#else
    for (int ph = 0; ph < N_PHASES; ++ph) { p.ph_lo = ph; p.ph_hi = ph + 1; hipLaunchKernelGGL(mega, dim3(grid), dim3(512), LDS_BYTES, stream, p); }
#endif
}
```

```cpp
#include <hip/hip_runtime.h>
#include <hip/hip_cooperative_groups.h>
#include <cstdio>
#include <cstdint>
namespace cg = cooperative_groups;
namespace pg8 {
#define PG8_LAS __attribute__((address_space(3)))
typedef unsigned short bf16_t;
typedef short bf16x8 __attribute__((ext_vector_type(8)));
typedef float f32x4 __attribute__((ext_vector_type(4)));
typedef unsigned u32x4 __attribute__((ext_vector_type(4)));
constexpr int BM = 256, BK = 64, HALF = 128, HTB = HALF * BK * 2  , STAGE_BYTES = 8 * HTB, NXCD = 8, WGM = 8;

__host__ __device__ __forceinline__ int lds_byte(int r, int c) { const int st = (r >> 4) * 2 + (c >> 5), rr = r & 15, cc = c & 31, ob = rr * 64 + cc * 2; return st * 1024 + (ob ^ (((ob >> 9) & 1) << 5)); }
__host__ __device__ __forceinline__ void stage_rc(int b, int& R, int& C) { const int st = b / 1024, sb = b % 1024, swz = sb ^ (((sb >> 9) & 1) << 5); R = (st >> 1) * 16 + swz / 64; C = (st & 1) * 32 + (swz % 64) / 2; }
__host__ __device__ __forceinline__ int perm32(int rho) { const int n = rho >> 4, i = rho & 15; return 8 * (i >> 2) + 4 * n + (i & 3); }

struct Unit { int pm, pn; };
struct Gemm { const bf16_t* A; const bf16_t* Bt; int M, N, K; };

struct StaticOrder {
    int nM, nN, nwg, G, c;
    __host__ __device__ void init(int M, int N, int G_, int c_) { nM = M / BM; nN = N / BM; nwg = nM * nN; G = G_; c = c_; }
    __host__ __device__ bool next(int i, Unit& u) const {
        const long L = (long)i * G + c; if (L >= nwg) return false;
        int wgid = (int)L; { const int q = nwg / NXCD, r = nwg % NXCD, xcd = wgid % NXCD, off = wgid / NXCD; wgid = (xcd < r ? xcd * (q + 1) : r * (q + 1) + (xcd - r) * q) + off; }
        const int nig = WGM * nN, gid = wgid / nig, fm = gid * WGM, gsz = (nM - fm) < WGM ? (nM - fm) : WGM;
        u.pm = fm + ((wgid % nig) % gsz); u.pn = (wgid % nig) / gsz; return true;
    }
    __device__ __forceinline__ void a_ready(const Unit&) const {}
    __device__ __forceinline__ void done(const Unit&) const {}
};

__device__ __forceinline__ unsigned cvt_pk_bf16(float lo, float hi) { unsigned r; asm volatile("v_cvt_pk_bf16_f32 %0, %1, %2" : "=v"(r) : "v"(lo), "v"(hi)); return r; }
struct EpiStoreBf16 {
    static constexpr bool PERM = true, AFTER_DRAIN = false;
    bf16_t* O; int ldc;
    __device__ __forceinline__ void operator()(const f32x4 (&acc)[2][2][4][2], const Unit& u, int wr, int wc, int fr, int fq) const {
        const int row0 = u.pm * BM + wr * 64 + fr; const int col0 = u.pn * BM + wc * 32 + 8 * fq;
#pragma unroll
        for (int ai = 0; ai < 2; ++ai)
#pragma unroll
            for (int m = 0; m < 4; ++m) { bf16_t* rowp = O + (size_t)(row0 + ai * HALF + m * 16) * ldc + col0;
#pragma unroll
                for (int bj = 0; bj < 2; ++bj) { const f32x4 v0 = acc[ai][bj][m][0], v1 = acc[ai][bj][m][1];
                    u32x4 w; w.x = cvt_pk_bf16(v0[0], v0[1]); w.y = cvt_pk_bf16(v0[2], v0[3]); w.z = cvt_pk_bf16(v1[0], v1[1]); w.w = cvt_pk_bf16(v1[2], v1[3]);
                    *(u32x4*)(rowp + bj * HALF) = w; } }
    }
};
struct EpiResidual {
    static constexpr bool PERM = true, AFTER_DRAIN = false;
    const float* R; float* X; int ld;
    __device__ __forceinline__ void operator()(const f32x4 (&acc)[2][2][4][2], const Unit& u, int wr, int wc, int fr, int fq) const {
        const int row0 = u.pm * BM + wr * 64 + fr; const int col0 = u.pn * BM + wc * 32 + 8 * fq;
#pragma unroll
        for (int ai = 0; ai < 2; ++ai)
#pragma unroll
            for (int m = 0; m < 4; ++m) { const size_t off = (size_t)(row0 + ai * HALF + m * 16) * ld + col0;
#pragma unroll
                for (int bj = 0; bj < 2; ++bj) {
                    const f32x4 r0 = *(const f32x4*)(R + off + bj * HALF), r1 = *(const f32x4*)(R + off + bj * HALF + 4);
                    *(f32x4*)(X + off + bj * HALF) = r0 + acc[ai][bj][m][0]; *(f32x4*)(X + off + bj * HALF + 4) = r1 + acc[ai][bj][m][1]; } __builtin_amdgcn_sched_barrier(0); }
    }
};
__device__ __forceinline__ float silu_f(float g) { return g * __builtin_amdgcn_rcpf(1.f + __expf(-g)); }
struct EpiSwiGLU {
    static constexpr bool PERM = true, AFTER_DRAIN = false;
    bf16_t* O; int ldc;
    __device__ __forceinline__ void operator()(const f32x4 (&acc)[2][2][4][2], const Unit& u, int wr, int wc, int fr, int fq) const {
        const int row0 = u.pm * BM + wr * 64 + fr; const int col0 = u.pn * HALF + wc * 32 + 8 * fq;
#pragma unroll
        for (int ai = 0; ai < 2; ++ai)
#pragma unroll
            for (int m = 0; m < 4; ++m) { bf16_t* rowp = O + (size_t)(row0 + ai * HALF + m * 16) * ldc + col0;
                const f32x4 g0 = acc[ai][0][m][0], g1 = acc[ai][0][m][1], u0 = acc[ai][1][m][0], u1 = acc[ai][1][m][1];
                u32x4 w; w.x = cvt_pk_bf16(silu_f(g0[0]) * u0[0], silu_f(g0[1]) * u0[1]); w.y = cvt_pk_bf16(silu_f(g0[2]) * u0[2], silu_f(g0[3]) * u0[3]);
                w.z = cvt_pk_bf16(silu_f(g1[0]) * u1[0], silu_f(g1[1]) * u1[1]); w.w = cvt_pk_bf16(silu_f(g1[2]) * u1[2], silu_f(g1[3]) * u1[3]);
                *(u32x4*)rowp = w; __builtin_amdgcn_sched_barrier(0); }
    }
};
template <class Epi, class Sched, bool ALIGN_EPI = false, bool SP2 = false>
__device__ __forceinline__ void gemm_phase(PG8_LAS unsigned char* lds, const Gemm g, const Sched& S, const Epi& E, const int tid) {
    const int wid = __builtin_amdgcn_readfirstlane(tid >> 6), lane = tid & 63, wr = wid >> 2, wc = wid & 3, fr = lane & 15, fq = lane >> 4;
    const int K = g.K, nt = K / BK;
    unsigned voffA[2], voffB[2];
#pragma unroll
    for (int i = 0; i < 2; ++i) { int R, C; stage_rc(tid * 16 + i * 8192, R, C); const int Rb = Epi::PERM ? ((R & ~31) + perm32(R & 31)) : R;
        voffA[i] = (unsigned)(R * K + C) * 2u; voffB[i] = (unsigned)(Rb * K + C) * 2u; }
    const size_t kstep = (size_t)(BK * 2);
    const size_t hstep = (size_t)HALF * K * 2;
    const size_t tstep = 2 * hstep;
    const unsigned ldsw = (unsigned)wid * 1024u;
    const int aoff = lds_byte(wr * 64 + fr, fq * 8), boff = lds_byte(wc * 32 + fr, fq * 8);
#define PG8_SA(b, h) (((b) * 2 + (h)) * HTB)
#define PG8_SB(b, h) ((4 + (b) * 2 + (h)) * HTB)
#define PG8_STAGE(bufoff, gbase, voff) do { _Pragma("unroll") for (int _i = 0; _i < 2; ++_i) \
        __builtin_amdgcn_global_load_lds((const unsigned*)((const char*)(gbase) + (voff)[_i]), (PG8_LAS unsigned*)(lds + (bufoff) + ldsw + _i * 8192), 16, 0, 0); } while (0)
#define PG8_LDA(dst, b, h) do { _Pragma("unroll") for (int m = 0; m < 4; ++m) _Pragma("unroll") for (int k = 0; k < 2; ++k) dst[m][k] = *(const PG8_LAS bf16x8*)(lds + PG8_SA(b, h) + aoff + m * 2048 + k * 1024); } while (0)
#define PG8_LDB(dst, b, h) do { _Pragma("unroll") for (int n = 0; n < 2; ++n) _Pragma("unroll") for (int k = 0; k < 2; ++k) dst[n][k] = *(const PG8_LAS bf16x8*)(lds + PG8_SB(b, h) + boff + n * 2048 + k * 1024); } while (0)
#define PG8_MMA(ai, bj, At, Bt) do { __builtin_amdgcn_s_setprio(1); _Pragma("unroll") for (int m = 0; m < 4; ++m) _Pragma("unroll") for (int n = 0; n < 2; ++n) _Pragma("unroll") for (int k = 0; k < 2; ++k) \
        acc[ai][bj][m][n] = __builtin_amdgcn_mfma_f32_16x16x32_bf16(Bt[n][k], At[m][k], acc[ai][bj][m][n], 0, 0, 0); __builtin_amdgcn_s_setprio(0); } while (0)
#define PG8_WAIT_V(n) asm volatile("s_waitcnt vmcnt(" #n ")" ::: "memory")
#define PG8_WAIT_L(n) asm volatile("s_waitcnt lgkmcnt(" #n ")" ::: "memory")
#define PG8_BAR __builtin_amdgcn_s_barrier()
#define PG8_SCHED __builtin_amdgcn_sched_barrier(0)
    Unit cur, nxt; int ui = 0;
    if (!S.next(0, cur)) return;
    f32x4 acc[2][2][4][2];
#pragma unroll
    for (int a = 0; a < 2; ++a)
#pragma unroll
        for (int b = 0; b < 2; ++b)
#pragma unroll
            for (int m = 0; m < 4; ++m)
#pragma unroll
                for (int n = 0; n < 2; ++n) acc[a][b][m][n] = (f32x4){0.f, 0.f, 0.f, 0.f};
    bf16x8 At[4][2], B0[2][2], B1[2][2];
    const char* cA = (const char*)g.A + (size_t)cur.pm * tstep; const char* cB = (const char*)g.Bt + (size_t)cur.pn * tstep;
    S.a_ready(cur);
    if constexpr (SP2) {
        PG8_STAGE(PG8_SB(0, 0), cB, voffB); PG8_STAGE(PG8_SB(0, 1), cB + hstep, voffB); PG8_STAGE(PG8_SA(0, 0), cA, voffA); PG8_STAGE(PG8_SA(0, 1), cA + hstep, voffA);
        if (wr == 1) PG8_BAR;
        PG8_WAIT_V(2); PG8_BAR;
        PG8_STAGE(PG8_SB(1, 0), cB + kstep, voffB); PG8_STAGE(PG8_SA(1, 0), cA + kstep, voffA); PG8_STAGE(PG8_SB(1, 1), cB + hstep + kstep, voffB);
        PG8_WAIT_V(6); PG8_BAR;
    } else {
        PG8_STAGE(PG8_SB(0, 0), cB, voffB); PG8_STAGE(PG8_SA(0, 0), cA, voffA); PG8_STAGE(PG8_SB(0, 1), cB + hstep, voffB); PG8_STAGE(PG8_SA(0, 1), cA + hstep, voffA);
        if (wr == 1) PG8_BAR;
        PG8_WAIT_V(4); PG8_BAR;
        PG8_STAGE(PG8_SB(1, 0), cB + kstep, voffB); PG8_STAGE(PG8_SA(1, 0), cA + kstep, voffA); PG8_STAGE(PG8_SB(1, 1), cB + hstep + kstep, voffB);
        PG8_WAIT_V(6); PG8_BAR;
    }
    for (;;) {
        const bool has_next = S.next(ui + 1, nxt);
        const char* nA = has_next ? (const char*)g.A + (size_t)nxt.pm * tstep : cA; const char* nB = has_next ? (const char*)g.Bt + (size_t)nxt.pn * tstep : cB;
        for (int t = 0; t < nt; t += 2) {
            const bool last = (t == nt - 2);
            const char* a1 = cA + (size_t)(t + 1) * kstep;
            const char* a2 = last ? nA : cA + (size_t)(t + 2) * kstep; const char* b2 = last ? nB : cB + (size_t)(t + 2) * kstep;
            const char* a3 = a2 + kstep; const char* b3 = b2 + kstep;
            if (last && has_next) S.a_ready(nxt);
            if constexpr (SP2) {
            PG8_LDB(B0, 0, 0); PG8_LDB(B1, 0, 1); PG8_SCHED; PG8_LDA(At, 0, 0); PG8_STAGE(PG8_SA(1, 1), a1 + hstep, voffA);
            PG8_WAIT_V(8); PG8_WAIT_L(0); PG8_BAR; PG8_MMA(0, 0, At, B0); PG8_MMA(0, 1, At, B1); PG8_BAR; PG8_SCHED;
            PG8_LDA(At, 0, 1); PG8_STAGE(PG8_SB(0, 0), b2, voffB); PG8_STAGE(PG8_SB(0, 1), b2 + hstep, voffB); PG8_STAGE(PG8_SA(0, 0), a2, voffA);
            PG8_WAIT_V(8); PG8_WAIT_L(0); PG8_BAR; PG8_MMA(1, 0, At, B0); PG8_MMA(1, 1, At, B1); PG8_BAR; PG8_SCHED;
            PG8_LDB(B0, 1, 0); PG8_LDB(B1, 1, 1); PG8_SCHED; PG8_LDA(At, 1, 0); PG8_STAGE(PG8_SA(0, 1), a2 + hstep, voffA);
            PG8_WAIT_V(8); PG8_WAIT_L(0); PG8_BAR; PG8_MMA(0, 0, At, B0); PG8_MMA(0, 1, At, B1); PG8_BAR; PG8_SCHED;
            PG8_LDA(At, 1, 1); PG8_STAGE(PG8_SB(1, 0), b3, voffB); PG8_STAGE(PG8_SB(1, 1), b3 + hstep, voffB); PG8_STAGE(PG8_SA(1, 0), a3, voffA);
            PG8_WAIT_V(8); PG8_WAIT_L(0); PG8_BAR; PG8_MMA(1, 0, At, B0); PG8_MMA(1, 1, At, B1); PG8_BAR; PG8_SCHED;
            } else {
            PG8_LDB(B0, 0, 0); PG8_SCHED; PG8_LDA(At, 0, 0); PG8_STAGE(PG8_SA(1, 1), a1 + hstep, voffA);
            PG8_WAIT_L(8); PG8_BAR; PG8_WAIT_L(0); PG8_MMA(0, 0, At, B0); PG8_BAR; PG8_SCHED;
            PG8_LDB(B1, 0, 1); PG8_STAGE(PG8_SB(0, 0), b2, voffB);
            PG8_BAR; PG8_WAIT_L(0); PG8_MMA(0, 1, At, B1); PG8_BAR;
            PG8_LDA(At, 0, 1); PG8_STAGE(PG8_SA(0, 0), a2, voffA);
            PG8_BAR; PG8_WAIT_L(0); PG8_MMA(1, 0, At, B0); PG8_BAR; PG8_SCHED;
            PG8_STAGE(PG8_SB(0, 1), b2 + hstep, voffB);
            PG8_WAIT_V(6); PG8_BAR; PG8_MMA(1, 1, At, B1); PG8_BAR;
            PG8_LDB(B0, 1, 0); PG8_SCHED; PG8_LDA(At, 1, 0); PG8_STAGE(PG8_SA(0, 1), a2 + hstep, voffA);
            PG8_WAIT_L(8); PG8_BAR; PG8_WAIT_L(0); PG8_MMA(0, 0, At, B0); PG8_BAR; PG8_SCHED;
            PG8_LDB(B1, 1, 1); PG8_STAGE(PG8_SB(1, 0), b3, voffB);
            PG8_BAR; PG8_WAIT_L(0); PG8_MMA(0, 1, At, B1); PG8_BAR;
            PG8_LDA(At, 1, 1); PG8_STAGE(PG8_SA(1, 0), a3, voffA);
            PG8_BAR; PG8_WAIT_L(0); PG8_MMA(1, 0, At, B0); PG8_BAR; PG8_SCHED;
            PG8_STAGE(PG8_SB(1, 1), b3 + hstep, voffB);
            PG8_WAIT_V(6); PG8_BAR; PG8_MMA(1, 1, At, B1); PG8_BAR;
            }
        }
        if constexpr (ALIGN_EPI) { if (wr == 0) PG8_BAR; }
        if constexpr (!Epi::AFTER_DRAIN) { E(acc, cur, wr, wc, fr, fq); S.done(cur); }
        if (!has_next) break;
#pragma unroll
        for (int a = 0; a < 2; ++a)
#pragma unroll
            for (int b = 0; b < 2; ++b)
#pragma unroll
                for (int m = 0; m < 4; ++m)
#pragma unroll
                    for (int n = 0; n < 2; ++n) acc[a][b][m][n] = (f32x4){0.f, 0.f, 0.f, 0.f};
        cur = nxt; cA = nA; cB = nB; ++ui;
        if constexpr (ALIGN_EPI) { if (wr == 1) PG8_BAR; }
    }
    PG8_WAIT_V(0);
    if constexpr (!ALIGN_EPI) { if (wr == 0) PG8_BAR; }
    PG8_BAR;
    if constexpr (Epi::AFTER_DRAIN) { E.fused(acc, cur, wr, wc, fr, fq, lds, wid, lane); S.done(cur); }
#undef PG8_SA
#undef PG8_SB
#undef PG8_STAGE
#undef PG8_LDA
#undef PG8_LDB
#undef PG8_MMA
#undef PG8_WAIT_V
#undef PG8_WAIT_L
#undef PG8_BAR
#undef PG8_SCHED
}
}

#define LAS __attribute__((address_space(3)))
typedef unsigned short bf16;
typedef unsigned v4u __attribute__((ext_vector_type(4)));
typedef unsigned v2u __attribute__((ext_vector_type(2)));
typedef float f32x4 __attribute__((ext_vector_type(4)));
constexpr int BATCH = 8, SEQ = 2048, T = BATCH * SEQ, D = 1024, DEPTH = 4;
constexpr int INW = 2694, NIN = 2816, FF = 2816, NGU = 5632;
constexpr int UQ = 0, UK = 384, UV = 768, UZ = 1152, UXS = 1536, UP = 2432;
constexpr int XBC = 896;
constexpr float EPS = 1e-6f;
constexpr size_t MiB = 1u << 20;
constexpr size_t WS_CTL = 0;
constexpr size_t WS_WIN = 1 * MiB, WS_WOUT = 23 * MiB, WS_WGU = 31 * MiB, WS_WD = 75 * MiB;
constexpr size_t WS_DTW = 97 * MiB, WS_PWT = WS_DTW + 128 * 1024, WS_KM = WS_DTW + 256 * 1024, WS_CD = WS_DTW + 512 * 1024;
constexpr size_t WS_DT = 98 * MiB, WS_H = 99 * MiB, WS_U = 131 * MiB, WS_ST = 219 * MiB, WS_PREV = 243 * MiB, WS_END = 255 * MiB;
constexpr int LDS_BYTES = 147456;
#ifndef NAIVE_ATTN
#define NAIVE_ATTN 0
#endif
#ifndef NAIVE_SSD
#define NAIVE_SSD 0
#endif
#ifndef NAIVE_POOL
#define NAIVE_POOL 0
#endif
#ifndef DUP_S
#define DUP_S 0
#endif
#ifndef SYNC_REP
#define SYNC_REP 1
#endif
#ifndef DUP_MIX
#define DUP_MIX 0
#endif
constexpr int NPH = 9;
constexpr int N_PHASES = 2 + DEPTH * NPH;

__device__ __forceinline__ float bf2f(unsigned short u) { return __builtin_bit_cast(float, (unsigned)u << 16); }
__device__ __forceinline__ unsigned f2bf(float f) { unsigned u = __builtin_bit_cast(unsigned, f); return (u + 0x7fffu + ((u >> 16) & 1u)) >> 16; }
__device__ __forceinline__ unsigned pk2(float lo, float hi) { return f2bf(lo) | (f2bf(hi) << 16); }
#define SWZ_XOR(v, m) __builtin_bit_cast(float, __builtin_amdgcn_ds_swizzle(__builtin_bit_cast(int, (v)), ((m) << 10) | 0x1f))
__device__ __forceinline__ float half_sum(float v) { v += SWZ_XOR(v, 1); v += SWZ_XOR(v, 2); v += SWZ_XOR(v, 4); v += SWZ_XOR(v, 8); v += SWZ_XOR(v, 16); return v; }
__device__ __forceinline__ float wave_sum(float v) {
    v = half_sum(v);
    return __builtin_bit_cast(float, __builtin_amdgcn_readlane(__builtin_bit_cast(int, v), 0)) + __builtin_bit_cast(float, __builtin_amdgcn_readlane(__builtin_bit_cast(int, v), 32));
}
__device__ __forceinline__ float wave_max(float v) {
    v = fmaxf(v, SWZ_XOR(v, 1)); v = fmaxf(v, SWZ_XOR(v, 2)); v = fmaxf(v, SWZ_XOR(v, 4)); v = fmaxf(v, SWZ_XOR(v, 8)); v = fmaxf(v, SWZ_XOR(v, 16));
    return fmaxf(__builtin_bit_cast(float, __builtin_amdgcn_readlane(__builtin_bit_cast(int, v), 0)), __builtin_bit_cast(float, __builtin_amdgcn_readlane(__builtin_bit_cast(int, v), 32)));
}
__device__ __forceinline__ float silu(float g) { return g / (1.f + __expf(-g)); }

struct Params { const float* in[16]; float* out; unsigned char* ws; int ph_lo, ph_hi; };
enum { I_X = 0, I_NMIX, I_WIN, I_CONVW, I_CONVB, I_DTB, I_ALOG, I_DSKIP, I_SSDN, I_POOLW, I_POOLS, I_WOUT, I_NFFN, I_WGU, I_WD, I_NFIN };

__device__ __forceinline__ void transpose_item(const float* W, int srcN, int c0, int k0, bf16* WT, int dstK, int n0, LAS float* scr, int lane) {
    if (c0 >= 0) {
#pragma unroll 8
        for (int i = 0; i < 32; ++i) { const int kk = 2 * i + (lane >> 5); scr[kk * 33 + (lane & 31)] = W[(size_t)(k0 + kk) * srcN + c0 + (lane & 31)]; }
    }
    asm volatile("s_waitcnt lgkmcnt(0)" ::: "memory");
    const int c = lane & 7;
#pragma unroll
    for (int j = 0; j < 4; ++j) { const int n = (lane >> 3) + 8 * j; const LAS float* s = scr + (8 * c) * 33 + n;
        v4u o = {0u, 0u, 0u, 0u};
        if (c0 >= 0) { o.x = pk2(s[0 * 33], s[1 * 33]); o.y = pk2(s[2 * 33], s[3 * 33]); o.z = pk2(s[4 * 33], s[5 * 33]); o.w = pk2(s[6 * 33], s[7 * 33]); }
        *(v4u*)(WT + (size_t)(n0 + n) * dstK + k0 + 8 * c) = o; }
    asm volatile("s_waitcnt lgkmcnt(0)" ::: "memory");
}
__device__ __forceinline__ void phase_prologue(const Params& P, LAS unsigned char* lds, int bid, int G, int tid, int wid, int lane) {
    LAS float* scr = (LAS float*)lds + wid * (64 * 33);
    const int gw = bid * 8 + wid, nw = G * 8;
    for (int it = gw; it < DEPTH * 6144; it += nw) {
        const int l = it / 6144; int r = it % 6144;
        if (r < 1408) { const int nb = r >> 4, kb = r & 15, n0 = nb * 32; const int c0 = n0 < 2432 ? n0 : (n0 < 2688 ? n0 + 6 : -1);
            transpose_item(P.in[I_WIN] + (size_t)l * D * INW, INW, c0, kb * 64, (bf16*)(P.ws + WS_WIN) + (size_t)l * NIN * D, D, n0, scr, lane); }
        else if (r < 1920) { r -= 1408; const int nb = r >> 4, kb = r & 15;
            transpose_item(P.in[I_WOUT] + (size_t)l * D * D, D, nb * 32, kb * 64, (bf16*)(P.ws + WS_WOUT) + (size_t)l * D * D, D, nb * 32, scr, lane); }
        else if (r < 4736) { r -= 1920; const int nb = r >> 4, kb = r & 15, n0 = nb * 32, pn = n0 >> 8, rr = n0 & 255; const int c0 = rr < 128 ? 128 * pn + rr : FF + 128 * pn + (rr - 128);
            transpose_item(P.in[I_WGU] + (size_t)l * D * NGU, NGU, c0, kb * 64, (bf16*)(P.ws + WS_WGU) + (size_t)l * NGU * D, D, n0, scr, lane); }
        else { r -= 4736; const int nb = r / 44, kb = r % 44;
            transpose_item(P.in[I_WD] + (size_t)l * FF * D, D, nb * 32, kb * 64, (bf16*)(P.ws + WS_WD) + (size_t)l * D * FF, FF, nb * 32, scr, lane); }
    }
    const int gt = bid * 512 + tid, nt = G * 512;
    float* dtw = (float*)(P.ws + WS_DTW);
    for (int i = gt; i < DEPTH * 8 * D; i += nt) { const int l = i / (8 * D), j = (i / D) & 7, k = i % D; dtw[i] = j < 6 ? P.in[I_WIN][((size_t)l * D + k) * INW + 2432 + j] : 0.f; }
    bf16* pwt = (bf16*)(P.ws + WS_PWT);
    for (int i = gt; i < DEPTH * 4 * 64 * 64; i += nt) { const int lg = i >> 12, d = (i >> 6) & 63, c = i & 63; pwt[i] = (bf16)f2bf(P.in[I_POOLW][(lg * 64 + c) * 64 + d]); }
}

__device__ __forceinline__ void phase_norm(const Params& P, int l, int mode, int bid, int G, int wid, int lane) {
    const float* X = (mode == 0 && l == 0) ? P.in[I_X] : P.out;
    const float* g = mode == 0 ? P.in[I_NMIX] + l * D : (mode == 1 ? P.in[I_NFFN] + l * D : P.in[I_NFIN]);
    bf16* H = (bf16*)(P.ws + WS_H);
    const float* dtw = (const float*)(P.ws + WS_DTW) + (size_t)l * 8 * D;
    float* DT = (float*)(P.ws + WS_DT);
    f32x4 gv[4];
#pragma unroll
    for (int j = 0; j < 4; ++j) gv[j] = *(const f32x4*)(g + 4 * lane + 256 * j);
    for (int row = bid * 8 + wid; row < T; row += G * 8) {
        const float* xr = X + (size_t)row * D + 4 * lane;
        f32x4 v[4]; float s = 0.f;
#pragma unroll
        for (int j = 0; j < 4; ++j) { v[j] = *(const f32x4*)(xr + 256 * j); s += (v[j].x * v[j].x + v[j].y * v[j].y) + (v[j].z * v[j].z + v[j].w * v[j].w); }
        const float rstd = rsqrtf(wave_sum(s) * (1.f / D) + EPS);
#pragma unroll
        for (int j = 0; j < 4; ++j) v[j] = (v[j] * rstd) * gv[j];
        if (mode == 2) {
#pragma unroll
            for (int j = 0; j < 4; ++j) *(f32x4*)(P.out + (size_t)row * D + 4 * lane + 256 * j) = v[j];
        } else {
            v2u* o8 = (v2u*)(H + (size_t)row * D + 4 * lane);
#pragma unroll
            for (int j = 0; j < 4; ++j) { v2u o; o.x = pk2(v[j].x, v[j].y); o.y = pk2(v[j].z, v[j].w); o8[64 * j] = o; }
            if (mode == 0) {
                float mine = 0.f;
#pragma unroll
                for (int q = 0; q < 6; ++q) { float a = 0.f;
#pragma unroll
                    for (int j = 0; j < 4; ++j) { const f32x4 w = *(const f32x4*)(dtw + q * D + 4 * lane + 256 * j); a += (v[j].x * w.x + v[j].y * w.y) + (v[j].z * w.z + v[j].w * w.w); }
                    a = wave_sum(a); if (lane == q) mine = a; }
                if (lane < 6) { const float z = mine + P.in[I_DTB][l * 6 + lane]; DT[(size_t)row * 8 + lane] = fmaxf(z, 0.f) + log1pf(__expf(-fabsf(z))); }
            }
        }
    }
}
__device__ __forceinline__ void naive_kmean(const Params& P, int bid, int tid) {
    const bf16* U = (const bf16*)(P.ws + WS_U); float* KM = (float*)(P.ws + WS_KM);
    const int i = bid * 512 + tid;
    if (i < BATCH * 6 * 8 * 64) { const int d = i & 63, j = (i >> 6) & 7, bh = i >> 9, b = bh / 6, h = bh % 6;
        float s = 0.f; for (int r = 0; r < 256; ++r) s += bf2f(U[(size_t)(b * SEQ + j * 256 + r) * NIN + UK + h * 64 + d]);
        KM[i] = s * (1.f / 256.f); }
}
__device__ __forceinline__ void naive_attn_query(const Params& P, int qi, int lane) {
    const bf16* U = (const bf16*)(P.ws + WS_U); const float* KM = (const float*)(P.ws + WS_KM); bf16* MIX = (bf16*)(P.ws + WS_H);
    const int t = qi & 2047, bh = qi >> 11, b = bh / 6, h = bh % 6, blk = t >> 8;
    float q[64];
    { const v4u* qp = (const v4u*)(U + (size_t)(b * SEQ + t) * NIN + UQ + h * 64);
#pragma unroll
      for (int c = 0; c < 8; ++c) { const v4u w = qp[c]; q[8*c] = bf2f(w.x & 0xffff); q[8*c+1] = bf2f(w.x >> 16); q[8*c+2] = bf2f(w.y & 0xffff); q[8*c+3] = bf2f(w.y >> 16);
          q[8*c+4] = bf2f(w.z & 0xffff); q[8*c+5] = bf2f(w.z >> 16); q[8*c+6] = bf2f(w.w & 0xffff); q[8*c+7] = bf2f(w.w >> 16); } }
    unsigned sel = 0;
    if (blk <= 3) sel = (1u << blk) - 1u;
    else {
        float gate[8];
        const float qd = bf2f(U[(size_t)(b * SEQ + t) * NIN + UQ + h * 64 + lane]);
#pragma unroll
        for (int j = 0; j < 8; ++j) { const float g = wave_sum(qd * KM[((size_t)bh * 8 + j) * 64 + lane]); gate[j] = j < blk ? g : -3e38f; }
#pragma unroll
        for (int r = 0; r < 3; ++r) { int best = 0; float bv = -3.4e38f;
#pragma unroll
            for (int j = 0; j < 8; ++j) { const bool ok = !((sel >> j) & 1u) && gate[j] > bv; bv = ok ? gate[j] : bv; best = ok ? j : best; }
            sel |= 1u << best; }
    }
#pragma unroll 1
    for (int dh = 0; dh < 2; ++dh) {
        float m = -1e30f, lsum = 0.f, o[32];
#pragma unroll
        for (int d = 0; d < 32; ++d) o[d] = 0.f;
        for (int jb = 0; jb <= blk; ++jb) {
            const bool own = jb == blk;
            if (!own && !((sel >> jb) & 1u)) continue;
            const int kend = own ? (t & 255) + 1 : 256;
            for (int kk = lane; kk < kend; kk += 64) {
                const v4u* kp = (const v4u*)(U + (size_t)(b * SEQ + jb * 256 + kk) * NIN + UK + h * 64);
                float s = 0.f;
#pragma unroll
                for (int c = 0; c < 8; ++c) { const v4u w = kp[c];
                    s += q[8*c] * bf2f(w.x & 0xffff) + q[8*c+1] * bf2f(w.x >> 16) + q[8*c+2] * bf2f(w.y & 0xffff) + q[8*c+3] * bf2f(w.y >> 16)
                       + q[8*c+4] * bf2f(w.z & 0xffff) + q[8*c+5] * bf2f(w.z >> 16) + q[8*c+6] * bf2f(w.w & 0xffff) + q[8*c+7] * bf2f(w.w >> 16); }
                s *= 0.125f;
                const float mn = fmaxf(m, s), a = __expf(m - mn), p = __expf(s - mn);
                lsum = lsum * a + p; m = mn;
                const v4u* vp = (const v4u*)((const bf16*)kp + 384 + dh * 32);
#pragma unroll
                for (int c = 0; c < 4; ++c) { const v4u w = vp[c];
                    o[8*c] = o[8*c] * a + p * bf2f(w.x & 0xffff); o[8*c+1] = o[8*c+1] * a + p * bf2f(w.x >> 16); o[8*c+2] = o[8*c+2] * a + p * bf2f(w.y & 0xffff); o[8*c+3] = o[8*c+3] * a + p * bf2f(w.y >> 16);
                    o[8*c+4] = o[8*c+4] * a + p * bf2f(w.z & 0xffff); o[8*c+5] = o[8*c+5] * a + p * bf2f(w.z >> 16); o[8*c+6] = o[8*c+6] * a + p * bf2f(w.w & 0xffff); o[8*c+7] = o[8*c+7] * a + p * bf2f(w.w >> 16); }
            }
        }
        const float M = wave_max(m), sc = __expf(m - M);
        const float L = wave_sum(lsum * sc);
        float outv = 0.f;
#pragma unroll
        for (int d = 0; d < 32; ++d) { const float s = wave_sum(o[d] * sc); outv = lane == d ? s : outv; }
        if (lane < 32) MIX[(size_t)(b * SEQ + t) * D + h * 64 + dh * 32 + lane] = (bf16)f2bf(outv / L);
    }
}
__device__ __forceinline__ void naive_ssd(const Params& P, int l, int bh, LAS unsigned char* lds, int tid) {
    const bf16* U = (const bf16*)(P.ws + WS_U); const float* DT = (const float*)(P.ws + WS_DT); float* YT = (float*)(P.ws + WS_ST);
    const int b = bh / 6, h = bh % 6, g = h / 3;
    LAS float* xs = (LAS float*)lds; LAS float* Bs = xs + 32 * 64; LAS float* Cs = Bs + 32 * 128; LAS float* dts = Cs + 32 * 128; LAS float* dAs = dts + 32;
    const float a = -__expf(P.in[I_ALOG][l * 6 + h]), Dk = P.in[I_DSKIP][l * 6 + h];
    const float* cw = P.in[I_CONVW] + (size_t)l * 4 * XBC; const float* cb = P.in[I_CONVB] + (size_t)l * XBC;
    const int p = tid >> 3, ns = (tid & 7) * 16;
    float hst[16];
#pragma unroll
    for (int i = 0; i < 16; ++i) hst[i] = 0.f;
    for (int t0 = 0; t0 < SEQ; t0 += 32) {
        __syncthreads();
        for (int idx = tid; idx < 32 * 320; idx += 512) {
            const int tt = idx / 320, c = idx % 320;
            const int ch = c < 64 ? h * 64 + c : (c < 192 ? 384 + g * 128 + (c - 64) : 640 + g * 128 + (c - 192));
            float acc = cb[ch];
#pragma unroll
            for (int k = 0; k < 4; ++k) { const int ts = t0 + tt - 3 + k; if (ts >= 0) acc += cw[k * XBC + ch] * bf2f(U[(size_t)(b * SEQ + ts) * NIN + UXS + ch]); }
            const float v = silu(acc);
            if (c < 64) xs[tt * 64 + c] = v; else if (c < 192) Bs[tt * 128 + c - 64] = v; else Cs[tt * 128 + c - 192] = v;
        }
        if (tid < 32) { const float dt = DT[(size_t)(b * SEQ + t0 + tid) * 8 + h]; dts[tid] = dt; dAs[tid] = __expf(dt * a); }
        __syncthreads();
        for (int tt = 0; tt < 32; ++tt) {
            const float xv = xs[tt * 64 + p], dA = dAs[tt], coef = dts[tt] * xv;
            float y = 0.f;
#pragma unroll
            for (int i = 0; i < 16; ++i) { hst[i] = hst[i] * dA + coef * Bs[tt * 128 + ns + i]; y += hst[i] * Cs[tt * 128 + ns + i]; }
            y += SWZ_XOR(y, 1); y += SWZ_XOR(y, 2); y += SWZ_XOR(y, 4);
            if ((tid & 7) == 0) { const size_t row = (size_t)(b * SEQ + t0 + tt);
                const float z = bf2f(U[row * NIN + UZ + h * 64 + p]);
                YT[row * 384 + h * 64 + p] = (y + Dk * xv) * silu(z); }
        }
    }
}
__device__ __forceinline__ void naive_ssd_norm(const Params& P, int l, int bid, int G, int wid, int lane) {
    const float* YT = (const float*)(P.ws + WS_ST); bf16* MIX = (bf16*)(P.ws + WS_H);
    for (int it = bid * 8 + wid; it < T * 2; it += G * 8) {
        const int row = it >> 1, g = it & 1;
        const float* y = YT + (size_t)row * 384 + g * 192;
        const float v0 = y[lane], v1 = y[lane + 64], v2 = y[lane + 128];
        const float r = rsqrtf(wave_sum(v0 * v0 + v1 * v1 + v2 * v2) * (1.f / 192.f) + EPS);
        const float* nw = P.in[I_SSDN] + l * 384 + g * 192;
        bf16* o = MIX + (size_t)row * D + 384 + g * 192;
        o[lane] = (bf16)f2bf(v0 * r * nw[lane]); o[lane + 64] = (bf16)f2bf(v1 * r * nw[lane + 64]); o[lane + 128] = (bf16)f2bf(v2 * r * nw[lane + 128]);
    }
}
__device__ __forceinline__ void naive_pool(const Params& P, int l, int item, LAS unsigned char* lds, int tid) {
    const bf16* U = (const bf16*)(P.ws + WS_U); bf16* MIX = (bf16*)(P.ws + WS_H);
    LAS float* diff = (LAS float*)lds;
    const int tok0 = item * 8;
    __syncthreads();
    for (int idx = tid; idx < 8 * 256; idx += 512) { const int tt = idx >> 8, c = idx & 255, g = c >> 6, W = 2 << g; const int row = tok0 + tt, pos = row & (SEQ - 1);
        const int cnt = pos + 1 < W ? pos + 1 : W; float s = 0.f;
        for (int i = 0; i < cnt; ++i) s += bf2f(U[(size_t)(row - i) * NIN + UP + c]);
        diff[idx] = s / (float)cnt - bf2f(U[(size_t)row * NIN + UP + c]); }
    __syncthreads();
    for (int idx = tid; idx < 8 * 256; idx += 512) { const int tt = idx >> 8, dc = idx & 255, g = dc >> 6, dd = dc & 63;
        const float* w = P.in[I_POOLW] + ((size_t)(l * 4 + g) * 64) * 64 + dd; float acc = 0.f;
        for (int c = 0; c < 64; ++c) acc += diff[tt * 256 + g * 64 + c] * w[c * 64];
        MIX[(size_t)(tok0 + tt) * D + 768 + dc] = (bf16)f2bf(acc * P.in[I_POOLS][l * 256 + dc]); }
}
typedef float f32x16 __attribute__((ext_vector_type(16)));
typedef short s16x8 __attribute__((ext_vector_type(8)));
typedef short s16x4 __attribute__((ext_vector_type(4)));
typedef short v4i16_t __attribute__((ext_vector_type(4)));
#define MFMA32(a, b, c) __builtin_amdgcn_mfma_f32_32x32x16_bf16((a), (b), (c), 0, 0, 0)
__device__ __forceinline__ s16x4 lds_tr(LAS const unsigned char* p) { return __builtin_bit_cast(s16x4, __builtin_amdgcn_ds_read_tr16_b64_v4i16((LAS v4i16_t*)p)); }
__device__ __forceinline__ float xhalf_sum(float v) { float a = v, b = v; asm volatile("s_nop 1\n\tv_permlane32_swap_b32 %0, %1" : "+v"(a), "+v"(b)); return a + b; }
__device__ __forceinline__ float xhalf_max(float v) { float a = v, b = v; asm volatile("s_nop 1\n\tv_permlane32_swap_b32 %0, %1" : "+v"(a), "+v"(b)); return fmaxf(a, b); }
typedef float f32x2_t __attribute__((ext_vector_type(2)));
typedef __bf16 bf16x2_t __attribute__((ext_vector_type(2)));
__device__ __forceinline__ unsigned cvtpk(float lo, float hi) { const f32x2_t v = {lo, hi}; const bf16x2_t b = __builtin_convertvector(v, bf16x2_t); return __builtin_bit_cast(unsigned, b); }
constexpr int AT_KS = 144;
constexpr int AT_BLK = 256 * AT_KS;
constexpr int AT_K0 = 0, AT_V0 = AT_BLK, AT_KM = 2 * AT_BLK, AT_PART = AT_KM + 8 * 64 * 4;
__device__ __forceinline__ void attn_unit(const Params& P, int b, int h, int blk, LAS unsigned char* lds, int tid, int wid, int lane) {
    const bf16* U = (const bf16*)(P.ws + WS_U); bf16* MIX = (bf16*)(P.ws + WS_H);
    const int r = lane & 31, hh = lane >> 5;
    const size_t row0 = (size_t)b * SEQ;
    LAS float* KM = (LAS float*)(lds + AT_KM);
    const int ldrow = tid >> 3, ldch = tid & 7;
    const bf16* kvbase = U + (row0 + ldrow) * NIN + UK + h * 64 + ldch * 8;
    const int ldoff = ldrow * AT_KS + ldch * 16;
    auto blk_key0 = [&](int i) { return i == 0 ? blk * 256 : (i - 1) * 256; };
    v4u kreg[4], vreg[4];
#define AT_LOAD(i) do { const bf16* p_ = kvbase + (size_t)blk_key0(i) * NIN; _Pragma("unroll") for (int j_ = 0; j_ < 4; ++j_) { kreg[j_] = *(const v4u*)(p_ + (size_t)(64 * j_) * NIN); vreg[j_] = *(const v4u*)(p_ + (size_t)(64 * j_) * NIN + 384); } } while (0)
#define AT_STORE() do { _Pragma("unroll") for (int j_ = 0; j_ < 4; ++j_) { *(LAS v4u*)(lds + AT_K0 + 64 * j_ * AT_KS + ldoff) = kreg[j_]; *(LAS v4u*)(lds + AT_V0 + 64 * j_ * AT_KS + ldoff) = vreg[j_]; } } while (0)
    AT_LOAD(0);
    __syncthreads();
    if (blk >= 4) {
        LAS float* part = (LAS float*)(lds + AT_PART);
        const int d2 = tid & 31, kg = tid >> 5;
        for (int j = 0; j < blk; ++j) {
            const unsigned* kp = (const unsigned*)(U + (row0 + j * 256 + kg * 16) * NIN + UK + h * 64) + d2;
            float s0 = 0.f, s1 = 0.f;
#pragma unroll
            for (int i = 0; i < 16; ++i) { const unsigned w = kp[(size_t)i * (NIN / 2)]; s0 += bf2f(w & 0xffff); s1 += bf2f(w >> 16); }
            part[(j * 16 + kg) * 64 + 2 * d2] = s0; part[(j * 16 + kg) * 64 + 2 * d2 + 1] = s1;
        }
        __syncthreads();
        if (tid < blk * 64) { const int j = tid >> 6, d = tid & 63; float s = 0.f;
#pragma unroll
            for (int k = 0; k < 16; ++k) s += part[(j * 16 + k) * 64 + d];
            KM[j * 64 + d] = s * (1.f / 256.f); }
    }
    AT_STORE();
    __syncthreads();
    const int qrow = blk * 256 + wid * 32 + r;
    s16x8 qf[4];
    { const v4u* qp = (const v4u*)(U + (row0 + qrow) * NIN + UQ + h * 64 + 8 * hh);
#pragma unroll
      for (int s = 0; s < 4; ++s) qf[s] = __builtin_bit_cast(s16x8, qp[2 * s]); }
    unsigned sel = (1u << blk) - 1u;
    if (blk >= 4) {
        float gate[8];
#pragma unroll
        for (int j = 0; j < 8; ++j) gate[j] = -3e38f;
#pragma unroll
        for (int j = 0; j < 7; ++j) if (j < blk) { float g = 0.f;
#pragma unroll
            for (int s = 0; s < 4; ++s) {
                const f32x4 k0 = *(LAS const f32x4*)(KM + j * 64 + 16 * s + 8 * hh), k1 = *(LAS const f32x4*)(KM + j * 64 + 16 * s + 8 * hh + 4);
                g += bf2f((unsigned short)qf[s][0]) * k0.x + bf2f((unsigned short)qf[s][1]) * k0.y + bf2f((unsigned short)qf[s][2]) * k0.z + bf2f((unsigned short)qf[s][3]) * k0.w
                   + bf2f((unsigned short)qf[s][4]) * k1.x + bf2f((unsigned short)qf[s][5]) * k1.y + bf2f((unsigned short)qf[s][6]) * k1.z + bf2f((unsigned short)qf[s][7]) * k1.w; }
            gate[j] = xhalf_sum(g); }
        sel = 0u;
#pragma unroll
        for (int t = 0; t < 3; ++t) { int best = 0; float bv = -3.4e38f;
#pragma unroll
            for (int j = 0; j < 8; ++j) { const bool ok = !((sel >> j) & 1u) && gate[j] > bv; bv = ok ? gate[j] : bv; best = ok ? j : best; }
            sel |= 1u << best; }
    }
    f32x16 o0, o1;
#pragma unroll
    for (int i = 0; i < 16; ++i) { o0[i] = 0.f; o1[i] = 0.f; }
    float m = -1e30f, lsum = 0.f;
    const float SC = 0.125f * 1.44269504088896f;
    const int i16 = lane & 15, b16 = (lane >> 4) & 1;
    const int troff = (i16 >> 2) * AT_KS + (16 * b16) * 2 + 8 * (i16 & 3);
    const int qpos = 32 * wid + r;
    for (int bi = 0; bi <= blk; ++bi) {
        if (bi < blk) AT_LOAD(bi + 1);
        const int jpast = bi - 1;
        const bool lane_on = (bi == 0) || ((sel >> jpast) & 1u);
        const bool need_blk = (bi == 0) || (__builtin_amdgcn_ballot_w64(lane_on) != 0ull);
        if (need_blk) {
            const int nt = bi == 0 ? ((32 * wid + 31) >> 6) + 1 : 4;
            for (int kt = 0; kt < nt; ++kt) {
                LAS const unsigned char* Kt = lds + AT_K0 + kt * 64 * AT_KS; LAS const unsigned char* Vt = lds + AT_V0 + kt * 64 * AT_KS;
                f32x16 sA, sB;
#pragma unroll
                for (int e = 0; e < 16; ++e) { sA[e] = 0.f; sB[e] = 0.f; }
#pragma unroll
                for (int s = 0; s < 4; ++s) {
                    const s16x8 ka = *(LAS const s16x8*)(Kt + r * AT_KS + 32 * s + 16 * hh);
                    const s16x8 kb = *(LAS const s16x8*)(Kt + (32 + r) * AT_KS + 32 * s + 16 * hh);
                    sA = MFMA32(ka, qf[s], sA); sB = MFMA32(kb, qf[s], sB);
                }
                if (bi == 0 && kt == nt - 1) {
#pragma unroll
                    for (int e = 0; e < 16; ++e) { const int kr = (e & 3) + 8 * (e >> 2) + 4 * hh;
                        if (64 * kt + kr > qpos) sA[e] = -3e38f; if (64 * kt + 32 + kr > qpos) sB[e] = -3e38f; }
                }
                float mx = fmaxf(sA[0], sB[0]);
#pragma unroll
                for (int e = 1; e < 16; ++e) mx = fmaxf(mx, fmaxf(sA[e], sB[e]));
                mx = lane_on ? mx * SC : -1e30f;
                mx = xhalf_max(mx);
                const float mn = fmaxf(m, mx);
                const float nb = lane_on ? -mn : -3e38f;
                if (__builtin_amdgcn_ballot_w64(mn > m) != 0ull) {
                    const float alpha = __builtin_amdgcn_exp2f(m - mn);
                    lsum *= alpha;
#pragma unroll
                    for (int e = 0; e < 16; ++e) { o0[e] *= alpha; o1[e] *= alpha; }
                    m = mn;
                }
                float ps = 0.f;
#pragma unroll
                for (int e = 0; e < 16; ++e) { sA[e] = __builtin_amdgcn_exp2f(__builtin_fmaf(sA[e], SC, nb)); sB[e] = __builtin_amdgcn_exp2f(__builtin_fmaf(sB[e], SC, nb)); ps += sA[e] + sB[e]; }
                lsum += ps;
#pragma unroll
                for (int sub = 0; sub < 2; ++sub)
#pragma unroll
                    for (int s2 = 0; s2 < 2; ++s2) {
                        s16x8 pb;
#pragma unroll
                        for (int jj = 0; jj < 8; jj += 2) { const float x0 = sub ? sB[8 * s2 + jj] : sA[8 * s2 + jj], x1 = sub ? sB[8 * s2 + jj + 1] : sA[8 * s2 + jj + 1];
                            const unsigned w = cvtpk(x0, x1); pb[jj] = (short)(w & 0xffff); pb[jj + 1] = (short)(w >> 16); }
                        const int klo = 32 * sub + 16 * s2 + 4 * hh;
#pragma unroll
                        for (int db = 0; db < 2; ++db) {
                            const s16x4 lo = lds_tr(Vt + klo * AT_KS + troff + 64 * db), hi = lds_tr(Vt + (klo + 8) * AT_KS + troff + 64 * db);
                            const s16x8 va = __builtin_shufflevector(lo, hi, 0, 1, 2, 3, 4, 5, 6, 7);
                            if (db == 0) o0 = MFMA32(va, pb, o0); else o1 = MFMA32(va, pb, o1);
                        }
                    }
            }
        }
        if (bi < blk) { __syncthreads(); AT_STORE(); __syncthreads(); }
    }
#undef AT_LOAD
#undef AT_STORE
    const float inv = 1.f / xhalf_sum(lsum);
    bf16* orow = MIX + (row0 + qrow) * D + h * 64 + 4 * hh;
#pragma unroll
    for (int g = 0; g < 4; ++g) {
        v2u w0, w1;
        w0.x = pk2(o0[4 * g] * inv, o0[4 * g + 1] * inv); w0.y = pk2(o0[4 * g + 2] * inv, o0[4 * g + 3] * inv);
        w1.x = pk2(o1[4 * g] * inv, o1[4 * g + 1] * inv); w1.y = pk2(o1[4 * g + 2] * inv, o1[4 * g + 3] * inv);
        *(v2u*)(orow + 8 * g) = w0; *(v2u*)(orow + 32 + 8 * g) = w1;
    }
}
constexpr int SX_S = 400, SB_S = 272;
constexpr int S_X = 0, S_B = 51200, S_C = 86016, S_PREV = 120832, S_DT = 138240, S_AC = S_DT + 1536, S_DA = S_AC + 1536;
__device__ __forceinline__ int crow16(int i, int hh) { return (i & 3) + 8 * (i >> 2) + 4 * hh; }
template <bool PHASE_A>
__device__ __forceinline__ void ssd_stage(const Params& P, int l, int b, int c, int g, LAS unsigned char* lds, int tid) {
    const bf16* U = (const bf16*)(P.ws + WS_U); const float* DT = (const float*)(P.ws + WS_DT);
    const float* alog = P.in[I_ALOG]; const float* convw = P.in[I_CONVW]; const float* convb = P.in[I_CONVB];
    asm volatile("" : "+s"(alog), "+s"(convw), "+s"(convb));
    const size_t row0 = (size_t)b * SEQ + c * 128;
    LAS float* dts = (LAS float*)(lds + S_DT); LAS float* acs = (LAS float*)(lds + S_AC); LAS float* das = (LAS float*)(lds + S_DA);
    if (tid < 384) { const int hh3 = tid >> 7, li = tid & 127, h = 3 * g + hh3; const float dt = DT[(row0 + li) * 8 + h]; dts[tid] = dt; das[tid] = dt * -__expf(alog[l * 6 + h]); }
    __syncthreads();
    if (tid < 384) { const int hh3 = tid >> 7, li = tid & 127; float s = 0.f; for (int i = 0; i <= li; ++i) s += das[hh3 * 128 + i]; acs[tid] = s; }
    __syncthreads();
    const int cc = tid & 63, tg = tid >> 6;
    if (cc < (PHASE_A ? 40 : 56)) {
        const int ch = cc < 24 ? g * 192 + cc * 8 : (cc < 40 ? 384 + g * 128 + (cc - 24) * 8 : 640 + g * 128 + (cc - 40) * 8);
        const float* cw = convw + (size_t)l * 4 * XBC + ch; const float* cb = convb + (size_t)l * XBC + ch;
        float w[4][8], bias[8], xw[3][8];
#pragma unroll
        for (int k = 0; k < 4; ++k) { const f32x4 a = *(const f32x4*)(cw + k * XBC), d = *(const f32x4*)(cw + k * XBC + 4);
            w[k][0] = a.x; w[k][1] = a.y; w[k][2] = a.z; w[k][3] = a.w; w[k][4] = d.x; w[k][5] = d.y; w[k][6] = d.z; w[k][7] = d.w; }
        { const f32x4 a = *(const f32x4*)cb, d = *(const f32x4*)(cb + 4); bias[0] = a.x; bias[1] = a.y; bias[2] = a.z; bias[3] = a.w; bias[4] = d.x; bias[5] = d.y; bias[6] = d.z; bias[7] = d.w; }
        const bf16* src = U + (row0 + tg * 16) * NIN + UXS + ch;
        const bool has_prev = !(c == 0 && tg == 0);
#pragma unroll
        for (int k = 0; k < 3; ++k) { v4u q = {0u, 0u, 0u, 0u}; if (has_prev) q = *(const v4u*)(src - (size_t)(3 - k) * NIN);
            xw[k][0] = bf2f(q.x & 0xffff); xw[k][1] = bf2f(q.x >> 16); xw[k][2] = bf2f(q.y & 0xffff); xw[k][3] = bf2f(q.y >> 16);
            xw[k][4] = bf2f(q.z & 0xffff); xw[k][5] = bf2f(q.z >> 16); xw[k][6] = bf2f(q.w & 0xffff); xw[k][7] = bf2f(q.w >> 16); }
        const int hh3 = cc >> 3;
        const float ac_end = acs[(cc < 24 ? hh3 : 0) * 128 + 127];
        LAS unsigned char* dst = lds + (cc < 24 ? S_X + cc * 16 : (cc < 40 ? S_B + (cc - 24) * 16 : S_C + (cc - 40) * 16));
        const int dstride = cc < 24 ? SX_S : SB_S;
#pragma unroll
        for (int t = 0; t < 16; ++t) {
            const v4u q = *(const v4u*)(src + (size_t)t * NIN);
            float cur[8] = {bf2f(q.x & 0xffff), bf2f(q.x >> 16), bf2f(q.y & 0xffff), bf2f(q.y >> 16), bf2f(q.z & 0xffff), bf2f(q.z >> 16), bf2f(q.w & 0xffff), bf2f(q.w >> 16)};
            const int tok = tg * 16 + t;
            float sc = 1.f;
            if (PHASE_A && cc < 24) sc = dts[hh3 * 128 + tok] * __expf(ac_end - acs[hh3 * 128 + tok]);
            float o[8];
#pragma unroll
            for (int j = 0; j < 8; ++j) { const float a = bias[j] + w[0][j] * xw[0][j] + w[1][j] * xw[1][j] + w[2][j] * xw[2][j] + w[3][j] * cur[j]; o[j] = silu(a) * sc;
                xw[0][j] = xw[1][j]; xw[1][j] = xw[2][j]; xw[2][j] = cur[j]; }
            v4u pk; pk.x = pk2(o[0], o[1]); pk.y = pk2(o[2], o[3]); pk.z = pk2(o[4], o[5]); pk.w = pk2(o[6], o[7]);
            *(LAS v4u*)(dst + tok * dstride) = pk;
        }
    }
    __syncthreads();
}
__device__ __forceinline__ void ssd_unit_a(const Params& P, int l, int b, int c, int g, LAS unsigned char* lds, int tid, int wid, int lane) {
    __syncthreads();
    ssd_stage<true>(P, l, b, c, g, lds, tid);
    LAS float* acs = (LAS float*)(lds + S_AC);
    if (tid < 3) ((float*)(P.ws + WS_CD))[(b * 16 + c) * 6 + 3 * g + tid] = __expf(acs[tid * 128 + 127]);
    const int r = lane & 31, hh = lane >> 5, nt = wid & 3, pt = wid >> 2, i16 = lane & 15, b16 = (lane >> 4) & 1;
    const int troffB = (i16 >> 2) * SB_S + (32 * nt + 16 * b16) * 2 + 8 * (i16 & 3);
    s16x8 bfr[8];
#pragma unroll
    for (int s = 0; s < 8; ++s) { const int k0 = 16 * s + 8 * hh;
        const s16x4 lo = lds_tr(lds + S_B + k0 * SB_S + troffB), hi = lds_tr(lds + S_B + (k0 + 4) * SB_S + troffB);
        bfr[s] = __builtin_shufflevector(lo, hi, 0, 1, 2, 3, 4, 5, 6, 7); }
    float* ST = (float*)(P.ws + WS_ST);
#pragma unroll
    for (int hh3 = 0; hh3 < 3; ++hh3) {
        const int troffX = (i16 >> 2) * SX_S + (hh3 * 64 + 32 * pt + 16 * b16) * 2 + 8 * (i16 & 3);
        f32x16 acc;
#pragma unroll
        for (int e = 0; e < 16; ++e) acc[e] = 0.f;
#pragma unroll
        for (int s = 0; s < 8; ++s) { const int k0 = 16 * s + 8 * hh;
            const s16x4 lo = lds_tr(lds + S_X + k0 * SX_S + troffX), hi = lds_tr(lds + S_X + (k0 + 4) * SX_S + troffX);
            const s16x8 xa = __builtin_shufflevector(lo, hi, 0, 1, 2, 3, 4, 5, 6, 7);
            acc = MFMA32(xa, bfr[s], acc); }
        float* S = ST + ((size_t)((b * 16 + c) * 6 + 3 * g + hh3)) * 8192;
#pragma unroll
        for (int e = 0; e < 16; ++e) S[(32 * pt + crow16(e, hh)) * 128 + 32 * nt + r] = acc[e];
    }
}
__device__ __forceinline__ void ssd_scan(const Params& P, int bid, int G, int tid) {
    const float* ST = (const float*)(P.ws + WS_ST); const float* CD = (const float*)(P.ws + WS_CD); bf16* PV = (bf16*)(P.ws + WS_PREV);
    for (int it = bid * 512 + tid; it < BATCH * 6 * 2048; it += G * 512) {
        const int bh = it >> 11, e4 = (it & 2047) * 4, b = bh / 6, h = bh % 6;
        f32x4 sv[15]; float dv[15];
#pragma unroll
        for (int c = 0; c < 15; ++c) { sv[c] = *(const f32x4*)(ST + ((size_t)((b * 16 + c) * 6 + h)) * 8192 + e4); dv[c] = CD[(b * 16 + c) * 6 + h]; }
        f32x4 acc = {0.f, 0.f, 0.f, 0.f};
#pragma unroll
        for (int c = 0; c < 16; ++c) {
            v2u w; w.x = pk2(acc.x, acc.y); w.y = pk2(acc.z, acc.w);
            *(v2u*)(PV + ((size_t)((b * 16 + c) * 6 + h)) * 8192 + e4) = w;
            if (c < 15) acc = acc * dv[c] + sv[c];
        }
    }
}
__device__ __forceinline__ void ssd_unit_b(const Params& P, int l, int b, int c, int g, LAS unsigned char* lds, int tid, int wid, int lane) {
    const float* dskip = P.in[I_DSKIP]; const float* ssdn = P.in[I_SSDN];
    asm volatile("" : "+s"(dskip), "+s"(ssdn));
    __syncthreads();
    ssd_stage<false>(P, l, b, c, g, lds, tid);
    const bf16* U = (const bf16*)(P.ws + WS_U); bf16* MIX = (bf16*)(P.ws + WS_H);
    const bf16* PV = (const bf16*)(P.ws + WS_PREV);
    LAS float* dts = (LAS float*)(lds + S_DT); LAS float* acs = (LAS float*)(lds + S_AC); LAS float* ssb = (LAS float*)(lds + S_DA);
    const size_t row0 = (size_t)b * SEQ + c * 128;
    const int r = lane & 31, hh = lane >> 5, lt = wid & 3, pb = wid >> 2, i16 = lane & 15, b16 = (lane >> 4) & 1;
#define CF(s) (*(LAS const s16x8*)(lds + S_C + (32 * lt + r) * SB_S + (16 * (s) + 8 * hh) * 2))
    f32x16 Y[3];
#pragma unroll
    for (int hh3 = 0; hh3 < 3; ++hh3) {
        const int h = 3 * g + hh3;
        __syncthreads();
        { const v4u* src = (const v4u*)(PV + ((size_t)((b * 16 + c) * 6 + h)) * 8192) + tid;
          const v4u q0 = src[0], q1 = src[512];
          *(LAS v4u*)(lds + S_PREV + (tid >> 4) * SB_S + (tid & 15) * 16) = q0; *(LAS v4u*)(lds + S_PREV + (32 + (tid >> 4)) * SB_S + (tid & 15) * 16) = q1; }
        __syncthreads();
        f32x16 acc;
#pragma unroll
        for (int e = 0; e < 16; ++e) acc[e] = 0.f;
#pragma unroll
        for (int s = 0; s < 8; ++s) { const s16x8 a = *(LAS const s16x8*)(lds + S_PREV + (32 * pb + r) * SB_S + (16 * s + 8 * hh) * 2); acc = MFMA32(a, CF(s), acc); }
        const float el = __expf(acs[hh3 * 128 + 32 * lt + r]);
#pragma unroll
        for (int e = 0; e < 16; ++e) Y[hh3][e] = acc[e] * el;
    }
    for (int st = 0; st <= lt; ++st) {
        f32x16 Gt;
#pragma unroll
        for (int e = 0; e < 16; ++e) Gt[e] = 0.f;
#pragma unroll
        for (int s = 0; s < 8; ++s) { const s16x8 a = *(LAS const s16x8*)(lds + S_B + (32 * st + r) * SB_S + (16 * s + 8 * hh) * 2); Gt = MFMA32(a, CF(s), Gt); }
#pragma unroll
        for (int hh3 = 0; hh3 < 3; ++hh3) {
            const float acl = acs[hh3 * 128 + 32 * lt + r];
            const int troffX = (i16 >> 2) * SX_S + (hh3 * 64 + 32 * pb + 16 * b16) * 2 + 8 * (i16 & 3);
#pragma unroll
            for (int s2 = 0; s2 < 2; ++s2) {
                s16x8 pbk;
#pragma unroll
                for (int jj = 0; jj < 8; jj += 2) {
                    float mv[2];
#pragma unroll
                    for (int t = 0; t < 2; ++t) { const int e = 8 * s2 + jj + t, kr = crow16(e, hh), stok = 32 * st + kr;
                        const bool valid = (st < lt) || (kr <= r);
                        const float v = Gt[e] * __expf(fminf(acl - acs[hh3 * 128 + stok], 0.f)) * dts[hh3 * 128 + stok];
                        mv[t] = valid ? v : 0.f; }
                    const unsigned w = pk2(mv[0], mv[1]); pbk[jj] = (short)(w & 0xffff); pbk[jj + 1] = (short)(w >> 16); }
                const int klo = 32 * st + 16 * s2 + 4 * hh;
                const s16x4 lo = lds_tr(lds + S_X + klo * SX_S + troffX), hi = lds_tr(lds + S_X + (klo + 8) * SX_S + troffX);
                const s16x8 xa = __builtin_shufflevector(lo, hi, 0, 1, 2, 3, 4, 5, 6, 7);
                Y[hh3] = MFMA32(xa, pbk, Y[hh3]);
                __builtin_amdgcn_sched_barrier(0);
            }
        }
    }
    float ssq = 0.f;
    const size_t grow = row0 + 32 * lt + r;
#pragma unroll
    for (int hh3 = 0; hh3 < 3; ++hh3) { const int h = 3 * g + hh3; const float Dk = dskip[l * 6 + h];
#pragma unroll
        for (int q4 = 0; q4 < 4; ++q4) { const int p0 = 32 * pb + 8 * q4 + 4 * hh;
            const v2u xr = *(LAS const v2u*)(lds + S_X + (32 * lt + r) * SX_S + (hh3 * 64 + p0) * 2);
            const v2u zr = *(const v2u*)(U + grow * NIN + UZ + h * 64 + p0);
            const f32x4 xv = {bf2f(xr.x & 0xffff), bf2f(xr.x >> 16), bf2f(xr.y & 0xffff), bf2f(xr.y >> 16)};
            const f32x4 zv = {bf2f(zr.x & 0xffff), bf2f(zr.x >> 16), bf2f(zr.y & 0xffff), bf2f(zr.y >> 16)};
#pragma unroll
            for (int e = 0; e < 4; ++e) { const float y = (Y[hh3][4 * q4 + e] + Dk * xv[e]) * silu(zv[e]); Y[hh3][4 * q4 + e] = y; ssq += y * y; } } }
    ssq = xhalf_sum(ssq);
    if (hh == 0) ssb[pb * 128 + 32 * lt + r] = ssq;
    __syncthreads();
    const float rs = rsqrtf((ssb[32 * lt + r] + ssb[128 + 32 * lt + r]) * (1.f / 192.f) + EPS);
#pragma unroll
    for (int hh3 = 0; hh3 < 3; ++hh3)
#pragma unroll
        for (int q4 = 0; q4 < 4; ++q4) { const int p0 = 32 * pb + 8 * q4 + 4 * hh, chn = g * 192 + hh3 * 64 + p0;
            const f32x4 nw = *(const f32x4*)(ssdn + l * 384 + chn);
            v2u w; w.x = pk2(Y[hh3][4 * q4] * rs * nw.x, Y[hh3][4 * q4 + 1] * rs * nw.y); w.y = pk2(Y[hh3][4 * q4 + 2] * rs * nw.z, Y[hh3][4 * q4 + 3] * rs * nw.w);
            *(v2u*)(MIX + grow * D + 384 + chn) = w; }
}
constexpr int PL_S = 528;
__device__ __forceinline__ void pool_unit(const Params& P, int l, int unit, LAS unsigned char* lds, int tid, int wid, int lane) {
    const bf16* U = (const bf16*)(P.ws + WS_U); bf16* MIX = (bf16*)(P.ws + WS_H);
    const bf16* pwt = (const bf16*)(P.ws + WS_PWT) + (size_t)l * 4 * 4096;
    const float* pscale = P.in[I_POOLS]; asm volatile("" : "+s"(pscale));
    const size_t row0 = (size_t)unit * 64;
    __syncthreads();
    { const int cc = tid & 31, ts = tid >> 5, g = cc >> 3, W = 2 << g;
      const bf16* src = U + row0 * NIN + UP + cc * 8;
      f32x4 s0 = {0.f, 0.f, 0.f, 0.f}, s1 = s0;
      const int t0 = ts * 4, pos0 = (int)((row0 + t0) & (SEQ - 1));
#pragma unroll
      for (int i = 1; i < 16; ++i) if (i < W && i <= pos0) { const v4u q = *(const v4u*)(src + (ptrdiff_t)(t0 - i) * NIN);
          s0.x += bf2f(q.x & 0xffff); s0.y += bf2f(q.x >> 16); s0.z += bf2f(q.y & 0xffff); s0.w += bf2f(q.y >> 16);
          s1.x += bf2f(q.z & 0xffff); s1.y += bf2f(q.z >> 16); s1.z += bf2f(q.w & 0xffff); s1.w += bf2f(q.w >> 16); }
#pragma unroll
      for (int t = 0; t < 4; ++t) {
          const int tok = t0 + t, pos = pos0 + t;
          const v4u q = *(const v4u*)(src + (size_t)tok * NIN);
          const f32x4 x0 = {bf2f(q.x & 0xffff), bf2f(q.x >> 16), bf2f(q.y & 0xffff), bf2f(q.y >> 16)}, x1 = {bf2f(q.z & 0xffff), bf2f(q.z >> 16), bf2f(q.w & 0xffff), bf2f(q.w >> 16)};
          s0 += x0; s1 += x1;
          if (t > 0 && pos - W >= 0) { const v4u o = *(const v4u*)(src + (ptrdiff_t)(tok - W) * NIN);
              const f32x4 y0 = {bf2f(o.x & 0xffff), bf2f(o.x >> 16), bf2f(o.y & 0xffff), bf2f(o.y >> 16)}, y1 = {bf2f(o.z & 0xffff), bf2f(o.z >> 16), bf2f(o.w & 0xffff), bf2f(o.w >> 16)};
              s0 -= y0; s1 -= y1; }
          const float inv = 1.f / (float)(pos + 1 < W ? pos + 1 : W);
          const f32x4 d0 = s0 * inv - x0, d1 = s1 * inv - x1;
          v4u pk; pk.x = pk2(d0.x, d0.y); pk.y = pk2(d0.z, d0.w); pk.z = pk2(d1.x, d1.y); pk.w = pk2(d1.z, d1.w);
          *(LAS v4u*)(lds + tok * PL_S + cc * 16) = pk;
      } }
    __syncthreads();
    const int r = lane & 31, hh = lane >> 5, g = wid >> 1, dt = wid & 1;
    s16x8 wa[4];
#pragma unroll
    for (int s = 0; s < 4; ++s) wa[s] = __builtin_bit_cast(s16x8, *(const v4u*)(pwt + (size_t)g * 4096 + (32 * dt + r) * 64 + 16 * s + 8 * hh));
#pragma unroll
    for (int tt = 0; tt < 2; ++tt) {
        f32x16 acc;
#pragma unroll
        for (int e = 0; e < 16; ++e) acc[e] = 0.f;
#pragma unroll
        for (int s = 0; s < 4; ++s) { const s16x8 bq = *(LAS const s16x8*)(lds + (32 * tt + r) * PL_S + (g * 64 + 16 * s + 8 * hh) * 2); acc = MFMA32(wa[s], bq, acc); }
        bf16* orow = MIX + (row0 + 32 * tt + r) * D + 768 + g * 64 + 32 * dt + 4 * hh;
#pragma unroll
        for (int q4 = 0; q4 < 4; ++q4) { const f32x4 sc = *(const f32x4*)(pscale + l * 256 + g * 64 + 32 * dt + 4 * hh + 8 * q4);
            v2u w; w.x = pk2(acc[4 * q4] * sc.x, acc[4 * q4 + 1] * sc.y); w.y = pk2(acc[4 * q4 + 2] * sc.z, acc[4 * q4 + 3] * sc.w);
            *(v2u*)(orow + 8 * q4) = w; }
    }
}
#define XB_TMO      128
#define XB_XCNT(j)  (256  + 64 * (j))
#define XB_XSUB(j)  (1280 + 64 * (j))
#define XB_XGEN(j)  (2304 + 64 * (j))
#define XB_TOP      3328
#define XB_TOPGEN   3392
#define XCD_BAR_WORDS 3456
#define XB_SPIN_CAP (1u << 18)

__device__ __forceinline__ unsigned xb_ld(unsigned* p)              { return __hip_atomic_load(p, __ATOMIC_RELAXED, __HIP_MEMORY_SCOPE_AGENT); }
__device__ __forceinline__ unsigned xb_add(unsigned* p, unsigned v) { return __hip_atomic_fetch_add(p, v, __ATOMIC_RELAXED, __HIP_MEMORY_SCOPE_AGENT); }
__device__ __forceinline__ unsigned xb_xcc_id() { return (unsigned)__builtin_amdgcn_s_getreg((3 << 11) | 20) & 0xFu; }
#define XB_SPIN(cond, bar) do { unsigned _sp = 0; while (cond) { __builtin_amdgcn_s_sleep(1); \
    if ((++_sp & 255u) == 0u) { if (xb_ld(&(bar)[XB_TMO])) break; if (_sp > XB_SPIN_CAP) { atomicAdd(&(bar)[XB_TMO], 1u); break; } } } } while (0)

struct XcdBarrier {
    unsigned* bar; unsigned x;
    volatile LAS unsigned* st;
};

__device__ __forceinline__ XcdBarrier xcd_barrier_post(unsigned* bar, volatile LAS unsigned* st, const bool leader) {
    XcdBarrier b; b.bar = bar; b.x = xb_xcc_id(); b.st = st;
    if (leader) (void)xb_add(&bar[XB_XCNT(b.x)], 1u);
    return b;
}
__device__ __forceinline__ void xcd_barrier_complete(unsigned* bar, unsigned x, unsigned& nloc, unsigned& nx) {
    const unsigned G = gridDim.x * gridDim.y * gridDim.z;
    unsigned sum, cnt, mine, sp = 0u;
    for (;;) {
        sum = 0u; cnt = 0u; mine = 0u;
#pragma unroll
        for (unsigned j = 0; j < 16; ++j) { const unsigned c = xb_ld(&bar[XB_XCNT(j)]); sum += c; cnt += (c > 0u) ? 1u : 0u; mine = (j == x) ? c : mine; }
        if (sum == G) break;
        __builtin_amdgcn_s_sleep(1);
        if ((++sp & 255u) == 0u) { if (xb_ld(&bar[XB_TMO])) break; if (sp > XB_SPIN_CAP) { atomicAdd(&bar[XB_TMO], 1u); break; } }
    }
    nloc = mine > 0u ? mine : 1u; nx = cnt > 0u ? cnt : 1u;
}

__device__ __forceinline__ void xcd_barrier(const XcdBarrier& b, const bool leader) {
    asm volatile("s_waitcnt vmcnt(0)" ::: "memory");
    __syncthreads();
    if (leader) {
        unsigned* bar = b.bar;
        __builtin_amdgcn_s_waitcnt(0);
        unsigned nloc = b.st[0], nx = b.st[1];
        if (nloc == 0u) { xcd_barrier_complete(bar, b.x, nloc, nx); b.st[0] = nloc; b.st[1] = nx; }
        const unsigned old = xb_add(&bar[XB_XSUB(b.x)], 1u);
        const unsigned gen = old / nloc;
        if (old + 1u == (gen + 1u) * nloc) {
            __builtin_amdgcn_fence(__ATOMIC_RELEASE, "agent");
            asm volatile("s_waitcnt vmcnt(0)" ::: "memory");
            const unsigned og = xb_add(&bar[XB_TOP], 1u);
            const unsigned tg = og / nx;
            if (og + 1u == (tg + 1u) * nx) xb_add(&bar[XB_TOPGEN], 1u);
            else XB_SPIN(xb_ld(&bar[XB_TOPGEN]) == tg, bar);
            __builtin_amdgcn_fence(__ATOMIC_ACQUIRE, "agent");
            xb_add(&bar[XB_XGEN(b.x)], 1u);
            asm volatile("s_waitcnt vmcnt(0)" ::: "memory");
        } else {
            XB_SPIN(xb_ld(&bar[XB_XGEN(b.x)]) == gen, bar);
            __builtin_amdgcn_fence(__ATOMIC_ACQUIRE, "agent");
            asm volatile("s_waitcnt vmcnt(0)" ::: "memory");
        }
    }
    __syncthreads();
}
constexpr int BAR_LDS_OFF = LDS_BYTES - 16;
constexpr size_t WS_BAR = 65536;
__device__ __forceinline__ bool is_leader(int wid0) { int lane; asm volatile("v_mbcnt_lo_u32_b32 %0, -1, 0\n\tv_mbcnt_hi_u32_b32 %0, -1, %0" : "=v"(lane)); return wid0 == 0 && lane == 0; }
__device__ __forceinline__ void grid_sync(unsigned char* ws, LAS unsigned char* lds, int wid0) {
    XcdBarrier b; b.bar = (unsigned*)(ws + WS_BAR); b.x = xb_xcc_id(); b.st = (volatile LAS unsigned*)(lds + BAR_LDS_OFF);
    xcd_barrier(b, is_leader(wid0));
}
template <int PH> __device__ __forceinline__ void run_phase(const Params& P0, LAS unsigned char* lds, const int wid0) {
    Params P = P0; asm volatile("" : "+s"(P.ws), "+s"(P.out));
#pragma unroll
    for (int i = 0; i < 16; ++i) asm volatile("" : "+s"(P.in[i]));
    int lane_; asm volatile("v_mbcnt_lo_u32_b32 %0, -1, 0\n\tv_mbcnt_hi_u32_b32 %0, -1, %0" : "=v"(lane_));
    int wid_ = wid0; asm volatile("" : "+s"(wid_));
    const int tid = wid_ * 64 + lane_;
    int bid = blockIdx.x, G = gridDim.x; asm volatile("" : "+s"(bid), "+s"(G));
    const int lane = lane_, wid = wid_;
    if constexpr (PH == 0) phase_prologue(P, lds, bid, G, tid, wid, lane);
    else if constexpr (PH == N_PHASES - 1) phase_norm(P, 0, 2, bid, G, wid, lane);
    else {
        constexpr int l = (PH - 1) / NPH, s = (PH - 1) % NPH;
        if constexpr (s == 0) phase_norm(P, l, 0, bid, G, wid, lane);
        else if constexpr (s == 1) { pg8::Gemm g{(const pg8::bf16_t*)(P.ws + WS_H), (const pg8::bf16_t*)(P.ws + WS_WIN) + (size_t)l * NIN * D, T, NIN, D};
            pg8::StaticOrder S; S.init(T, NIN, G, bid); pg8::EpiStoreBf16 E{(pg8::bf16_t*)(P.ws + WS_U), NIN};
            pg8::gemm_phase<pg8::EpiStoreBf16, pg8::StaticOrder, true, true>(lds, g, S, E, tid); }
        else if constexpr (s == 2) {
#if NAIVE_ATTN
            for (int qi = bid * 8 + wid; qi < BATCH * 6 * SEQ; qi += G * 8) naive_attn_query(P, qi, lane);
#else
            if (G == 256) {
                for (int k = 0; k < 2 * (1 + (DUP_MIX & 1)); ++k) { const int u = (k & 1) == 0 ? bid : 383 - bid;
                    if ((k & 1) == 1 && bid >= 128) continue;
                    int t2 = tid; asm volatile("" : "+v"(t2));
                    attn_unit(P, (u % 48) / 6, (u % 48) % 6, 7 - u / 48, lds, t2, wid, t2 & 63); }
            } else for (int u = bid; u < 384; u += G) attn_unit(P, (u % 48) / 6, (u % 48) % 6, 7 - u / 48, lds, tid, wid, lane);
#endif
#if NAIVE_POOL
            for (int it = bid; it < T / 8; it += G) naive_pool(P, l, it, lds, tid);
#else
            for (int rp = 0; rp < 1 + ((DUP_MIX >> 1) & 1); ++rp) for (int u = bid; u < T / 64; u += G) { int t2 = tid; asm volatile("" : "+v"(t2)); pool_unit(P, l, u, lds, t2, wid, t2 & 63); }
#endif
#if NAIVE_SSD
            for (int bh = bid; bh < BATCH * 6; bh += G) naive_ssd(P, l, bh, lds, tid);
#else
            for (int rp = 0; rp < 1 + ((DUP_MIX >> 2) & 1); ++rp) for (int u = bid; u < 256; u += G) if (((u >> 1) & 15) != 15) { int t2 = tid; asm volatile("" : "+v"(t2)); ssd_unit_a(P, l, u >> 5, (u >> 1) & 15, u & 1, lds, t2, wid, t2 & 63); }
#endif
        }
        else if constexpr (s == 3) ssd_scan(P, bid, G, tid);
        else if constexpr (s == 4) {
#if NAIVE_SSD
            naive_ssd_norm(P, l, bid, G, wid, lane);
#else
            for (int u = bid; u < 256; u += G) { int t2 = tid; asm volatile("" : "+v"(t2)); ssd_unit_b(P, l, u >> 5, (u >> 1) & 15, u & 1, lds, t2, wid, t2 & 63); }
#endif
        }
        else if constexpr (s == 5) { pg8::Gemm g{(const pg8::bf16_t*)(P.ws + WS_H), (const pg8::bf16_t*)(P.ws + WS_WOUT) + (size_t)l * D * D, T, D, D};
            pg8::StaticOrder S; S.init(T, D, G, bid); pg8::EpiResidual E{l == 0 ? P.in[I_X] : P.out, P.out, D};
            pg8::gemm_phase<pg8::EpiResidual, pg8::StaticOrder, true, true>(lds, g, S, E, tid); }
        else if constexpr (s == 6) phase_norm(P, l, 1, bid, G, wid, lane);
        else if constexpr (s == 7) { pg8::Gemm g{(const pg8::bf16_t*)(P.ws + WS_H), (const pg8::bf16_t*)(P.ws + WS_WGU) + (size_t)l * NGU * D, T, NGU, D};
            pg8::StaticOrder S; S.init(T, NGU, G, bid); pg8::EpiSwiGLU E{(pg8::bf16_t*)(P.ws + WS_U), FF};
            pg8::gemm_phase<pg8::EpiSwiGLU, pg8::StaticOrder, true, true>(lds, g, S, E, tid); }
        else { pg8::Gemm g{(const pg8::bf16_t*)(P.ws + WS_U), (const pg8::bf16_t*)(P.ws + WS_WD) + (size_t)l * D * FF, T, D, FF};
            pg8::StaticOrder S; S.init(T, D, G, bid); pg8::EpiResidual E{P.out, P.out, D};
            pg8::gemm_phase<pg8::EpiResidual, pg8::StaticOrder, true, true>(lds, g, S, E, tid); }
    }
}
template <int PH> __device__ __forceinline__ void run_all(const Params& P0, LAS unsigned char* lds, const int wid0, const int lo, const int hi) {
    if constexpr (PH < N_PHASES) {
        if (PH >= lo && PH < hi) { run_phase<PH>(P0, lds, wid0);
#if DUP_S
            if constexpr (PH >= 1 && PH < N_PHASES - 1 && ((DUP_S >> ((PH - 1) % NPH)) & 1)) { __syncthreads(); run_phase<PH>(P0, lds, wid0); }
            if constexpr (PH == 0 && ((DUP_S >> 30) & 1)) { __syncthreads(); run_phase<PH>(P0, lds, wid0); }
#endif
            if (PH + 1 < hi) {
#pragma unroll
                for (int rep = 0; rep < SYNC_REP; ++rep) grid_sync(P0.ws, lds, wid0); } }
        run_all<PH + 1>(P0, lds, wid0, lo, hi);
    }
}
__global__ void __launch_bounds__(512, 2) mega(Params P0) {
    extern __shared__ __attribute__((aligned(16))) unsigned char lds_raw[];
    LAS unsigned char* lds = (LAS unsigned char*)lds_raw;
    const int wid0 = __builtin_amdgcn_readfirstlane(threadIdx.x >> 6);
    { const bool leader = is_leader(wid0);
      if (leader) { ((volatile LAS unsigned*)(lds + BAR_LDS_OFF))[0] = 0u; ((volatile LAS unsigned*)(lds + BAR_LDS_OFF))[1] = 0u; }
      __syncthreads();
      if (P0.ph_hi - P0.ph_lo > 1) (void)xcd_barrier_post((unsigned*)(P0.ws + WS_BAR), (volatile LAS unsigned*)(lds + BAR_LDS_OFF), leader); }
    run_all<0>(P0, lds, wid0, P0.ph_lo, P0.ph_hi);
}

#ifndef ONE_LAUNCH
#define ONE_LAUNCH 1
#endif
extern "C" void kernel_launch(void* const* d_in, const int* in_sizes, int n_in, void* d_out, int out_size, void* d_ws, size_t ws_size, hipStream_t stream) {
    static int grid = 0;
    if (grid == 0) {
        if (n_in != 16 || out_size != T * D || ws_size < WS_END) { fprintf(stderr, "kernel_launch: unexpected shapes n_in %d out %d ws %zu\n", n_in, out_size, ws_size); grid = -1; return; }
        int dev = 0, cus = 0, per_cu = 0;
        hipGetDevice(&dev); hipDeviceGetAttribute(&cus, hipDeviceAttributeMultiprocessorCount, dev);
        if (hipFuncSetAttribute((const void*)mega, hipFuncAttributeMaxDynamicSharedMemorySize, LDS_BYTES) != hipSuccess) { fprintf(stderr, "kernel_launch: hipFuncSetAttribute failed\n"); grid = -1; return; }
        hipOccupancyMaxActiveBlocksPerMultiprocessor(&per_cu, (const void*)mega, 512, LDS_BYTES);
        if (per_cu < 1) { fprintf(stderr, "kernel_launch: occupancy query says %d\n", per_cu); per_cu = 1; }
        (void)hipGetLastError();
        grid = cus * per_cu;
    }
    if (grid < 0) return;
    if (hipMemsetAsync((char*)d_ws + WS_CTL, 0, 131072, stream) != hipSuccess) { fprintf(stderr, "kernel_launch: memset failed\n"); return; }
    Params p{};
    for (int i = 0; i < 16; ++i) p.in[i] = (const float*)d_in[i];
    p.out = (float*)d_out; p.ws = (unsigned char*)d_ws;
#if ONE_LAUNCH
    p.ph_lo = 0; p.ph_hi = N_PHASES;
    void* args[] = {&p};
    hipError_t e = hipLaunchCooperativeKernel((const void*)mega, dim3(grid), dim3(512), args, LDS_BYTES, stream);
    if (e != hipSuccess) fprintf(stderr, "cooperative launch failed: %s (grid %d)\n", hipGetErrorString(e), grid);
#else
    for (int ph = 0; ph < N_PHASES; ++ph) { p.ph_lo = ph; p.ph_hi = ph + 1; hipLaunchKernelGGL(mega, dim3(grid), dim3(512), LDS_BYTES, stream, p); }
#endif
}
```

```cpp
#include <hip/hip_runtime.h>
#include <hip/hip_cooperative_groups.h>
#include <cstdio>
#include <cstdint>
namespace cg = cooperative_groups;
#ifndef EPI_REP
#define EPI_REP 0
#endif
namespace pg8 {
#define PG8_LAS __attribute__((address_space(3)))
typedef unsigned short bf16_t;
typedef short bf16x8 __attribute__((ext_vector_type(8)));
typedef float f32x4 __attribute__((ext_vector_type(4)));
typedef unsigned u32x4 __attribute__((ext_vector_type(4)));
constexpr int BM = 256, BK = 64, HALF = 128, HTB = HALF * BK * 2  , STAGE_BYTES = 8 * HTB, NXCD = 8, WGM = 8;

__host__ __device__ __forceinline__ int lds_byte(int r, int c) { const int st = (r >> 4) * 2 + (c >> 5), rr = r & 15, cc = c & 31, ob = rr * 64 + cc * 2; return st * 1024 + (ob ^ (((ob >> 9) & 1) << 5)); }
__host__ __device__ __forceinline__ void stage_rc(int b, int& R, int& C) { const int st = b / 1024, sb = b % 1024, swz = sb ^ (((sb >> 9) & 1) << 5); R = (st >> 1) * 16 + swz / 64; C = (st & 1) * 32 + (swz % 64) / 2; }
__host__ __device__ __forceinline__ int perm32(int rho) { const int n = rho >> 4, i = rho & 15; return 8 * (i >> 2) + 4 * n + (i & 3); }

struct Unit { int pm, pn; };
struct Gemm { const bf16_t* A; const bf16_t* Bt; int M, N, K; };

struct StaticOrder {
    int nM, nN, nwg, G, c;
    __host__ __device__ void init(int M, int N, int G_, int c_) { nM = M / BM; nN = N / BM; nwg = nM * nN; G = G_; c = c_; }
    __host__ __device__ bool next(int i, Unit& u) const {
        const long L = (long)i * G + c; if (L >= nwg) return false;
        int wgid = (int)L; { const int q = nwg / NXCD, r = nwg % NXCD, xcd = wgid % NXCD, off = wgid / NXCD; wgid = (xcd < r ? xcd * (q + 1) : r * (q + 1) + (xcd - r) * q) + off; }
        const int nig = WGM * nN, gid = wgid / nig, fm = gid * WGM, gsz = (nM - fm) < WGM ? (nM - fm) : WGM;
        u.pm = fm + ((wgid % nig) % gsz); u.pn = (wgid % nig) / gsz; return true;
    }
    __device__ __forceinline__ void a_ready(const Unit&) const {}
    __device__ __forceinline__ void done(const Unit&) const {}
};

__device__ __forceinline__ unsigned cvt_pk_bf16(float lo, float hi) { unsigned r; asm volatile("v_cvt_pk_bf16_f32 %0, %1, %2" : "=v"(r) : "v"(lo), "v"(hi)); return r; }
__device__ __forceinline__ float rstd_of(const float* rs, size_t row) {
    const f32x4 a = *(const f32x4*)(rs + row * 16), b = *(const f32x4*)(rs + row * 16 + 4), c = *(const f32x4*)(rs + row * 16 + 8), d = *(const f32x4*)(rs + row * 16 + 12);
    const float t = (((a[0] + a[1]) + (a[2] + a[3])) + ((b[0] + b[1]) + (b[2] + b[3]))) + (((c[0] + c[1]) + (c[2] + c[3])) + ((d[0] + d[1]) + (d[2] + d[3])));
    return __builtin_amdgcn_rsqf(t * (1.f / 1024.f) + 1e-6f);
}
constexpr int RSTD_LDS_OFF = 131072;
template <class Sched> __device__ __forceinline__ int stage_rstd(const float* rs, PG8_LAS unsigned char* lds, const Sched& S, int tid) {
    Unit u0; if (!S.next(0, u0)) return 0;
    const int fm = (u0.pm >> 3) << 3;
    PG8_LAS float* rl = (PG8_LAS float*)(lds + RSTD_LDS_OFF);
#pragma unroll
    for (int k = 0; k < 4; ++k) rl[tid + 512 * k] = rstd_of(rs, (size_t)fm * BM + tid + 512 * k);
    __syncthreads();
    return fm;
}
#define RSV_LOAD(rsv, rs, rl, fm, row0) do { _Pragma("unroll") for (int ai_ = 0; ai_ < 2; ++ai_) _Pragma("unroll") for (int m_ = 0; m_ < 4; ++m_) { \
    const int ri_ = (row0) + ai_ * HALF + m_ * 16 - (fm) * BM; (rsv)[ai_][m_] = ((unsigned)ri_ < 2048u) ? (rl)[ri_] : rstd_of((rs), (size_t)((row0) + ai_ * HALF + m_ * 16)); } } while (0)
__device__ __forceinline__ float softplus_f(float z) { return fmaxf(z, 0.f) + log1pf(__expf(-fabsf(z))); }
struct EpiStoreBf16 { static constexpr bool IDEMP = true;
    static constexpr bool PERM = true, AFTER_DRAIN = false;
    bf16_t* O; int ldc; const float* rs; float* DT; const float* dtb; const PG8_LAS float* rl; int fm;
    __device__ __forceinline__ void operator()(const f32x4 (&acc)[2][2][4][2], const Unit& u, int wr, int wc, int fr, int fq) const {
        const int row0 = u.pm * BM + wr * 64 + fr; const int col0 = u.pn * BM + wc * 32 + 8 * fq;
        const bool dtl = (u.pn == 10) && (wc == 0) && (fq == 0);
        float rsv[2][4];
        RSV_LOAD(rsv, rs, rl, fm, row0);
#pragma unroll
        for (int ai = 0; ai < 2; ++ai)
#pragma unroll
            for (int m = 0; m < 4; ++m) { const size_t row = (size_t)(row0 + ai * HALF + m * 16); bf16_t* rowp = O + row * ldc + col0;
                const float rstd = rsv[ai][m];
#pragma unroll
                for (int bj = 0; bj < 2; ++bj) { const f32x4 v0 = acc[ai][bj][m][0] * rstd, v1 = acc[ai][bj][m][1] * rstd;
                    u32x4 w; w.x = cvt_pk_bf16(v0[0], v0[1]); w.y = cvt_pk_bf16(v0[2], v0[3]); w.z = cvt_pk_bf16(v1[0], v1[1]); w.w = cvt_pk_bf16(v1[2], v1[3]);
                    *(u32x4*)(rowp + bj * HALF) = w;
                    if (bj == 1 && dtl) { f32x4 d0; d0[0] = softplus_f(v0[0] + dtb[0]); d0[1] = softplus_f(v0[1] + dtb[1]); d0[2] = softplus_f(v0[2] + dtb[2]); d0[3] = softplus_f(v0[3] + dtb[3]);
                        *(f32x4*)(DT + row * 8) = d0; DT[row * 8 + 4] = softplus_f(v1[0] + dtb[4]); DT[row * 8 + 5] = softplus_f(v1[1] + dtb[5]); } }
                __builtin_amdgcn_sched_barrier(0); }
    }
};
template <bool R32> struct EpiResidual { static constexpr bool IDEMP = false;
    static constexpr bool PERM = true, AFTER_DRAIN = false;
    const float* R; int ld; bf16_t* XB; float* RSO;
    __device__ __forceinline__ void operator()(const f32x4 (&acc)[2][2][4][2], const Unit& u, int wr, int wc, int fr, int fq) const {
        const int row0 = u.pm * BM + wr * 64 + fr; const int col0 = u.pn * BM + wc * 32 + 8 * fq;
#pragma unroll
        for (int ai = 0; ai < 2; ++ai) {
            f32x4 rv[4][2][2];
#pragma unroll
            for (int m = 0; m < 4; ++m)
#pragma unroll
                for (int bj = 0; bj < 2; ++bj) { const size_t off = (size_t)(row0 + ai * HALF + m * 16) * ld + col0 + bj * HALF;
                    if constexpr (R32) { rv[m][bj][0] = *(const f32x4*)(R + off); rv[m][bj][1] = *(const f32x4*)(R + off + 4); }
                    else { const u32x4 q = *(const u32x4*)(XB + off);
                        rv[m][bj][0] = (f32x4){__builtin_bit_cast(float, q.x << 16), __builtin_bit_cast(float, q.x & 0xffff0000u), __builtin_bit_cast(float, q.y << 16), __builtin_bit_cast(float, q.y & 0xffff0000u)};
                        rv[m][bj][1] = (f32x4){__builtin_bit_cast(float, q.z << 16), __builtin_bit_cast(float, q.z & 0xffff0000u), __builtin_bit_cast(float, q.w << 16), __builtin_bit_cast(float, q.w & 0xffff0000u)}; } }
#pragma unroll
            for (int m = 0; m < 4; ++m) { const size_t row = (size_t)(row0 + ai * HALF + m * 16); const size_t off = row * ld + col0;
                float ss = 0.f;
#pragma unroll
                for (int bj = 0; bj < 2; ++bj) {
                    const f32x4 x0 = rv[m][bj][0] + acc[ai][bj][m][0], x1 = rv[m][bj][1] + acc[ai][bj][m][1];
                    u32x4 w; w.x = cvt_pk_bf16(x0[0], x0[1]); w.y = cvt_pk_bf16(x0[2], x0[3]); w.z = cvt_pk_bf16(x1[0], x1[1]); w.w = cvt_pk_bf16(x1[2], x1[3]);
                    *(u32x4*)(XB + off + bj * HALF) = w;
                    ss += ((x0[0] * x0[0] + x0[1] * x0[1]) + (x0[2] * x0[2] + x0[3] * x0[3])) + ((x1[0] * x1[0] + x1[1] * x1[1]) + (x1[2] * x1[2] + x1[3] * x1[3])); }
                ss += __builtin_bit_cast(float, __builtin_amdgcn_ds_swizzle(__builtin_bit_cast(int, ss), (16 << 10) | 0x1f));
                { float a = ss, b = ss; asm volatile("s_nop 1\n\tv_permlane32_swap_b32 %0, %1" : "+v"(a), "+v"(b)); ss = a + b; }
                if (fq == 0) RSO[row * 16 + u.pn * 4 + wc] = ss; }
            __builtin_amdgcn_sched_barrier(0); }
    }
};
__device__ __forceinline__ float silu_f(float g) { return g * __builtin_amdgcn_rcpf(1.f + __expf(-g)); }
struct EpiSwiGLU { static constexpr bool IDEMP = true;
    static constexpr bool PERM = true, AFTER_DRAIN = false;
    bf16_t* O; int ldc; const float* rs; const PG8_LAS float* rl; int fm;
    __device__ __forceinline__ void operator()(const f32x4 (&acc)[2][2][4][2], const Unit& u, int wr, int wc, int fr, int fq) const {
        const int row0 = u.pm * BM + wr * 64 + fr; const int col0 = u.pn * HALF + wc * 32 + 8 * fq;
        float rsv[2][4];
        RSV_LOAD(rsv, rs, rl, fm, row0);
#pragma unroll
        for (int ai = 0; ai < 2; ++ai)
#pragma unroll
            for (int m = 0; m < 4; ++m) { const size_t row = (size_t)(row0 + ai * HALF + m * 16); bf16_t* rowp = O + row * ldc + col0;
                const float rstd = rsv[ai][m];
                const f32x4 g0 = acc[ai][0][m][0] * rstd, g1 = acc[ai][0][m][1] * rstd, u0 = acc[ai][1][m][0] * rstd, u1 = acc[ai][1][m][1] * rstd;
                u32x4 w; w.x = cvt_pk_bf16(silu_f(g0[0]) * u0[0], silu_f(g0[1]) * u0[1]); w.y = cvt_pk_bf16(silu_f(g0[2]) * u0[2], silu_f(g0[3]) * u0[3]);
                w.z = cvt_pk_bf16(silu_f(g1[0]) * u1[0], silu_f(g1[1]) * u1[1]); w.w = cvt_pk_bf16(silu_f(g1[2]) * u1[2], silu_f(g1[3]) * u1[3]);
                *(u32x4*)rowp = w; __builtin_amdgcn_sched_barrier(0); }
    }
};
template <class Epi, class Sched, bool ALIGN_EPI = false, bool SP2 = false>
__device__ __forceinline__ void gemm_phase(PG8_LAS unsigned char* lds, const Gemm g, const Sched& S, const Epi& E, const int tid) {
    const int wid = __builtin_amdgcn_readfirstlane(tid >> 6), lane = tid & 63, wr = wid >> 2, wc = wid & 3, fr = lane & 15, fq = lane >> 4;
    const int K = g.K, nt = K / BK;
    unsigned voffA[2], voffB[2];
#pragma unroll
    for (int i = 0; i < 2; ++i) { int R, C; stage_rc(tid * 16 + i * 8192, R, C); const int Rb = Epi::PERM ? ((R & ~31) + perm32(R & 31)) : R;
        voffA[i] = (unsigned)(R * K + C) * 2u; voffB[i] = (unsigned)(Rb * K + C) * 2u; }
    const size_t kstep = (size_t)(BK * 2);
    const size_t hstep = (size_t)HALF * K * 2;
    const size_t tstep = 2 * hstep;
    const unsigned ldsw = (unsigned)wid * 1024u;
    const int aoff = lds_byte(wr * 64 + fr, fq * 8), boff = lds_byte(wc * 32 + fr, fq * 8);
#define PG8_SA(b, h) (((b) * 2 + (h)) * HTB)
#define PG8_SB(b, h) ((4 + (b) * 2 + (h)) * HTB)
#define PG8_STAGE(bufoff, gbase, voff) do { _Pragma("unroll") for (int _i = 0; _i < 2; ++_i) \
        __builtin_amdgcn_global_load_lds((const unsigned*)((const char*)(gbase) + (voff)[_i]), (PG8_LAS unsigned*)(lds + (bufoff) + ldsw + _i * 8192), 16, 0, 0); } while (0)
#define PG8_LDA(dst, b, h) do { _Pragma("unroll") for (int m = 0; m < 4; ++m) _Pragma("unroll") for (int k = 0; k < 2; ++k) dst[m][k] = *(const PG8_LAS bf16x8*)(lds + PG8_SA(b, h) + aoff + m * 2048 + k * 1024); } while (0)
#define PG8_LDB(dst, b, h) do { _Pragma("unroll") for (int n = 0; n < 2; ++n) _Pragma("unroll") for (int k = 0; k < 2; ++k) dst[n][k] = *(const PG8_LAS bf16x8*)(lds + PG8_SB(b, h) + boff + n * 2048 + k * 1024); } while (0)
#define PG8_MMA(ai, bj, At, Bt) do { __builtin_amdgcn_s_setprio(1); _Pragma("unroll") for (int m = 0; m < 4; ++m) _Pragma("unroll") for (int n = 0; n < 2; ++n) _Pragma("unroll") for (int k = 0; k < 2; ++k) \
        acc[ai][bj][m][n] = __builtin_amdgcn_mfma_f32_16x16x32_bf16(Bt[n][k], At[m][k], acc[ai][bj][m][n], 0, 0, 0); __builtin_amdgcn_s_setprio(0); } while (0)
#define PG8_WAIT_V(n) asm volatile("s_waitcnt vmcnt(" #n ")" ::: "memory")
#define PG8_WAIT_L(n) asm volatile("s_waitcnt lgkmcnt(" #n ")" ::: "memory")
#define PG8_BAR __builtin_amdgcn_s_barrier()
#define PG8_SCHED __builtin_amdgcn_sched_barrier(0)
    Unit cur, nxt; int ui = 0;
    if (!S.next(0, cur)) return;
    f32x4 acc[2][2][4][2];
#pragma unroll
    for (int a = 0; a < 2; ++a)
#pragma unroll
        for (int b = 0; b < 2; ++b)
#pragma unroll
            for (int m = 0; m < 4; ++m)
#pragma unroll
                for (int n = 0; n < 2; ++n) acc[a][b][m][n] = (f32x4){0.f, 0.f, 0.f, 0.f};
    bf16x8 At[4][2], B0[2][2], B1[2][2];
    const char* cA = (const char*)g.A + (size_t)cur.pm * tstep; const char* cB = (const char*)g.Bt + (size_t)cur.pn * tstep;
    S.a_ready(cur);
    if constexpr (SP2) {
        PG8_STAGE(PG8_SB(0, 0), cB, voffB); PG8_STAGE(PG8_SB(0, 1), cB + hstep, voffB); PG8_STAGE(PG8_SA(0, 0), cA, voffA); PG8_STAGE(PG8_SA(0, 1), cA + hstep, voffA);
        if (wr == 1) PG8_BAR;
        PG8_WAIT_V(2); PG8_BAR;
        PG8_STAGE(PG8_SB(1, 0), cB + kstep, voffB); PG8_STAGE(PG8_SA(1, 0), cA + kstep, voffA); PG8_STAGE(PG8_SB(1, 1), cB + hstep + kstep, voffB);
        PG8_WAIT_V(6); PG8_BAR;
    } else {
        PG8_STAGE(PG8_SB(0, 0), cB, voffB); PG8_STAGE(PG8_SA(0, 0), cA, voffA); PG8_STAGE(PG8_SB(0, 1), cB + hstep, voffB); PG8_STAGE(PG8_SA(0, 1), cA + hstep, voffA);
        if (wr == 1) PG8_BAR;
        PG8_WAIT_V(4); PG8_BAR;
        PG8_STAGE(PG8_SB(1, 0), cB + kstep, voffB); PG8_STAGE(PG8_SA(1, 0), cA + kstep, voffA); PG8_STAGE(PG8_SB(1, 1), cB + hstep + kstep, voffB);
        PG8_WAIT_V(6); PG8_BAR;
    }
    for (;;) {
        const bool has_next = S.next(ui + 1, nxt);
        const char* nA = has_next ? (const char*)g.A + (size_t)nxt.pm * tstep : cA; const char* nB = has_next ? (const char*)g.Bt + (size_t)nxt.pn * tstep : cB;
        for (int t = 0; t < nt; t += 2) {
            const bool last = (t == nt - 2);
            const char* a1 = cA + (size_t)(t + 1) * kstep;
            const char* a2 = last ? nA : cA + (size_t)(t + 2) * kstep; const char* b2 = last ? nB : cB + (size_t)(t + 2) * kstep;
            const char* a3 = a2 + kstep; const char* b3 = b2 + kstep;
            if (last && has_next) S.a_ready(nxt);
            if constexpr (SP2) {
            PG8_LDB(B0, 0, 0); PG8_LDB(B1, 0, 1); PG8_SCHED; PG8_LDA(At, 0, 0); PG8_STAGE(PG8_SA(1, 1), a1 + hstep, voffA);
            PG8_WAIT_V(8); PG8_WAIT_L(0); PG8_BAR; PG8_MMA(0, 0, At, B0); PG8_MMA(0, 1, At, B1); PG8_BAR; PG8_SCHED;
            PG8_LDA(At, 0, 1); PG8_STAGE(PG8_SB(0, 0), b2, voffB); PG8_STAGE(PG8_SB(0, 1), b2 + hstep, voffB); PG8_STAGE(PG8_SA(0, 0), a2, voffA);
            PG8_WAIT_V(8); PG8_WAIT_L(0); PG8_BAR; PG8_MMA(1, 0, At, B0); PG8_MMA(1, 1, At, B1); PG8_BAR; PG8_SCHED;
            PG8_LDB(B0, 1, 0); PG8_LDB(B1, 1, 1); PG8_SCHED; PG8_LDA(At, 1, 0); PG8_STAGE(PG8_SA(0, 1), a2 + hstep, voffA);
            PG8_WAIT_V(8); PG8_WAIT_L(0); PG8_BAR; PG8_MMA(0, 0, At, B0); PG8_MMA(0, 1, At, B1); PG8_BAR; PG8_SCHED;
            PG8_LDA(At, 1, 1); PG8_STAGE(PG8_SB(1, 0), b3, voffB); PG8_STAGE(PG8_SB(1, 1), b3 + hstep, voffB); PG8_STAGE(PG8_SA(1, 0), a3, voffA);
            PG8_WAIT_V(8); PG8_WAIT_L(0); PG8_BAR; PG8_MMA(1, 0, At, B0); PG8_MMA(1, 1, At, B1); PG8_BAR; PG8_SCHED;
            } else {
            PG8_LDB(B0, 0, 0); PG8_SCHED; PG8_LDA(At, 0, 0); PG8_STAGE(PG8_SA(1, 1), a1 + hstep, voffA);
            PG8_WAIT_L(8); PG8_BAR; PG8_WAIT_L(0); PG8_MMA(0, 0, At, B0); PG8_BAR; PG8_SCHED;
            PG8_LDB(B1, 0, 1); PG8_STAGE(PG8_SB(0, 0), b2, voffB);
            PG8_BAR; PG8_WAIT_L(0); PG8_MMA(0, 1, At, B1); PG8_BAR;
            PG8_LDA(At, 0, 1); PG8_STAGE(PG8_SA(0, 0), a2, voffA);
            PG8_BAR; PG8_WAIT_L(0); PG8_MMA(1, 0, At, B0); PG8_BAR; PG8_SCHED;
            PG8_STAGE(PG8_SB(0, 1), b2 + hstep, voffB);
            PG8_WAIT_V(6); PG8_BAR; PG8_MMA(1, 1, At, B1); PG8_BAR;
            PG8_LDB(B0, 1, 0); PG8_SCHED; PG8_LDA(At, 1, 0); PG8_STAGE(PG8_SA(0, 1), a2 + hstep, voffA);
            PG8_WAIT_L(8); PG8_BAR; PG8_WAIT_L(0); PG8_MMA(0, 0, At, B0); PG8_BAR; PG8_SCHED;
            PG8_LDB(B1, 1, 1); PG8_STAGE(PG8_SB(1, 0), b3, voffB);
            PG8_BAR; PG8_WAIT_L(0); PG8_MMA(0, 1, At, B1); PG8_BAR;
            PG8_LDA(At, 1, 1); PG8_STAGE(PG8_SA(1, 0), a3, voffA);
            PG8_BAR; PG8_WAIT_L(0); PG8_MMA(1, 0, At, B0); PG8_BAR; PG8_SCHED;
            PG8_STAGE(PG8_SB(1, 1), b3 + hstep, voffB);
            PG8_WAIT_V(6); PG8_BAR; PG8_MMA(1, 1, At, B1); PG8_BAR;
            }
        }
        if constexpr (ALIGN_EPI) { if (wr == 0) PG8_BAR; }
        if constexpr (!Epi::AFTER_DRAIN) { E(acc, cur, wr, wc, fr, fq);
#if EPI_REP
            if constexpr (Epi::IDEMP) { __builtin_amdgcn_sched_barrier(0); E(acc, cur, wr, wc, fr, fq); }
#endif
            S.done(cur); }
        if (!has_next) break;
#pragma unroll
        for (int a = 0; a < 2; ++a)
#pragma unroll
            for (int b = 0; b < 2; ++b)
#pragma unroll
                for (int m = 0; m < 4; ++m)
#pragma unroll
                    for (int n = 0; n < 2; ++n) acc[a][b][m][n] = (f32x4){0.f, 0.f, 0.f, 0.f};
        cur = nxt; cA = nA; cB = nB; ++ui;
        if constexpr (ALIGN_EPI) { if (wr == 1) PG8_BAR; }
    }
    PG8_WAIT_V(0);
    if constexpr (!ALIGN_EPI) { if (wr == 0) PG8_BAR; }
    PG8_BAR;
    if constexpr (Epi::AFTER_DRAIN) { E.fused(acc, cur, wr, wc, fr, fq, lds, wid, lane); S.done(cur); }
#undef PG8_SA
#undef PG8_SB
#undef PG8_STAGE
#undef PG8_LDA
#undef PG8_LDB
#undef PG8_MMA
#undef PG8_WAIT_V
#undef PG8_WAIT_L
#undef PG8_BAR
#undef PG8_SCHED
}
}

#define LAS __attribute__((address_space(3)))
typedef unsigned short bf16;
typedef unsigned v4u __attribute__((ext_vector_type(4)));
typedef unsigned v2u __attribute__((ext_vector_type(2)));
typedef float f32x4 __attribute__((ext_vector_type(4)));
constexpr int BATCH = 8, SEQ = 2048, T = BATCH * SEQ, D = 1024, DEPTH = 4;
constexpr int INW = 2694, NIN = 2816, FF = 2816, NGU = 5632;
constexpr int UQ = 0, UK = 384, UV = 768, UZ = 1152, UXS = 1536, UP = 2432;
constexpr int XBC = 896;
constexpr float EPS = 1e-6f;
constexpr size_t MiB = 1u << 20;
constexpr size_t WS_CTL = 0;
constexpr size_t WS_WIN = 1 * MiB, WS_WOUT = 23 * MiB, WS_WGU = 31 * MiB, WS_WD = 75 * MiB;
constexpr size_t WS_DTW = 97 * MiB, WS_PWT = WS_DTW + 128 * 1024, WS_KM = WS_DTW + 256 * 1024, WS_CD = WS_DTW + 512 * 1024;
constexpr size_t WS_DT = 98 * MiB, WS_H = 99 * MiB, WS_U = 131 * MiB, WS_ST = 219 * MiB, WS_PREV = 243 * MiB, WS_RS = 255 * MiB, WS_XB = 266 * MiB, WS_END = 298 * MiB;
constexpr int LDS_BYTES = 147456;
#ifndef NAIVE_ATTN
#define NAIVE_ATTN 0
#endif
#ifndef NAIVE_SSD
#define NAIVE_SSD 0
#endif
#ifndef NAIVE_POOL
#define NAIVE_POOL 0
#endif
#ifndef DUP_S
#define DUP_S 0
#endif
#ifndef SYNC_REP
#define SYNC_REP 1
#endif
#ifndef DUP_MIX
#define DUP_MIX 0
#endif
constexpr int NPH = 7;
constexpr int N_PHASES = 2 + DEPTH * NPH;

__device__ __forceinline__ float bf2f(unsigned short u) { return __builtin_bit_cast(float, (unsigned)u << 16); }
__device__ __forceinline__ unsigned f2bf(float f) { unsigned u = __builtin_bit_cast(unsigned, f); return (u + 0x7fffu + ((u >> 16) & 1u)) >> 16; }
__device__ __forceinline__ unsigned pk2(float lo, float hi) { return f2bf(lo) | (f2bf(hi) << 16); }
#define SWZ_XOR(v, m) __builtin_bit_cast(float, __builtin_amdgcn_ds_swizzle(__builtin_bit_cast(int, (v)), ((m) << 10) | 0x1f))
__device__ __forceinline__ float half_sum(float v) { v += SWZ_XOR(v, 1); v += SWZ_XOR(v, 2); v += SWZ_XOR(v, 4); v += SWZ_XOR(v, 8); v += SWZ_XOR(v, 16); return v; }
__device__ __forceinline__ float wave_sum(float v) {
    v = half_sum(v);
    return __builtin_bit_cast(float, __builtin_amdgcn_readlane(__builtin_bit_cast(int, v), 0)) + __builtin_bit_cast(float, __builtin_amdgcn_readlane(__builtin_bit_cast(int, v), 32));
}
__device__ __forceinline__ float wave_max(float v) {
    v = fmaxf(v, SWZ_XOR(v, 1)); v = fmaxf(v, SWZ_XOR(v, 2)); v = fmaxf(v, SWZ_XOR(v, 4)); v = fmaxf(v, SWZ_XOR(v, 8)); v = fmaxf(v, SWZ_XOR(v, 16));
    return fmaxf(__builtin_bit_cast(float, __builtin_amdgcn_readlane(__builtin_bit_cast(int, v), 0)), __builtin_bit_cast(float, __builtin_amdgcn_readlane(__builtin_bit_cast(int, v), 32)));
}
__device__ __forceinline__ float silu(float g) { return g / (1.f + __expf(-g)); }

struct Params { const float* in[16]; float* out; unsigned char* ws; int ph_lo, ph_hi; };
enum { I_X = 0, I_NMIX, I_WIN, I_CONVW, I_CONVB, I_DTB, I_ALOG, I_DSKIP, I_SSDN, I_POOLW, I_POOLS, I_WOUT, I_NFFN, I_WGU, I_WD, I_NFIN };

typedef float f32x2v __attribute__((ext_vector_type(2)));
__device__ __forceinline__ void transpose_item(const float* W, int srcN, int c0, int ncols, const float* gk, int k0, bf16* WT, int dstK, int n0, LAS float* scr, int lane) {
    const int cq = lane & 31, kr = lane >> 5;
    if (c0 >= 0) {
        const float* src = W + (size_t)(k0 + kr) * srcN + c0 + 2 * cq;
#pragma unroll 16
        for (int i = 0; i < 32; ++i) { f32x2v v = {0.f, 0.f};
            if (2 * cq < ncols) v = *(const f32x2v*)(src + (size_t)(2 * i) * srcN);
            scr[(2 * i + kr) * 65 + 2 * cq] = v.x; scr[(2 * i + kr) * 65 + 2 * cq + 1] = v.y; }
    }
    asm volatile("s_waitcnt lgkmcnt(0)" ::: "memory");
    const int c = lane & 7;
    f32x4 g0 = {1.f, 1.f, 1.f, 1.f}, g1 = g0;
    if (gk) { g0 = *(const f32x4*)(gk + k0 + 8 * c); g1 = *(const f32x4*)(gk + k0 + 8 * c + 4); }
#pragma unroll
    for (int j = 0; j < 8; ++j) { const int n = (lane >> 3) + 8 * j; const LAS float* s = scr + (8 * c) * 65 + n;
        v4u o = {0u, 0u, 0u, 0u};
        if (c0 >= 0) { o.x = pk2(s[0 * 65] * g0.x, s[1 * 65] * g0.y); o.y = pk2(s[2 * 65] * g0.z, s[3 * 65] * g0.w); o.z = pk2(s[4 * 65] * g1.x, s[5 * 65] * g1.y); o.w = pk2(s[6 * 65] * g1.z, s[7 * 65] * g1.w); }
        *(v4u*)(WT + (size_t)(n0 + n) * dstK + k0 + 8 * c) = o; }
    asm volatile("s_waitcnt lgkmcnt(0)" ::: "memory");
}
__device__ __forceinline__ void phase_prologue(const Params& P, LAS unsigned char* lds, int bid, int G, int tid, int wid, int lane) {
    LAS float* scr = (LAS float*)lds + wid * (64 * 65);
    const int gw = bid * 8 + wid, nw = G * 8;
    for (int it = gw; it < DEPTH * 3072; it += nw) {
        const int l = it / 3072; int r = it % 3072;
        if (r < 704) { const int nb = r >> 4, kb = r & 15, n0 = nb * 64; const int c0 = nb < 38 ? n0 : (nb < 42 ? n0 + 6 : (nb == 42 ? 2432 : -1));
            transpose_item(P.in[I_WIN] + (size_t)l * D * INW, INW, c0, nb == 42 ? 6 : 64, P.in[I_NMIX] + l * D, kb * 64, (bf16*)(P.ws + WS_WIN) + (size_t)l * NIN * D, D, n0, scr, lane); }
        else if (r < 960) { r -= 704; const int nb = r >> 4, kb = r & 15;
            transpose_item(P.in[I_WOUT] + (size_t)l * D * D, D, nb * 64, 64, nullptr, kb * 64, (bf16*)(P.ws + WS_WOUT) + (size_t)l * D * D, D, nb * 64, scr, lane); }
        else if (r < 2368) { r -= 960; const int nb = r >> 4, kb = r & 15, n0 = nb * 64, pn = n0 >> 8, rr = n0 & 255; const int c0 = rr < 128 ? 128 * pn + rr : FF + 128 * pn + (rr - 128);
            transpose_item(P.in[I_WGU] + (size_t)l * D * NGU, NGU, c0, 64, P.in[I_NFFN] + l * D, kb * 64, (bf16*)(P.ws + WS_WGU) + (size_t)l * NGU * D, D, n0, scr, lane); }
        else { r -= 2368; const int nb = r / 44, kb = r % 44;
            transpose_item(P.in[I_WD] + (size_t)l * FF * D, D, nb * 64, 64, nullptr, kb * 64, (bf16*)(P.ws + WS_WD) + (size_t)l * D * FF, FF, nb * 64, scr, lane); }
    }
    const int gt = bid * 512 + tid, nt = G * 512;
    { bf16* XB = (bf16*)(P.ws + WS_XB); float* RS = (float*)(P.ws + WS_RS);
      for (int row = bid * 8 + wid; row < T; row += G * 8) {
          const float* xr = P.in[I_X] + (size_t)row * D + 4 * lane; float s = 0.f;
          v2u* o8 = (v2u*)(XB + (size_t)row * D + 4 * lane);
#pragma unroll
          for (int j = 0; j < 4; ++j) { const f32x4 v = *(const f32x4*)(xr + 256 * j); s += (v.x * v.x + v.y * v.y) + (v.z * v.z + v.w * v.w); v2u o; o.x = pk2(v.x, v.y); o.y = pk2(v.z, v.w); o8[64 * j] = o; }
          s = wave_sum(s);
          if (lane < 16) RS[(size_t)row * 16 + lane] = lane == 0 ? s : 0.f;
      } }
    bf16* pwt = (bf16*)(P.ws + WS_PWT);
    for (int i = gt; i < DEPTH * 4 * 64 * 64; i += nt) { const int lg = i >> 12, d = (i >> 6) & 63, c = i & 63; pwt[i] = (bf16)f2bf(P.in[I_POOLW][(lg * 64 + c) * 64 + d]); }
}

__device__ __forceinline__ void phase_norm(const Params& P, int l, int mode, int bid, int G, int wid, int lane) {
    const bf16* XB = (const bf16*)(P.ws + WS_XB); const float* g = P.in[I_NFIN];
    f32x4 gv[4];
#pragma unroll
    for (int j = 0; j < 4; ++j) gv[j] = *(const f32x4*)(g + 4 * lane + 256 * j);
    for (int row = bid * 8 + wid; row < T; row += G * 8) {
        const v2u* xr = (const v2u*)(XB + (size_t)row * D + 4 * lane);
        f32x4 v[4]; float s = 0.f;
#pragma unroll
        for (int j = 0; j < 4; ++j) { const v2u q = xr[64 * j]; v[j] = (f32x4){bf2f(q.x & 0xffff), bf2f(q.x >> 16), bf2f(q.y & 0xffff), bf2f(q.y >> 16)}; s += (v[j].x * v[j].x + v[j].y * v[j].y) + (v[j].z * v[j].z + v[j].w * v[j].w); }
        const float rstd = rsqrtf(wave_sum(s) * (1.f / D) + EPS);
#pragma unroll
        for (int j = 0; j < 4; ++j) *(f32x4*)(P.out + (size_t)row * D + 4 * lane + 256 * j) = (v[j] * rstd) * gv[j];
    }
}
typedef float f32x16 __attribute__((ext_vector_type(16)));
typedef short s16x8 __attribute__((ext_vector_type(8)));
typedef short s16x4 __attribute__((ext_vector_type(4)));
typedef short v4i16_t __attribute__((ext_vector_type(4)));
#define MFMA32(a, b, c) __builtin_amdgcn_mfma_f32_32x32x16_bf16((a), (b), (c), 0, 0, 0)
__device__ __forceinline__ s16x4 lds_tr(LAS const unsigned char* p) { return __builtin_bit_cast(s16x4, __builtin_amdgcn_ds_read_tr16_b64_v4i16((LAS v4i16_t*)p)); }
__device__ __forceinline__ float xhalf_sum(float v) { float a = v, b = v; asm volatile("s_nop 1\n\tv_permlane32_swap_b32 %0, %1" : "+v"(a), "+v"(b)); return a + b; }
__device__ __forceinline__ float xhalf_max(float v) { float a = v, b = v; asm volatile("s_nop 1\n\tv_permlane32_swap_b32 %0, %1" : "+v"(a), "+v"(b)); return fmaxf(a, b); }
typedef float f32x2_t __attribute__((ext_vector_type(2)));
typedef __bf16 bf16x2_t __attribute__((ext_vector_type(2)));
__device__ __forceinline__ unsigned cvtpk(float lo, float hi) { const f32x2_t v = {lo, hi}; const bf16x2_t b = __builtin_convertvector(v, bf16x2_t); return __builtin_bit_cast(unsigned, b); }
constexpr int AT_KS = 144;
constexpr int AT_BLK = 256 * AT_KS;
constexpr int AT_K0 = 0, AT_V0 = AT_BLK, AT_KM = 2 * AT_BLK, AT_PART = AT_KM + 8 * 64 * 4;
__device__ __forceinline__ void attn_unit(const Params& P, int b, int h, int blk, LAS unsigned char* lds, int tid, int wid, int lane) {
    const bf16* U = (const bf16*)(P.ws + WS_U); bf16* MIX = (bf16*)(P.ws + WS_H);
    const int r = lane & 31, hh = lane >> 5;
    const size_t row0 = (size_t)b * SEQ;
    LAS float* KM = (LAS float*)(lds + AT_KM);
    const int ldrow = tid >> 3, ldch = tid & 7;
    const bf16* kvbase = U + (row0 + ldrow) * NIN + UK + h * 64 + ldch * 8;
    const int ldoff = ldrow * AT_KS + ldch * 16;
    auto blk_key0 = [&](int i) { return i == 0 ? blk * 256 : (i - 1) * 256; };
    v4u kreg[4], vreg[4];
#define AT_LOAD(i) do { const bf16* p_ = kvbase + (size_t)blk_key0(i) * NIN; _Pragma("unroll") for (int j_ = 0; j_ < 4; ++j_) { kreg[j_] = *(const v4u*)(p_ + (size_t)(64 * j_) * NIN); vreg[j_] = *(const v4u*)(p_ + (size_t)(64 * j_) * NIN + 384); } } while (0)
#define AT_STORE() do { _Pragma("unroll") for (int j_ = 0; j_ < 4; ++j_) { *(LAS v4u*)(lds + AT_K0 + 64 * j_ * AT_KS + ldoff) = kreg[j_]; *(LAS v4u*)(lds + AT_V0 + 64 * j_ * AT_KS + ldoff) = vreg[j_]; } } while (0)
    AT_LOAD(0);
    __syncthreads();
    if (blk >= 4) {
        LAS float* part = (LAS float*)(lds + AT_PART);
        const int d2 = tid & 31, kg = tid >> 5;
        for (int j = 0; j < blk; ++j) {
            const unsigned* kp = (const unsigned*)(U + (row0 + j * 256 + kg * 16) * NIN + UK + h * 64) + d2;
            float s0 = 0.f, s1 = 0.f;
#pragma unroll
            for (int i = 0; i < 16; ++i) { const unsigned w = kp[(size_t)i * (NIN / 2)]; s0 += bf2f(w & 0xffff); s1 += bf2f(w >> 16); }
            part[(j * 16 + kg) * 64 + 2 * d2] = s0; part[(j * 16 + kg) * 64 + 2 * d2 + 1] = s1;
        }
        __syncthreads();
        if (tid < blk * 64) { const int j = tid >> 6, d = tid & 63; float s = 0.f;
#pragma unroll
            for (int k = 0; k < 16; ++k) s += part[(j * 16 + k) * 64 + d];
            KM[j * 64 + d] = s * (1.f / 256.f); }
    }
    AT_STORE();
    __syncthreads();
    const int qrow = blk * 256 + wid * 32 + r;
    s16x8 qf[4];
    { const v4u* qp = (const v4u*)(U + (row0 + qrow) * NIN + UQ + h * 64 + 8 * hh);
#pragma unroll
      for (int s = 0; s < 4; ++s) qf[s] = __builtin_bit_cast(s16x8, qp[2 * s]); }
    unsigned sel = (1u << blk) - 1u;
    if (blk >= 4) {
        float gate[8];
#pragma unroll
        for (int j = 0; j < 8; ++j) gate[j] = -3e38f;
#pragma unroll
        for (int j = 0; j < 7; ++j) if (j < blk) { float g = 0.f;
#pragma unroll
            for (int s = 0; s < 4; ++s) {
                const f32x4 k0 = *(LAS const f32x4*)(KM + j * 64 + 16 * s + 8 * hh), k1 = *(LAS const f32x4*)(KM + j * 64 + 16 * s + 8 * hh + 4);
                g += bf2f((unsigned short)qf[s][0]) * k0.x + bf2f((unsigned short)qf[s][1]) * k0.y + bf2f((unsigned short)qf[s][2]) * k0.z + bf2f((unsigned short)qf[s][3]) * k0.w
                   + bf2f((unsigned short)qf[s][4]) * k1.x + bf2f((unsigned short)qf[s][5]) * k1.y + bf2f((unsigned short)qf[s][6]) * k1.z + bf2f((unsigned short)qf[s][7]) * k1.w; }
            gate[j] = xhalf_sum(g); }
        sel = 0u;
#pragma unroll
        for (int t = 0; t < 3; ++t) { int best = 0; float bv = -3.4e38f;
#pragma unroll
            for (int j = 0; j < 8; ++j) { const bool ok = !((sel >> j) & 1u) && gate[j] > bv; bv = ok ? gate[j] : bv; best = ok ? j : best; }
            sel |= 1u << best; }
    }
    f32x16 o0, o1;
#pragma unroll
    for (int i = 0; i < 16; ++i) { o0[i] = 0.f; o1[i] = 0.f; }
    float m = -1e30f, lsum = 0.f;
    const float SC = 0.125f * 1.44269504088896f;
    const int i16 = lane & 15, b16 = (lane >> 4) & 1;
    const int troff = (i16 >> 2) * AT_KS + (16 * b16) * 2 + 8 * (i16 & 3);
    const int qpos = 32 * wid + r;
    for (int bi = 0; bi <= blk; ++bi) {
        if (bi < blk) AT_LOAD(bi + 1);
        const int jpast = bi - 1;
        const bool lane_on = (bi == 0) || ((sel >> jpast) & 1u);
        const bool need_blk = (bi == 0) || (__builtin_amdgcn_ballot_w64(lane_on) != 0ull);
        if (need_blk) {
            const int nt = bi == 0 ? ((32 * wid + 31) >> 6) + 1 : 4;
            for (int kt = 0; kt < nt; ++kt) {
                LAS const unsigned char* Kt = lds + AT_K0 + kt * 64 * AT_KS; LAS const unsigned char* Vt = lds + AT_V0 + kt * 64 * AT_KS;
                f32x16 sA, sB;
#pragma unroll
                for (int e = 0; e < 16; ++e) { sA[e] = 0.f; sB[e] = 0.f; }
#pragma unroll
                for (int s = 0; s < 4; ++s) {
                    const s16x8 ka = *(LAS const s16x8*)(Kt + r * AT_KS + 32 * s + 16 * hh);
                    const s16x8 kb = *(LAS const s16x8*)(Kt + (32 + r) * AT_KS + 32 * s + 16 * hh);
                    sA = MFMA32(ka, qf[s], sA); sB = MFMA32(kb, qf[s], sB);
                }
                if (bi == 0 && kt == nt - 1) {
#pragma unroll
                    for (int e = 0; e < 16; ++e) { const int kr = (e & 3) + 8 * (e >> 2) + 4 * hh;
                        if (64 * kt + kr > qpos) sA[e] = -3e38f; if (64 * kt + 32 + kr > qpos) sB[e] = -3e38f; }
                }
                float mx = fmaxf(sA[0], sB[0]);
#pragma unroll
                for (int e = 1; e < 16; ++e) mx = fmaxf(mx, fmaxf(sA[e], sB[e]));
                mx = lane_on ? mx * SC : -1e30f;
                mx = xhalf_max(mx);
                const float mn = fmaxf(m, mx);
                const float nb = lane_on ? -mn : -3e38f;
                if (__builtin_amdgcn_ballot_w64(mn > m) != 0ull) {
                    const float alpha = __builtin_amdgcn_exp2f(m - mn);
                    lsum *= alpha;
#pragma unroll
                    for (int e = 0; e < 16; ++e) { o0[e] *= alpha; o1[e] *= alpha; }
                    m = mn;
                }
                float ps = 0.f;
#pragma unroll
                for (int e = 0; e < 16; ++e) { sA[e] = __builtin_amdgcn_exp2f(__builtin_fmaf(sA[e], SC, nb)); sB[e] = __builtin_amdgcn_exp2f(__builtin_fmaf(sB[e], SC, nb)); ps += sA[e] + sB[e]; }
                lsum += ps;
#pragma unroll
                for (int sub = 0; sub < 2; ++sub)
#pragma unroll
                    for (int s2 = 0; s2 < 2; ++s2) {
                        s16x8 pb;
#pragma unroll
                        for (int jj = 0; jj < 8; jj += 2) { const float x0 = sub ? sB[8 * s2 + jj] : sA[8 * s2 + jj], x1 = sub ? sB[8 * s2 + jj + 1] : sA[8 * s2 + jj + 1];
                            const unsigned w = cvtpk(x0, x1); pb[jj] = (short)(w & 0xffff); pb[jj + 1] = (short)(w >> 16); }
                        const int klo = 32 * sub + 16 * s2 + 4 * hh;
#pragma unroll
                        for (int db = 0; db < 2; ++db) {
                            const s16x4 lo = lds_tr(Vt + klo * AT_KS + troff + 64 * db), hi = lds_tr(Vt + (klo + 8) * AT_KS + troff + 64 * db);
                            const s16x8 va = __builtin_shufflevector(lo, hi, 0, 1, 2, 3, 4, 5, 6, 7);
                            if (db == 0) o0 = MFMA32(va, pb, o0); else o1 = MFMA32(va, pb, o1);
                        }
                    }
            }
        }
        if (bi < blk) { __syncthreads(); AT_STORE(); __syncthreads(); }
    }
#undef AT_LOAD
#undef AT_STORE
    const float inv = 1.f / xhalf_sum(lsum);
    bf16* orow = MIX + (row0 + qrow) * D + h * 64 + 4 * hh;
#pragma unroll
    for (int g = 0; g < 4; ++g) {
        v2u w0, w1;
        w0.x = pk2(o0[4 * g] * inv, o0[4 * g + 1] * inv); w0.y = pk2(o0[4 * g + 2] * inv, o0[4 * g + 3] * inv);
        w1.x = pk2(o1[4 * g] * inv, o1[4 * g + 1] * inv); w1.y = pk2(o1[4 * g + 2] * inv, o1[4 * g + 3] * inv);
        *(v2u*)(orow + 8 * g) = w0; *(v2u*)(orow + 32 + 8 * g) = w1;
    }
}
constexpr int SX_S = 400, SB_S = 272;
constexpr int S_X = 0, S_B = 51200, S_C = 86016, S_PREV = 120832, S_DT = 138240, S_AC = S_DT + 1536, S_DA = S_AC + 1536;
__device__ __forceinline__ int crow16(int i, int hh) { return (i & 3) + 8 * (i >> 2) + 4 * hh; }
template <bool PHASE_A>
__device__ __forceinline__ void ssd_stage(const Params& P, int l, int b, int c, int g, LAS unsigned char* lds, int tid) {
    const bf16* U = (const bf16*)(P.ws + WS_U); const float* DT = (const float*)(P.ws + WS_DT);
    const float* alog = P.in[I_ALOG]; const float* convw = P.in[I_CONVW]; const float* convb = P.in[I_CONVB];
    asm volatile("" : "+s"(alog), "+s"(convw), "+s"(convb));
    const size_t row0 = (size_t)b * SEQ + c * 128;
    LAS float* dts = (LAS float*)(lds + S_DT); LAS float* acs = (LAS float*)(lds + S_AC); LAS float* das = (LAS float*)(lds + S_DA);
    const int cc = tid & 63, tg = tid >> 6;
    const bool conv_on = cc < (PHASE_A ? 40 : 56);
    const int ch = cc < 24 ? g * 192 + cc * 8 : (cc < 40 ? 384 + g * 128 + (cc - 24) * 8 : 640 + g * 128 + (cc - 40) * 8);
    v4u rows[19];
    if (conv_on) {
        const bf16* src = U + (row0 + tg * 16) * NIN + UXS + ch;
        const bool has_prev = !(c == 0 && tg == 0);
#pragma unroll
        for (int k = 0; k < 3; ++k) { rows[k] = (v4u){0u, 0u, 0u, 0u}; if (has_prev) rows[k] = *(const v4u*)(src - (size_t)(3 - k) * NIN); }
#pragma unroll
        for (int t = 0; t < 16; ++t) rows[3 + t] = *(const v4u*)(src + (size_t)t * NIN);
    }
    if (tid < 384) { const int hh3 = tid >> 7, li = tid & 127, h = 3 * g + hh3; const float dt = DT[(row0 + li) * 8 + h]; dts[tid] = dt; das[tid] = dt * -__expf(alog[l * 6 + h]); }
    __syncthreads();
    if (tid < 384) {
        const int hh3 = tid >> 7, li = tid & 127; float s = 0.f;
#pragma unroll
        for (int q = 0; q < 32; ++q) { const f32x4 v = *(LAS const f32x4*)(das + hh3 * 128 + 4 * q);
            s += (4 * q <= li ? v.x : 0.f); s += (4 * q + 1 <= li ? v.y : 0.f); s += (4 * q + 2 <= li ? v.z : 0.f); s += (4 * q + 3 <= li ? v.w : 0.f); }
        acs[tid] = s; }
    __syncthreads();
    if (conv_on) {
        const float* cw = convw + (size_t)l * 4 * XBC + ch; const float* cb = convb + (size_t)l * XBC + ch;
        float w[4][8], bias[8];
#pragma unroll
        for (int k = 0; k < 4; ++k) { const f32x4 a = *(const f32x4*)(cw + k * XBC), d = *(const f32x4*)(cw + k * XBC + 4);
            w[k][0] = a.x; w[k][1] = a.y; w[k][2] = a.z; w[k][3] = a.w; w[k][4] = d.x; w[k][5] = d.y; w[k][6] = d.z; w[k][7] = d.w; }
        { const f32x4 a = *(const f32x4*)cb, d = *(const f32x4*)(cb + 4); bias[0] = a.x; bias[1] = a.y; bias[2] = a.z; bias[3] = a.w; bias[4] = d.x; bias[5] = d.y; bias[6] = d.z; bias[7] = d.w; }
        const int hh3 = cc >> 3;
        const float ac_end = acs[(cc < 24 ? hh3 : 0) * 128 + 127];
        LAS unsigned char* dst = lds + (cc < 24 ? S_X + cc * 16 : (cc < 40 ? S_B + (cc - 24) * 16 : S_C + (cc - 40) * 16));
        const int dstride = cc < 24 ? SX_S : SB_S;
#define UNPK(q, j) ((j) == 0 ? bf2f((q).x & 0xffff) : (j) == 1 ? bf2f((q).x >> 16) : (j) == 2 ? bf2f((q).y & 0xffff) : (j) == 3 ? bf2f((q).y >> 16) : (j) == 4 ? bf2f((q).z & 0xffff) : (j) == 5 ? bf2f((q).z >> 16) : (j) == 6 ? bf2f((q).w & 0xffff) : bf2f((q).w >> 16))
#pragma unroll
        for (int t = 0; t < 16; ++t) {
            const int tok = tg * 16 + t;
            float sc = 1.f;
            if (PHASE_A && cc < 24) sc = dts[hh3 * 128 + tok] * __expf(ac_end - acs[hh3 * 128 + tok]);
            float o[8];
#pragma unroll
            for (int j = 0; j < 8; ++j) { const float a = bias[j] + w[0][j] * UNPK(rows[t], j) + w[1][j] * UNPK(rows[t + 1], j) + w[2][j] * UNPK(rows[t + 2], j) + w[3][j] * UNPK(rows[t + 3], j); o[j] = silu(a) * sc; }
            v4u pk; pk.x = pk2(o[0], o[1]); pk.y = pk2(o[2], o[3]); pk.z = pk2(o[4], o[5]); pk.w = pk2(o[6], o[7]);
            *(LAS v4u*)(dst + tok * dstride) = pk;
        }
#undef UNPK
    }
    __syncthreads();
}
__device__ __forceinline__ void ssd_unit_a(const Params& P, int l, int b, int c, int g, LAS unsigned char* lds, int tid, int wid, int lane) {
    __syncthreads();
    ssd_stage<true>(P, l, b, c, g, lds, tid);
    LAS float* acs = (LAS float*)(lds + S_AC);
    if (tid < 3) ((float*)(P.ws + WS_CD))[(b * 16 + c) * 6 + 3 * g + tid] = __expf(acs[tid * 128 + 127]);
    const int r = lane & 31, hh = lane >> 5, nt = wid & 3, pt = wid >> 2, i16 = lane & 15, b16 = (lane >> 4) & 1;
    const int troffB = (i16 >> 2) * SB_S + (32 * nt + 16 * b16) * 2 + 8 * (i16 & 3);
    s16x8 bfr[8];
#pragma unroll
    for (int s = 0; s < 8; ++s) { const int k0 = 16 * s + 8 * hh;
        const s16x4 lo = lds_tr(lds + S_B + k0 * SB_S + troffB), hi = lds_tr(lds + S_B + (k0 + 4) * SB_S + troffB);
        bfr[s] = __builtin_shufflevector(lo, hi, 0, 1, 2, 3, 4, 5, 6, 7); }
    float* ST = (float*)(P.ws + WS_ST);
#pragma unroll
    for (int hh3 = 0; hh3 < 3; ++hh3) {
        const int troffX = (i16 >> 2) * SX_S + (hh3 * 64 + 32 * pt + 16 * b16) * 2 + 8 * (i16 & 3);
        f32x16 acc;
#pragma unroll
        for (int e = 0; e < 16; ++e) acc[e] = 0.f;
#pragma unroll
        for (int s = 0; s < 8; ++s) { const int k0 = 16 * s + 8 * hh;
            const s16x4 lo = lds_tr(lds + S_X + k0 * SX_S + troffX), hi = lds_tr(lds + S_X + (k0 + 4) * SX_S + troffX);
            const s16x8 xa = __builtin_shufflevector(lo, hi, 0, 1, 2, 3, 4, 5, 6, 7);
            acc = MFMA32(xa, bfr[s], acc); }
        float* S = ST + ((size_t)((b * 16 + c) * 6 + 3 * g + hh3)) * 8192;
#pragma unroll
        for (int e = 0; e < 16; ++e) S[(32 * pt + crow16(e, hh)) * 128 + 32 * nt + r] = acc[e];
    }
}
__device__ __forceinline__ void ssd_scan(const Params& P, int bid, int G, int tid) {
    const float* ST = (const float*)(P.ws + WS_ST); const float* CD = (const float*)(P.ws + WS_CD); bf16* PV = (bf16*)(P.ws + WS_PREV);
    for (int it = bid * 512 + tid; it < BATCH * 6 * 2048; it += G * 512) {
        const int bh = it >> 11, e4 = (it & 2047) * 4, b = bh / 6, h = bh % 6;
        f32x4 sv[15]; float dv[15];
#pragma unroll
        for (int c = 0; c < 15; ++c) { sv[c] = *(const f32x4*)(ST + ((size_t)((b * 16 + c) * 6 + h)) * 8192 + e4); dv[c] = CD[(b * 16 + c) * 6 + h]; }
        f32x4 acc = {0.f, 0.f, 0.f, 0.f};
#pragma unroll
        for (int c = 0; c < 16; ++c) {
            v2u w; w.x = pk2(acc.x, acc.y); w.y = pk2(acc.z, acc.w);
            *(v2u*)(PV + ((size_t)((b * 16 + c) * 6 + h)) * 8192 + e4) = w;
            if (c < 15) acc = acc * dv[c] + sv[c];
        }
    }
}
__device__ __forceinline__ void ssd_unit_b(const Params& P, int l, int b, int c, int g, LAS unsigned char* lds, int tid, int wid, int lane) {
    const float* dskip = P.in[I_DSKIP]; const float* ssdn = P.in[I_SSDN];
    asm volatile("" : "+s"(dskip), "+s"(ssdn));
    v4u pq[3][2];
    { const bf16* PV0 = (const bf16*)(P.ws + WS_PREV);
#pragma unroll
      for (int hh3 = 0; hh3 < 3; ++hh3) { const v4u* src = (const v4u*)(PV0 + ((size_t)((b * 16 + c) * 6 + 3 * g + hh3)) * 8192) + tid; pq[hh3][0] = src[0]; pq[hh3][1] = src[512]; } }
    __syncthreads();
    ssd_stage<false>(P, l, b, c, g, lds, tid);
    const bf16* U = (const bf16*)(P.ws + WS_U); bf16* MIX = (bf16*)(P.ws + WS_H);
    LAS float* dts = (LAS float*)(lds + S_DT); LAS float* acs = (LAS float*)(lds + S_AC); LAS float* ssb = (LAS float*)(lds + S_DA);
    const size_t row0 = (size_t)b * SEQ + c * 128;
    const int r = lane & 31, hh = lane >> 5, lt = wid & 3, pb = wid >> 2, i16 = lane & 15, b16 = (lane >> 4) & 1;
#define CF(s) (*(LAS const s16x8*)(lds + S_C + (32 * lt + r) * SB_S + (16 * (s) + 8 * hh) * 2))
    f32x16 Y[3];
#pragma unroll
    for (int hh3 = 0; hh3 < 3; ++hh3) {
        const int h = 3 * g + hh3;
        __syncthreads();
        *(LAS v4u*)(lds + S_PREV + (tid >> 4) * SB_S + (tid & 15) * 16) = pq[hh3][0]; *(LAS v4u*)(lds + S_PREV + (32 + (tid >> 4)) * SB_S + (tid & 15) * 16) = pq[hh3][1];
        __syncthreads();
        f32x16 acc;
#pragma unroll
        for (int e = 0; e < 16; ++e) acc[e] = 0.f;
#pragma unroll
        for (int s = 0; s < 8; ++s) { const s16x8 a = *(LAS const s16x8*)(lds + S_PREV + (32 * pb + r) * SB_S + (16 * s + 8 * hh) * 2); acc = MFMA32(a, CF(s), acc); }
        const float el = __expf(acs[hh3 * 128 + 32 * lt + r]);
#pragma unroll
        for (int e = 0; e < 16; ++e) Y[hh3][e] = acc[e] * el;
    }
    for (int st = 0; st <= lt; ++st) {
        f32x16 Gt;
#pragma unroll
        for (int e = 0; e < 16; ++e) Gt[e] = 0.f;
#pragma unroll
        for (int s = 0; s < 8; ++s) { const s16x8 a = *(LAS const s16x8*)(lds + S_B + (32 * st + r) * SB_S + (16 * s + 8 * hh) * 2); Gt = MFMA32(a, CF(s), Gt); }
#pragma unroll
        for (int hh3 = 0; hh3 < 3; ++hh3) {
            const float acl = acs[hh3 * 128 + 32 * lt + r];
            const int troffX = (i16 >> 2) * SX_S + (hh3 * 64 + 32 * pb + 16 * b16) * 2 + 8 * (i16 & 3);
#pragma unroll
            for (int s2 = 0; s2 < 2; ++s2) {
                s16x8 pbk;
#pragma unroll
                for (int jj = 0; jj < 8; jj += 2) {
                    float mv[2];
#pragma unroll
                    for (int t = 0; t < 2; ++t) { const int e = 8 * s2 + jj + t, kr = crow16(e, hh), stok = 32 * st + kr;
                        const bool valid = (st < lt) || (kr <= r);
                        const float v = Gt[e] * __expf(fminf(acl - acs[hh3 * 128 + stok], 0.f)) * dts[hh3 * 128 + stok];
                        mv[t] = valid ? v : 0.f; }
                    const unsigned w = pk2(mv[0], mv[1]); pbk[jj] = (short)(w & 0xffff); pbk[jj + 1] = (short)(w >> 16); }
                const int klo = 32 * st + 16 * s2 + 4 * hh;
                const s16x4 lo = lds_tr(lds + S_X + klo * SX_S + troffX), hi = lds_tr(lds + S_X + (klo + 8) * SX_S + troffX);
                const s16x8 xa = __builtin_shufflevector(lo, hi, 0, 1, 2, 3, 4, 5, 6, 7);
                Y[hh3] = MFMA32(xa, pbk, Y[hh3]);
                __builtin_amdgcn_sched_barrier(0);
            }
        }
    }
    float ssq = 0.f;
    const size_t grow = row0 + 32 * lt + r;
#pragma unroll
    for (int hh3 = 0; hh3 < 3; ++hh3) { const int h = 3 * g + hh3; const float Dk = dskip[l * 6 + h];
#pragma unroll
        for (int q4 = 0; q4 < 4; ++q4) { const int p0 = 32 * pb + 8 * q4 + 4 * hh;
            const v2u xr = *(LAS const v2u*)(lds + S_X + (32 * lt + r) * SX_S + (hh3 * 64 + p0) * 2);
            const v2u zr = *(const v2u*)(U + grow * NIN + UZ + h * 64 + p0);
            const f32x4 xv = {bf2f(xr.x & 0xffff), bf2f(xr.x >> 16), bf2f(xr.y & 0xffff), bf2f(xr.y >> 16)};
            const f32x4 zv = {bf2f(zr.x & 0xffff), bf2f(zr.x >> 16), bf2f(zr.y & 0xffff), bf2f(zr.y >> 16)};
#pragma unroll
            for (int e = 0; e < 4; ++e) { const float y = (Y[hh3][4 * q4 + e] + Dk * xv[e]) * silu(zv[e]); Y[hh3][4 * q4 + e] = y; ssq += y * y; } } }
    ssq = xhalf_sum(ssq);
    if (hh == 0) ssb[pb * 128 + 32 * lt + r] = ssq;
    __syncthreads();
    const float rs = rsqrtf((ssb[32 * lt + r] + ssb[128 + 32 * lt + r]) * (1.f / 192.f) + EPS);
#pragma unroll
    for (int hh3 = 0; hh3 < 3; ++hh3)
#pragma unroll
        for (int q4 = 0; q4 < 4; ++q4) { const int p0 = 32 * pb + 8 * q4 + 4 * hh, chn = g * 192 + hh3 * 64 + p0;
            const f32x4 nw = *(const f32x4*)(ssdn + l * 384 + chn);
            v2u w; w.x = pk2(Y[hh3][4 * q4] * rs * nw.x, Y[hh3][4 * q4 + 1] * rs * nw.y); w.y = pk2(Y[hh3][4 * q4 + 2] * rs * nw.z, Y[hh3][4 * q4 + 3] * rs * nw.w);
            *(v2u*)(MIX + grow * D + 384 + chn) = w; }
}
constexpr int PL_S = 528;
__device__ __forceinline__ void pool_unit(const Params& P, int l, int unit, LAS unsigned char* lds, int tid, int wid, int lane) {
    const bf16* U = (const bf16*)(P.ws + WS_U); bf16* MIX = (bf16*)(P.ws + WS_H);
    const bf16* pwt = (const bf16*)(P.ws + WS_PWT) + (size_t)l * 4 * 4096;
    const float* pscale = P.in[I_POOLS]; asm volatile("" : "+s"(pscale));
    const size_t row0 = (size_t)unit * 64;
    __syncthreads();
    { const int cc = tid & 31, ts = tid >> 5, g = cc >> 3, W = 2 << g;
      const bf16* src = U + row0 * NIN + UP + cc * 8;
      f32x4 s0 = {0.f, 0.f, 0.f, 0.f}, s1 = s0;
      const int t0 = ts * 4, pos0 = (int)((row0 + t0) & (SEQ - 1));
#pragma unroll
      for (int i = 1; i < 16; ++i) if (i < W && i <= pos0) { const v4u q = *(const v4u*)(src + (ptrdiff_t)(t0 - i) * NIN);
          s0.x += bf2f(q.x & 0xffff); s0.y += bf2f(q.x >> 16); s0.z += bf2f(q.y & 0xffff); s0.w += bf2f(q.y >> 16);
          s1.x += bf2f(q.z & 0xffff); s1.y += bf2f(q.z >> 16); s1.z += bf2f(q.w & 0xffff); s1.w += bf2f(q.w >> 16); }
#pragma unroll
      for (int t = 0; t < 4; ++t) {
          const int tok = t0 + t, pos = pos0 + t;
          const v4u q = *(const v4u*)(src + (size_t)tok * NIN);
          const f32x4 x0 = {bf2f(q.x & 0xffff), bf2f(q.x >> 16), bf2f(q.y & 0xffff), bf2f(q.y >> 16)}, x1 = {bf2f(q.z & 0xffff), bf2f(q.z >> 16), bf2f(q.w & 0xffff), bf2f(q.w >> 16)};
          s0 += x0; s1 += x1;
          if (t > 0 && pos - W >= 0) { const v4u o = *(const v4u*)(src + (ptrdiff_t)(tok - W) * NIN);
              const f32x4 y0 = {bf2f(o.x & 0xffff), bf2f(o.x >> 16), bf2f(o.y & 0xffff), bf2f(o.y >> 16)}, y1 = {bf2f(o.z & 0xffff), bf2f(o.z >> 16), bf2f(o.w & 0xffff), bf2f(o.w >> 16)};
              s0 -= y0; s1 -= y1; }
          const float inv = 1.f / (float)(pos + 1 < W ? pos + 1 : W);
          const f32x4 d0 = s0 * inv - x0, d1 = s1 * inv - x1;
          v4u pk; pk.x = pk2(d0.x, d0.y); pk.y = pk2(d0.z, d0.w); pk.z = pk2(d1.x, d1.y); pk.w = pk2(d1.z, d1.w);
          *(LAS v4u*)(lds + tok * PL_S + cc * 16) = pk;
      } }
    __syncthreads();
    const int r = lane & 31, hh = lane >> 5, g = wid >> 1, dt = wid & 1;
    s16x8 wa[4];
#pragma unroll
    for (int s = 0; s < 4; ++s) wa[s] = __builtin_bit_cast(s16x8, *(const v4u*)(pwt + (size_t)g * 4096 + (32 * dt + r) * 64 + 16 * s + 8 * hh));
#pragma unroll
    for (int tt = 0; tt < 2; ++tt) {
        f32x16 acc;
#pragma unroll
        for (int e = 0; e < 16; ++e) acc[e] = 0.f;
#pragma unroll
        for (int s = 0; s < 4; ++s) { const s16x8 bq = *(LAS const s16x8*)(lds + (32 * tt + r) * PL_S + (g * 64 + 16 * s + 8 * hh) * 2); acc = MFMA32(wa[s], bq, acc); }
        bf16* orow = MIX + (row0 + 32 * tt + r) * D + 768 + g * 64 + 32 * dt + 4 * hh;
#pragma unroll
        for (int q4 = 0; q4 < 4; ++q4) { const f32x4 sc = *(const f32x4*)(pscale + l * 256 + g * 64 + 32 * dt + 4 * hh + 8 * q4);
            v2u w; w.x = pk2(acc[4 * q4] * sc.x, acc[4 * q4 + 1] * sc.y); w.y = pk2(acc[4 * q4 + 2] * sc.z, acc[4 * q4 + 3] * sc.w);
            *(v2u*)(orow + 8 * q4) = w; }
    }
}
#define XB_TMO      128
#define XB_XCNT(j)  (256  + 64 * (j))
#define XB_XSUB(j)  (1280 + 64 * (j))
#define XB_XGEN(j)  (2304 + 64 * (j))
#define XB_TOP      3328
#define XB_TOPGEN   3392
#define XCD_BAR_WORDS 3456
#define XB_SPIN_CAP (1u << 18)

__device__ __forceinline__ unsigned xb_ld(unsigned* p)              { return __hip_atomic_load(p, __ATOMIC_RELAXED, __HIP_MEMORY_SCOPE_AGENT); }
__device__ __forceinline__ unsigned xb_add(unsigned* p, unsigned v) { return __hip_atomic_fetch_add(p, v, __ATOMIC_RELAXED, __HIP_MEMORY_SCOPE_AGENT); }
__device__ __forceinline__ unsigned xb_xcc_id() { return (unsigned)__builtin_amdgcn_s_getreg((3 << 11) | 20) & 0xFu; }
#define XB_SPIN(cond, bar) do { unsigned _sp = 0; while (cond) { __builtin_amdgcn_s_sleep(1); \
    if ((++_sp & 255u) == 0u) { if (xb_ld(&(bar)[XB_TMO])) break; if (_sp > XB_SPIN_CAP) { atomicAdd(&(bar)[XB_TMO], 1u); break; } } } } while (0)

struct XcdBarrier {
    unsigned* bar; unsigned x;
    volatile LAS unsigned* st;
};

__device__ __forceinline__ XcdBarrier xcd_barrier_post(unsigned* bar, volatile LAS unsigned* st, const bool leader) {
    XcdBarrier b; b.bar = bar; b.x = xb_xcc_id(); b.st = st;
    if (leader) (void)xb_add(&bar[XB_XCNT(b.x)], 1u);
    return b;
}
__device__ __forceinline__ void xcd_barrier_complete(unsigned* bar, unsigned x, unsigned& nloc, unsigned& nx) {
    const unsigned G = gridDim.x * gridDim.y * gridDim.z;
    unsigned sum, cnt, mine, sp = 0u;
    for (;;) {
        sum = 0u; cnt = 0u; mine = 0u;
#pragma unroll
        for (unsigned j = 0; j < 16; ++j) { const unsigned c = xb_ld(&bar[XB_XCNT(j)]); sum += c; cnt += (c > 0u) ? 1u : 0u; mine = (j == x) ? c : mine; }
        if (sum == G) break;
        __builtin_amdgcn_s_sleep(1);
        if ((++sp & 255u) == 0u) { if (xb_ld(&bar[XB_TMO])) break; if (sp > XB_SPIN_CAP) { atomicAdd(&bar[XB_TMO], 1u); break; } }
    }
    nloc = mine > 0u ? mine : 1u; nx = cnt > 0u ? cnt : 1u;
}

__device__ __forceinline__ void xcd_barrier(const XcdBarrier& b, const bool leader) {
    asm volatile("s_waitcnt vmcnt(0)" ::: "memory");
    __syncthreads();
    if (leader) {
        unsigned* bar = b.bar;
        __builtin_amdgcn_s_waitcnt(0);
        unsigned nloc = b.st[0], nx = b.st[1];
        if (nloc == 0u) { xcd_barrier_complete(bar, b.x, nloc, nx); b.st[0] = nloc; b.st[1] = nx; }
        const unsigned old = xb_add(&bar[XB_XSUB(b.x)], 1u);
        const unsigned gen = old / nloc;
        if (old + 1u == (gen + 1u) * nloc) {
            __builtin_amdgcn_fence(__ATOMIC_RELEASE, "agent");
            asm volatile("s_waitcnt vmcnt(0)" ::: "memory");
            const unsigned og = xb_add(&bar[XB_TOP], 1u);
            const unsigned tg = og / nx;
            if (og + 1u == (tg + 1u) * nx) xb_add(&bar[XB_TOPGEN], 1u);
            else XB_SPIN(xb_ld(&bar[XB_TOPGEN]) == tg, bar);
            __builtin_amdgcn_fence(__ATOMIC_ACQUIRE, "agent");
            xb_add(&bar[XB_XGEN(b.x)], 1u);
            asm volatile("s_waitcnt vmcnt(0)" ::: "memory");
        } else {
            XB_SPIN(xb_ld(&bar[XB_XGEN(b.x)]) == gen, bar);
            __builtin_amdgcn_fence(__ATOMIC_ACQUIRE, "agent");
            asm volatile("s_waitcnt vmcnt(0)" ::: "memory");
        }
    }
    __syncthreads();
}
constexpr int BAR_LDS_OFF = LDS_BYTES - 16;
constexpr size_t WS_BAR = 65536;
__device__ __forceinline__ bool is_leader(int wid0) { int lane; asm volatile("v_mbcnt_lo_u32_b32 %0, -1, 0\n\tv_mbcnt_hi_u32_b32 %0, -1, %0" : "=v"(lane)); return wid0 == 0 && lane == 0; }
__device__ __forceinline__ void grid_sync(unsigned char* ws, LAS unsigned char* lds, int wid0) {
    XcdBarrier b; b.bar = (unsigned*)(ws + WS_BAR); b.x = xb_xcc_id(); b.st = (volatile LAS unsigned*)(lds + BAR_LDS_OFF);
    xcd_barrier(b, is_leader(wid0));
}
template <int PH> __device__ __forceinline__ void run_phase(const Params& P0, LAS unsigned char* lds, const int wid0) {
    Params P = P0; asm volatile("" : "+s"(P.ws), "+s"(P.out));
#pragma unroll
    for (int i = 0; i < 16; ++i) asm volatile("" : "+s"(P.in[i]));
    int lane_; asm volatile("v_mbcnt_lo_u32_b32 %0, -1, 0\n\tv_mbcnt_hi_u32_b32 %0, -1, %0" : "=v"(lane_));
    int wid_ = wid0; asm volatile("" : "+s"(wid_));
    const int tid = wid_ * 64 + lane_;
    int bid = blockIdx.x, G = gridDim.x; asm volatile("" : "+s"(bid), "+s"(G));
    const int lane = lane_, wid = wid_;
    if constexpr (PH == 0) phase_prologue(P, lds, bid, G, tid, wid, lane);
    else if constexpr (PH == N_PHASES - 1) phase_norm(P, 0, 2, bid, G, wid, lane);
    else {
        constexpr int l = (PH - 1) / NPH, s = (PH - 1) % NPH;
        float* RS = (float*)(P.ws + WS_RS);
        if constexpr (s == 0) { pg8::Gemm g{(const pg8::bf16_t*)(P.ws + WS_XB), (const pg8::bf16_t*)(P.ws + WS_WIN) + (size_t)l * NIN * D, T, NIN, D};
            pg8::StaticOrder S; S.init(T, NIN, G, bid); const int fm = pg8::stage_rstd(RS + (size_t)(2 * l) * T * 16, lds, S, tid);
            pg8::EpiStoreBf16 E{(pg8::bf16_t*)(P.ws + WS_U), NIN, RS + (size_t)(2 * l) * T * 16, (float*)(P.ws + WS_DT), P.in[I_DTB] + l * 6, (const LAS float*)(lds + pg8::RSTD_LDS_OFF), fm};
            pg8::gemm_phase<pg8::EpiStoreBf16, pg8::StaticOrder, true, true>(lds, g, S, E, tid); }
        else if constexpr (s == 1) {
            if (G == 256) {
                for (int k = 0; k < 2 * (1 + (DUP_MIX & 1)); ++k) { const int u = (k & 1) == 0 ? bid : 383 - bid;
                    if ((k & 1) == 1 && bid >= 128) continue;
                    int t2 = tid; asm volatile("" : "+v"(t2));
                    attn_unit(P, (u % 48) / 6, (u % 48) % 6, 7 - u / 48, lds, t2, wid, t2 & 63); }
            } else for (int u = bid; u < 384; u += G) attn_unit(P, (u % 48) / 6, (u % 48) % 6, 7 - u / 48, lds, tid, wid, lane);
            { unsigned* qctr = (unsigned*)(P.ws + WS_CTL) + 64 * (l + 1);
              volatile LAS unsigned* qslot = (volatile LAS unsigned*)(lds + BAR_LDS_OFF + 8);
              for (;;) {
                  __syncthreads();
                  if (tid == 0) *qslot = __hip_atomic_fetch_add(qctr, 1u, __ATOMIC_RELAXED, __HIP_MEMORY_SCOPE_AGENT);
                  __syncthreads();
                  const int q = (int)*qslot;
                  if (q >= 240 + 256) break;
                  int t2 = tid; asm volatile("" : "+v"(t2));
                  if (q < 240) { const int bb = q / 30, rem = q % 30; ssd_unit_a(P, l, bb, rem >> 1, rem & 1, lds, t2, wid, t2 & 63); }
                  else pool_unit(P, l, q - 240, lds, t2, wid, t2 & 63);
              } }
        }
        else if constexpr (s == 2) ssd_scan(P, bid, G, tid);
        else if constexpr (s == 3) { for (int u = bid; u < 256; u += G) { int t2 = tid; asm volatile("" : "+v"(t2)); ssd_unit_b(P, l, u >> 5, (u >> 1) & 15, u & 1, lds, t2, wid, t2 & 63); } }
        else if constexpr (s == 4) { pg8::Gemm g{(const pg8::bf16_t*)(P.ws + WS_H), (const pg8::bf16_t*)(P.ws + WS_WOUT) + (size_t)l * D * D, T, D, D};
            pg8::StaticOrder S; S.init(T, D, G, bid); pg8::EpiResidual<l == 0> E{P.in[I_X], D, (pg8::bf16_t*)(P.ws + WS_XB), RS + (size_t)(2 * l + 1) * T * 16};
            pg8::gemm_phase<pg8::EpiResidual<l == 0>, pg8::StaticOrder, true, true>(lds, g, S, E, tid); }
        else if constexpr (s == 5) { pg8::Gemm g{(const pg8::bf16_t*)(P.ws + WS_XB), (const pg8::bf16_t*)(P.ws + WS_WGU) + (size_t)l * NGU * D, T, NGU, D};
            pg8::StaticOrder S; S.init(T, NGU, G, bid); const int fm = pg8::stage_rstd(RS + (size_t)(2 * l + 1) * T * 16, lds, S, tid);
            pg8::EpiSwiGLU E{(pg8::bf16_t*)(P.ws + WS_U), FF, RS + (size_t)(2 * l + 1) * T * 16, (const LAS float*)(lds + pg8::RSTD_LDS_OFF), fm};
            pg8::gemm_phase<pg8::EpiSwiGLU, pg8::StaticOrder, true, true>(lds, g, S, E, tid); }
        else { pg8::Gemm g{(const pg8::bf16_t*)(P.ws + WS_U), (const pg8::bf16_t*)(P.ws + WS_WD) + (size_t)l * D * FF, T, D, FF};
            pg8::StaticOrder S; S.init(T, D, G, bid); pg8::EpiResidual<false> E{nullptr, D, (pg8::bf16_t*)(P.ws + WS_XB), RS + (size_t)(2 * l + 2) * T * 16};
            pg8::gemm_phase<pg8::EpiResidual<false>, pg8::StaticOrder, true, true>(lds, g, S, E, tid); }
    }
}
template <int PH> __device__ __forceinline__ void run_all(const Params& P0, LAS unsigned char* lds, const int wid0, const int lo, const int hi) {
    if constexpr (PH < N_PHASES) {
        if (PH >= lo && PH < hi) { run_phase<PH>(P0, lds, wid0);
#if DUP_S
            if constexpr (PH >= 1 && PH < N_PHASES - 1 && ((DUP_S >> ((PH - 1) % NPH)) & 1)) { __syncthreads(); run_phase<PH>(P0, lds, wid0); }
            if constexpr (PH == 0 && ((DUP_S >> 30) & 1)) { __syncthreads(); run_phase<PH>(P0, lds, wid0); }
#endif
            if (PH + 1 < hi) {
#pragma unroll
                for (int rep = 0; rep < SYNC_REP; ++rep) grid_sync(P0.ws, lds, wid0); } }
        run_all<PH + 1>(P0, lds, wid0, lo, hi);
    }
}
__global__ void __launch_bounds__(512, 2) mega(Params P0) {
    extern __shared__ __attribute__((aligned(16))) unsigned char lds_raw[];
    LAS unsigned char* lds = (LAS unsigned char*)lds_raw;
    const int wid0 = __builtin_amdgcn_readfirstlane(threadIdx.x >> 6);
    { const bool leader = is_leader(wid0);
      if (leader) { ((volatile LAS unsigned*)(lds + BAR_LDS_OFF))[0] = 0u; ((volatile LAS unsigned*)(lds + BAR_LDS_OFF))[1] = 0u; }
      __syncthreads();
      if (P0.ph_hi - P0.ph_lo > 1) (void)xcd_barrier_post((unsigned*)(P0.ws + WS_BAR), (volatile LAS unsigned*)(lds + BAR_LDS_OFF), leader); }
    run_all<0>(P0, lds, wid0, P0.ph_lo, P0.ph_hi);
}

#ifndef ONE_LAUNCH
#define ONE_LAUNCH 1
#endif
extern "C" void kernel_launch(void* const* d_in, const int* in_sizes, int n_in, void* d_out, int out_size, void* d_ws, size_t ws_size, hipStream_t stream) {
    static int grid = 0;
    if (grid == 0) {
        if (n_in != 16 || out_size != T * D || ws_size < WS_END) { fprintf(stderr, "kernel_launch: unexpected shapes n_in %d out %d ws %zu\n", n_in, out_size, ws_size); grid = -1; return; }
        int dev = 0, cus = 0, per_cu = 0;
        hipGetDevice(&dev); hipDeviceGetAttribute(&cus, hipDeviceAttributeMultiprocessorCount, dev);
        if (hipFuncSetAttribute((const void*)mega, hipFuncAttributeMaxDynamicSharedMemorySize, LDS_BYTES) != hipSuccess) { fprintf(stderr, "kernel_launch: hipFuncSetAttribute failed\n"); grid = -1; return; }
        hipOccupancyMaxActiveBlocksPerMultiprocessor(&per_cu, (const void*)mega, 512, LDS_BYTES);
        if (per_cu < 1) { fprintf(stderr, "kernel_launch: occupancy query says %d\n", per_cu); per_cu = 1; }
        (void)hipGetLastError();
        grid = cus * per_cu;
    }
    if (grid < 0) return;
    if (hipMemsetAsync((char*)d_ws + WS_CTL, 0, 131072, stream) != hipSuccess) { fprintf(stderr, "kernel_launch: memset failed\n"); return; }
    Params p{};
    for (int i = 0; i < 16; ++i) p.in[i] = (const float*)d_in[i];
    p.out = (float*)d_out; p.ws = (unsigned char*)d_ws;
#if ONE_LAUNCH
    p.ph_lo = 0; p.ph_hi = N_PHASES;
    void* args[] = {&p};
    hipError_t e = hipLaunchCooperativeKernel((const void*)mega, dim3(grid), dim3(512), args, LDS_BYTES, stream);
    if (e != hipSuccess) fprintf(stderr, "cooperative launch failed: %s (grid %d)\n", hipGetErrorString(e), grid);
#else
    for (int ph = 0; ph < N_PHASES; ++ph) { p.ph_lo = ph; p.ph_hi = ph + 1; hipLaunchKernelGGL(mega, dim3(grid), dim3(512), LDS_BYTES, stream, p); }
#endif
}
```

```cpp
#include <hip/hip_runtime.h>
#include <hip/hip_cooperative_groups.h>
#include <cstdio>
#include <cstdint>
namespace cg = cooperative_groups;
#ifndef EPI_REP
#define EPI_REP 0
#endif
namespace pg8 {
#define PG8_LAS __attribute__((address_space(3)))
typedef unsigned short bf16_t;
typedef short bf16x8 __attribute__((ext_vector_type(8)));
typedef float f32x4 __attribute__((ext_vector_type(4)));
typedef unsigned u32x4 __attribute__((ext_vector_type(4)));
constexpr int BM = 256, BK = 64, HALF = 128, HTB = HALF * BK * 2  , STAGE_BYTES = 8 * HTB, NXCD = 8, WGM = 8;

__host__ __device__ __forceinline__ int lds_byte(int r, int c) { const int st = (r >> 4) * 2 + (c >> 5), rr = r & 15, cc = c & 31, ob = rr * 64 + cc * 2; return st * 1024 + (ob ^ (((ob >> 9) & 1) << 5)); }
__host__ __device__ __forceinline__ void stage_rc(int b, int& R, int& C) { const int st = b / 1024, sb = b % 1024, swz = sb ^ (((sb >> 9) & 1) << 5); R = (st >> 1) * 16 + swz / 64; C = (st & 1) * 32 + (swz % 64) / 2; }
__host__ __device__ __forceinline__ int perm32(int rho) { const int n = rho >> 4, i = rho & 15; return 8 * (i >> 2) + 4 * n + (i & 3); }

struct Unit { int pm, pn; };
struct Gemm { const bf16_t* A; const bf16_t* Bt; int M, N, K; };

struct StaticOrder {
    int nM, nN, nwg, G, c;
    __host__ __device__ void init(int M, int N, int G_, int c_) { nM = M / BM; nN = N / BM; nwg = nM * nN; G = G_; c = c_; }
    __host__ __device__ bool next(int i, Unit& u) const {
        const long L = (long)i * G + c; if (L >= nwg) return false;
        int wgid = (int)L; { const int q = nwg / NXCD, r = nwg % NXCD, xcd = wgid % NXCD, off = wgid / NXCD; wgid = (xcd < r ? xcd * (q + 1) : r * (q + 1) + (xcd - r) * q) + off; }
        const int nig = WGM * nN, gid = wgid / nig, fm = gid * WGM, gsz = (nM - fm) < WGM ? (nM - fm) : WGM;
        u.pm = fm + ((wgid % nig) % gsz); u.pn = (wgid % nig) / gsz; return true;
    }
    __device__ __forceinline__ void a_ready(const Unit&) const {}
    __device__ __forceinline__ void done(const Unit&) const {}
};

__device__ __forceinline__ unsigned cvt_pk_bf16(float lo, float hi) { unsigned r; asm volatile("v_cvt_pk_bf16_f32 %0, %1, %2" : "=v"(r) : "v"(lo), "v"(hi)); return r; }
__device__ __forceinline__ float rstd_of(const float* rs, size_t row) {
    const f32x4 a = *(const f32x4*)(rs + row * 16), b = *(const f32x4*)(rs + row * 16 + 4), c = *(const f32x4*)(rs + row * 16 + 8), d = *(const f32x4*)(rs + row * 16 + 12);
    const float t = (((a[0] + a[1]) + (a[2] + a[3])) + ((b[0] + b[1]) + (b[2] + b[3]))) + (((c[0] + c[1]) + (c[2] + c[3])) + ((d[0] + d[1]) + (d[2] + d[3])));
    return __builtin_amdgcn_rsqf(t * (1.f / 1024.f) + 1e-6f);
}
constexpr int RSTD_LDS_OFF = 131072;
template <class Sched> __device__ __forceinline__ int stage_rstd(const float* rs, PG8_LAS unsigned char* lds, const Sched& S, int tid) {
    Unit u0; if (!S.next(0, u0)) return 0;
    const int fm = (u0.pm >> 3) << 3;
    PG8_LAS float* rl = (PG8_LAS float*)(lds + RSTD_LDS_OFF);
#pragma unroll
    for (int k = 0; k < 4; ++k) rl[tid + 512 * k] = rstd_of(rs, (size_t)fm * BM + tid + 512 * k);
    __syncthreads();
    return fm;
}
#define RSV_LOAD(rsv, rs, rl, fm, row0) do { _Pragma("unroll") for (int ai_ = 0; ai_ < 2; ++ai_) _Pragma("unroll") for (int m_ = 0; m_ < 4; ++m_) { \
    const int ri_ = (row0) + ai_ * HALF + m_ * 16 - (fm) * BM; (rsv)[ai_][m_] = ((unsigned)ri_ < 2048u) ? (rl)[ri_] : rstd_of((rs), (size_t)((row0) + ai_ * HALF + m_ * 16)); } } while (0)
__device__ __forceinline__ float softplus_f(float z) { return fmaxf(z, 0.f) + log1pf(__expf(-fabsf(z))); }
struct EpiStoreBf16 { static constexpr bool IDEMP = true;
    static constexpr bool PERM = true, AFTER_DRAIN = false;
    bf16_t* O; int ldc; const float* rs; float* DT; const float* dtb; const PG8_LAS float* rl; int fm;
    __device__ __forceinline__ void operator()(const f32x4 (&acc)[2][2][4][2], const Unit& u, int wr, int wc, int fr, int fq) const {
        const int row0 = u.pm * BM + wr * 64 + fr; const int col0 = u.pn * BM + wc * 32 + 8 * fq;
        const bool dtl = (u.pn == 10) && (wc == 0) && (fq == 0);
        float rsv[2][4];
        RSV_LOAD(rsv, rs, rl, fm, row0);
#pragma unroll
        for (int ai = 0; ai < 2; ++ai)
#pragma unroll
            for (int m = 0; m < 4; ++m) { const size_t row = (size_t)(row0 + ai * HALF + m * 16); bf16_t* rowp = O + row * ldc + col0;
                const float rstd = rsv[ai][m];
#pragma unroll
                for (int bj = 0; bj < 2; ++bj) { const f32x4 v0 = acc[ai][bj][m][0] * rstd, v1 = acc[ai][bj][m][1] * rstd;
                    u32x4 w; w.x = cvt_pk_bf16(v0[0], v0[1]); w.y = cvt_pk_bf16(v0[2], v0[3]); w.z = cvt_pk_bf16(v1[0], v1[1]); w.w = cvt_pk_bf16(v1[2], v1[3]);
                    *(u32x4*)(rowp + bj * HALF) = w;
                    if (bj == 1 && dtl) { f32x4 d0; d0[0] = softplus_f(v0[0] + dtb[0]); d0[1] = softplus_f(v0[1] + dtb[1]); d0[2] = softplus_f(v0[2] + dtb[2]); d0[3] = softplus_f(v0[3] + dtb[3]);
                        *(f32x4*)(DT + row * 8) = d0; DT[row * 8 + 4] = softplus_f(v1[0] + dtb[4]); DT[row * 8 + 5] = softplus_f(v1[1] + dtb[5]); } }
                __builtin_amdgcn_sched_barrier(0); }
    }
};
template <bool R32> struct EpiResidual { static constexpr bool IDEMP = false;
    static constexpr bool PERM = true, AFTER_DRAIN = false;
    const float* R; int ld; bf16_t* XB; float* RSO;
    __device__ __forceinline__ void operator()(const f32x4 (&acc)[2][2][4][2], const Unit& u, int wr, int wc, int fr, int fq) const {
        const int row0 = u.pm * BM + wr * 64 + fr; const int col0 = u.pn * BM + wc * 32 + 8 * fq;
#pragma unroll
        for (int ai = 0; ai < 2; ++ai) {
            f32x4 rv[4][2][2];
#pragma unroll
            for (int m = 0; m < 4; ++m)
#pragma unroll
                for (int bj = 0; bj < 2; ++bj) { const size_t off = (size_t)(row0 + ai * HALF + m * 16) * ld + col0 + bj * HALF;
                    if constexpr (R32) { rv[m][bj][0] = *(const f32x4*)(R + off); rv[m][bj][1] = *(const f32x4*)(R + off + 4); }
                    else { const u32x4 q = *(const u32x4*)(XB + off);
                        rv[m][bj][0] = (f32x4){__builtin_bit_cast(float, q.x << 16), __builtin_bit_cast(float, q.x & 0xffff0000u), __builtin_bit_cast(float, q.y << 16), __builtin_bit_cast(float, q.y & 0xffff0000u)};
                        rv[m][bj][1] = (f32x4){__builtin_bit_cast(float, q.z << 16), __builtin_bit_cast(float, q.z & 0xffff0000u), __builtin_bit_cast(float, q.w << 16), __builtin_bit_cast(float, q.w & 0xffff0000u)}; } }
#pragma unroll
            for (int m = 0; m < 4; ++m) { const size_t row = (size_t)(row0 + ai * HALF + m * 16); const size_t off = row * ld + col0;
                float ss = 0.f;
#pragma unroll
                for (int bj = 0; bj < 2; ++bj) {
                    const f32x4 x0 = rv[m][bj][0] + acc[ai][bj][m][0], x1 = rv[m][bj][1] + acc[ai][bj][m][1];
                    u32x4 w; w.x = cvt_pk_bf16(x0[0], x0[1]); w.y = cvt_pk_bf16(x0[2], x0[3]); w.z = cvt_pk_bf16(x1[0], x1[1]); w.w = cvt_pk_bf16(x1[2], x1[3]);
                    *(u32x4*)(XB + off + bj * HALF) = w;
                    ss += ((x0[0] * x0[0] + x0[1] * x0[1]) + (x0[2] * x0[2] + x0[3] * x0[3])) + ((x1[0] * x1[0] + x1[1] * x1[1]) + (x1[2] * x1[2] + x1[3] * x1[3])); }
                ss += __builtin_bit_cast(float, __builtin_amdgcn_ds_swizzle(__builtin_bit_cast(int, ss), (16 << 10) | 0x1f));
                { float a = ss, b = ss; asm volatile("s_nop 1\n\tv_permlane32_swap_b32 %0, %1" : "+v"(a), "+v"(b)); ss = a + b; }
                if (fq == 0) RSO[row * 16 + u.pn * 4 + wc] = ss; }
            __builtin_amdgcn_sched_barrier(0); }
    }
};
__device__ __forceinline__ float silu_f(float g) { return g * __builtin_amdgcn_rcpf(1.f + __expf(-g)); }
struct EpiSwiGLU { static constexpr bool IDEMP = true;
    static constexpr bool PERM = true, AFTER_DRAIN = false;
    bf16_t* O; int ldc; const float* rs; const PG8_LAS float* rl; int fm;
    __device__ __forceinline__ void operator()(const f32x4 (&acc)[2][2][4][2], const Unit& u, int wr, int wc, int fr, int fq) const {
        const int row0 = u.pm * BM + wr * 64 + fr; const int col0 = u.pn * HALF + wc * 32 + 8 * fq;
        float rsv[2][4];
        RSV_LOAD(rsv, rs, rl, fm, row0);
#pragma unroll
        for (int ai = 0; ai < 2; ++ai)
#pragma unroll
            for (int m = 0; m < 4; ++m) { const size_t row = (size_t)(row0 + ai * HALF + m * 16); bf16_t* rowp = O + row * ldc + col0;
                const float rstd = rsv[ai][m];
                const f32x4 g0 = acc[ai][0][m][0] * rstd, g1 = acc[ai][0][m][1] * rstd, u0 = acc[ai][1][m][0] * rstd, u1 = acc[ai][1][m][1] * rstd;
                u32x4 w; w.x = cvt_pk_bf16(silu_f(g0[0]) * u0[0], silu_f(g0[1]) * u0[1]); w.y = cvt_pk_bf16(silu_f(g0[2]) * u0[2], silu_f(g0[3]) * u0[3]);
                w.z = cvt_pk_bf16(silu_f(g1[0]) * u1[0], silu_f(g1[1]) * u1[1]); w.w = cvt_pk_bf16(silu_f(g1[2]) * u1[2], silu_f(g1[3]) * u1[3]);
                *(u32x4*)rowp = w; __builtin_amdgcn_sched_barrier(0); }
    }
};
template <class Epi, class Sched, bool ALIGN_EPI = false, bool SP2 = false>
__device__ __forceinline__ void gemm_phase(PG8_LAS unsigned char* lds, const Gemm g, const Sched& S, const Epi& E, const int tid) {
    const int wid = __builtin_amdgcn_readfirstlane(tid >> 6), lane = tid & 63, wr = wid >> 2, wc = wid & 3, fr = lane & 15, fq = lane >> 4;
    const int K = g.K, nt = K / BK;
    unsigned voffA[2], voffB[2];
#pragma unroll
    for (int i = 0; i < 2; ++i) { int R, C; stage_rc(tid * 16 + i * 8192, R, C); const int Rb = Epi::PERM ? ((R & ~31) + perm32(R & 31)) : R;
        voffA[i] = (unsigned)(R * K + C) * 2u; voffB[i] = (unsigned)(Rb * K + C) * 2u; }
    const size_t kstep = (size_t)(BK * 2);
    const size_t hstep = (size_t)HALF * K * 2;
    const size_t tstep = 2 * hstep;
    const unsigned ldsw = (unsigned)wid * 1024u;
    const int aoff = lds_byte(wr * 64 + fr, fq * 8), boff = lds_byte(wc * 32 + fr, fq * 8);
#define PG8_SA(b, h) (((b) * 2 + (h)) * HTB)
#define PG8_SB(b, h) ((4 + (b) * 2 + (h)) * HTB)
#define PG8_STAGE(bufoff, gbase, voff) do { _Pragma("unroll") for (int _i = 0; _i < 2; ++_i) \
        __builtin_amdgcn_global_load_lds((const unsigned*)((const char*)(gbase) + (voff)[_i]), (PG8_LAS unsigned*)(lds + (bufoff) + ldsw + _i * 8192), 16, 0, 0); } while (0)
#define PG8_LDA(dst, b, h) do { _Pragma("unroll") for (int m = 0; m < 4; ++m) _Pragma("unroll") for (int k = 0; k < 2; ++k) dst[m][k] = *(const PG8_LAS bf16x8*)(lds + PG8_SA(b, h) + aoff + m * 2048 + k * 1024); } while (0)
#define PG8_LDB(dst, b, h) do { _Pragma("unroll") for (int n = 0; n < 2; ++n) _Pragma("unroll") for (int k = 0; k < 2; ++k) dst[n][k] = *(const PG8_LAS bf16x8*)(lds + PG8_SB(b, h) + boff + n * 2048 + k * 1024); } while (0)
#define PG8_MMA(ai, bj, At, Bt) do { __builtin_amdgcn_s_setprio(1); _Pragma("unroll") for (int m = 0; m < 4; ++m) _Pragma("unroll") for (int n = 0; n < 2; ++n) _Pragma("unroll") for (int k = 0; k < 2; ++k) \
        acc[ai][bj][m][n] = __builtin_amdgcn_mfma_f32_16x16x32_bf16(Bt[n][k], At[m][k], acc[ai][bj][m][n], 0, 0, 0); __builtin_amdgcn_s_setprio(0); } while (0)
#define PG8_WAIT_V(n) asm volatile("s_waitcnt vmcnt(" #n ")" ::: "memory")
#define PG8_WAIT_L(n) asm volatile("s_waitcnt lgkmcnt(" #n ")" ::: "memory")
#define PG8_BAR __builtin_amdgcn_s_barrier()
#define PG8_SCHED __builtin_amdgcn_sched_barrier(0)
    Unit cur, nxt; int ui = 0;
    if (!S.next(0, cur)) return;
    f32x4 acc[2][2][4][2];
#pragma unroll
    for (int a = 0; a < 2; ++a)
#pragma unroll
        for (int b = 0; b < 2; ++b)
#pragma unroll
            for (int m = 0; m < 4; ++m)
#pragma unroll
                for (int n = 0; n < 2; ++n) acc[a][b][m][n] = (f32x4){0.f, 0.f, 0.f, 0.f};
    bf16x8 At[4][2], B0[2][2], B1[2][2];
    const char* cA = (const char*)g.A + (size_t)cur.pm * tstep; const char* cB = (const char*)g.Bt + (size_t)cur.pn * tstep;
    S.a_ready(cur);
    if constexpr (SP2) {
        PG8_STAGE(PG8_SB(0, 0), cB, voffB); PG8_STAGE(PG8_SB(0, 1), cB + hstep, voffB); PG8_STAGE(PG8_SA(0, 0), cA, voffA); PG8_STAGE(PG8_SA(0, 1), cA + hstep, voffA);
        if (wr == 1) PG8_BAR;
        PG8_WAIT_V(2); PG8_BAR;
        PG8_STAGE(PG8_SB(1, 0), cB + kstep, voffB); PG8_STAGE(PG8_SA(1, 0), cA + kstep, voffA); PG8_STAGE(PG8_SB(1, 1), cB + hstep + kstep, voffB);
        PG8_WAIT_V(6); PG8_BAR;
    } else {
        PG8_STAGE(PG8_SB(0, 0), cB, voffB); PG8_STAGE(PG8_SA(0, 0), cA, voffA); PG8_STAGE(PG8_SB(0, 1), cB + hstep, voffB); PG8_STAGE(PG8_SA(0, 1), cA + hstep, voffA);
        if (wr == 1) PG8_BAR;
        PG8_WAIT_V(4); PG8_BAR;
        PG8_STAGE(PG8_SB(1, 0), cB + kstep, voffB); PG8_STAGE(PG8_SA(1, 0), cA + kstep, voffA); PG8_STAGE(PG8_SB(1, 1), cB + hstep + kstep, voffB);
        PG8_WAIT_V(6); PG8_BAR;
    }
    for (;;) {
        const bool has_next = S.next(ui + 1, nxt);
        const char* nA = has_next ? (const char*)g.A + (size_t)nxt.pm * tstep : cA; const char* nB = has_next ? (const char*)g.Bt + (size_t)nxt.pn * tstep : cB;
        for (int t = 0; t < nt; t += 2) {
            const bool last = (t == nt - 2);
            const char* a1 = cA + (size_t)(t + 1) * kstep;
            const char* a2 = last ? nA : cA + (size_t)(t + 2) * kstep; const char* b2 = last ? nB : cB + (size_t)(t + 2) * kstep;
            const char* a3 = a2 + kstep; const char* b3 = b2 + kstep;
            if (last && has_next) S.a_ready(nxt);
            if constexpr (SP2) {
            PG8_LDB(B0, 0, 0); PG8_LDB(B1, 0, 1); PG8_SCHED; PG8_LDA(At, 0, 0); PG8_STAGE(PG8_SA(1, 1), a1 + hstep, voffA);
            PG8_WAIT_V(8); PG8_WAIT_L(0); PG8_BAR; PG8_MMA(0, 0, At, B0); PG8_MMA(0, 1, At, B1); PG8_BAR; PG8_SCHED;
            PG8_LDA(At, 0, 1); PG8_STAGE(PG8_SB(0, 0), b2, voffB); PG8_STAGE(PG8_SB(0, 1), b2 + hstep, voffB); PG8_STAGE(PG8_SA(0, 0), a2, voffA);
            PG8_WAIT_V(8); PG8_WAIT_L(0); PG8_BAR; PG8_MMA(1, 0, At, B0); PG8_MMA(1, 1, At, B1); PG8_BAR; PG8_SCHED;
            PG8_LDB(B0, 1, 0); PG8_LDB(B1, 1, 1); PG8_SCHED; PG8_LDA(At, 1, 0); PG8_STAGE(PG8_SA(0, 1), a2 + hstep, voffA);
            PG8_WAIT_V(8); PG8_WAIT_L(0); PG8_BAR; PG8_MMA(0, 0, At, B0); PG8_MMA(0, 1, At, B1); PG8_BAR; PG8_SCHED;
            PG8_LDA(At, 1, 1); PG8_STAGE(PG8_SB(1, 0), b3, voffB); PG8_STAGE(PG8_SB(1, 1), b3 + hstep, voffB); PG8_STAGE(PG8_SA(1, 0), a3, voffA);
            PG8_WAIT_V(8); PG8_WAIT_L(0); PG8_BAR; PG8_MMA(1, 0, At, B0); PG8_MMA(1, 1, At, B1); PG8_BAR; PG8_SCHED;
            } else {
            PG8_LDB(B0, 0, 0); PG8_SCHED; PG8_LDA(At, 0, 0); PG8_STAGE(PG8_SA(1, 1), a1 + hstep, voffA);
            PG8_WAIT_L(8); PG8_BAR; PG8_WAIT_L(0); PG8_MMA(0, 0, At, B0); PG8_BAR; PG8_SCHED;
            PG8_LDB(B1, 0, 1); PG8_STAGE(PG8_SB(0, 0), b2, voffB);
            PG8_BAR; PG8_WAIT_L(0); PG8_MMA(0, 1, At, B1); PG8_BAR;
            PG8_LDA(At, 0, 1); PG8_STAGE(PG8_SA(0, 0), a2, voffA);
            PG8_BAR; PG8_WAIT_L(0); PG8_MMA(1, 0, At, B0); PG8_BAR; PG8_SCHED;
            PG8_STAGE(PG8_SB(0, 1), b2 + hstep, voffB);
            PG8_WAIT_V(6); PG8_BAR; PG8_MMA(1, 1, At, B1); PG8_BAR;
            PG8_LDB(B0, 1, 0); PG8_SCHED; PG8_LDA(At, 1, 0); PG8_STAGE(PG8_SA(0, 1), a2 + hstep, voffA);
            PG8_WAIT_L(8); PG8_BAR; PG8_WAIT_L(0); PG8_MMA(0, 0, At, B0); PG8_BAR; PG8_SCHED;
            PG8_LDB(B1, 1, 1); PG8_STAGE(PG8_SB(1, 0), b3, voffB);
            PG8_BAR; PG8_WAIT_L(0); PG8_MMA(0, 1, At, B1); PG8_BAR;
            PG8_LDA(At, 1, 1); PG8_STAGE(PG8_SA(1, 0), a3, voffA);
            PG8_BAR; PG8_WAIT_L(0); PG8_MMA(1, 0, At, B0); PG8_BAR; PG8_SCHED;
            PG8_STAGE(PG8_SB(1, 1), b3 + hstep, voffB);
            PG8_WAIT_V(6); PG8_BAR; PG8_MMA(1, 1, At, B1); PG8_BAR;
            }
        }
        if constexpr (ALIGN_EPI) { if (wr == 0) PG8_BAR; }
        if constexpr (!Epi::AFTER_DRAIN) { E(acc, cur, wr, wc, fr, fq);
#if EPI_REP
            if constexpr (Epi::IDEMP) { __builtin_amdgcn_sched_barrier(0); E(acc, cur, wr, wc, fr, fq); }
#endif
            S.done(cur); }
        if (!has_next) break;
#pragma unroll
        for (int a = 0; a < 2; ++a)
#pragma unroll
            for (int b = 0; b < 2; ++b)
#pragma unroll
                for (int m = 0; m < 4; ++m)
#pragma unroll
                    for (int n = 0; n < 2; ++n) acc[a][b][m][n] = (f32x4){0.f, 0.f, 0.f, 0.f};
        cur = nxt; cA = nA; cB = nB; ++ui;
        if constexpr (ALIGN_EPI) { if (wr == 1) PG8_BAR; }
    }
    PG8_WAIT_V(0);
    if constexpr (!ALIGN_EPI) { if (wr == 0) PG8_BAR; }
    PG8_BAR;
    if constexpr (Epi::AFTER_DRAIN) { E.fused(acc, cur, wr, wc, fr, fq, lds, wid, lane); S.done(cur); }
#undef PG8_SA
#undef PG8_SB
#undef PG8_STAGE
#undef PG8_LDA
#undef PG8_LDB
#undef PG8_MMA
#undef PG8_WAIT_V
#undef PG8_WAIT_L
#undef PG8_BAR
#undef PG8_SCHED
}
}

#define LAS __attribute__((address_space(3)))
typedef unsigned short bf16;
typedef unsigned v4u __attribute__((ext_vector_type(4)));
typedef unsigned v2u __attribute__((ext_vector_type(2)));
typedef float f32x4 __attribute__((ext_vector_type(4)));
constexpr int BATCH = 8, SEQ = 2048, T = BATCH * SEQ, D = 1024, DEPTH = 4;
constexpr int INW = 2694, NIN = 2816, FF = 2816, NGU = 5632;
constexpr int UQ = 0, UK = 384, UV = 768, UZ = 1152, UXS = 1536, UP = 2432;
constexpr int XBC = 896;
constexpr float EPS = 1e-6f;
constexpr size_t MiB = 1u << 20;
constexpr size_t WS_CTL = 0;
constexpr size_t WS_WIN = 1 * MiB, WS_WOUT = 23 * MiB, WS_WGU = 31 * MiB, WS_WD = 75 * MiB;
constexpr size_t WS_DTW = 97 * MiB, WS_PWT = WS_DTW + 128 * 1024, WS_KM = WS_DTW + 256 * 1024, WS_CD = WS_DTW + 512 * 1024;
constexpr size_t WS_DT = 98 * MiB, WS_H = 99 * MiB, WS_U = 131 * MiB, WS_ST = 219 * MiB, WS_PREV = 243 * MiB, WS_RS = 255 * MiB, WS_XB = 266 * MiB, WS_END = 298 * MiB;
constexpr int LDS_BYTES = 147456;
#ifndef NAIVE_ATTN
#define NAIVE_ATTN 0
#endif
#ifndef NAIVE_SSD
#define NAIVE_SSD 0
#endif
#ifndef NAIVE_POOL
#define NAIVE_POOL 0
#endif
#ifndef DUP_S
#define DUP_S 0
#endif
#ifndef SYNC_REP
#define SYNC_REP 1
#endif
#ifndef DUP_MIX
#define DUP_MIX 0
#endif
constexpr int NPH = 7;
constexpr int N_PHASES = 2 + DEPTH * NPH;

__device__ __forceinline__ float bf2f(unsigned short u) { return __builtin_bit_cast(float, (unsigned)u << 16); }
__device__ __forceinline__ unsigned f2bf(float f) { unsigned u = __builtin_bit_cast(unsigned, f); return (u + 0x7fffu + ((u >> 16) & 1u)) >> 16; }
__device__ __forceinline__ unsigned pk2(float lo, float hi) { return f2bf(lo) | (f2bf(hi) << 16); }
#define SWZ_XOR(v, m) __builtin_bit_cast(float, __builtin_amdgcn_ds_swizzle(__builtin_bit_cast(int, (v)), ((m) << 10) | 0x1f))
__device__ __forceinline__ float half_sum(float v) { v += SWZ_XOR(v, 1); v += SWZ_XOR(v, 2); v += SWZ_XOR(v, 4); v += SWZ_XOR(v, 8); v += SWZ_XOR(v, 16); return v; }
__device__ __forceinline__ float wave_sum(float v) {
    v = half_sum(v);
    return __builtin_bit_cast(float, __builtin_amdgcn_readlane(__builtin_bit_cast(int, v), 0)) + __builtin_bit_cast(float, __builtin_amdgcn_readlane(__builtin_bit_cast(int, v), 32));
}
__device__ __forceinline__ float wave_max(float v) {
    v = fmaxf(v, SWZ_XOR(v, 1)); v = fmaxf(v, SWZ_XOR(v, 2)); v = fmaxf(v, SWZ_XOR(v, 4)); v = fmaxf(v, SWZ_XOR(v, 8)); v = fmaxf(v, SWZ_XOR(v, 16));
    return fmaxf(__builtin_bit_cast(float, __builtin_amdgcn_readlane(__builtin_bit_cast(int, v), 0)), __builtin_bit_cast(float, __builtin_amdgcn_readlane(__builtin_bit_cast(int, v), 32)));
}
__device__ __forceinline__ float silu(float g) { return g / (1.f + __expf(-g)); }

struct Params { const float* in[16]; float* out; unsigned char* ws; int ph_lo, ph_hi; };
enum { I_X = 0, I_NMIX, I_WIN, I_CONVW, I_CONVB, I_DTB, I_ALOG, I_DSKIP, I_SSDN, I_POOLW, I_POOLS, I_WOUT, I_NFFN, I_WGU, I_WD, I_NFIN };

typedef float f32x2v __attribute__((ext_vector_type(2)));
__device__ __forceinline__ void transpose_item(const float* W, int srcN, int c0, int ncols, const float* gk, int k0, bf16* WT, int dstK, int n0, LAS float* scr, int lane) {
    const int cq = lane & 31, kr = lane >> 5;
    if (c0 >= 0) {
        const float* src = W + (size_t)(k0 + kr) * srcN + c0 + 2 * cq;
#pragma unroll
        for (int i = 0; i < 32; ++i) { f32x2v v = {0.f, 0.f};
            if (2 * cq < ncols) v = *(const f32x2v*)(src + (size_t)(2 * i) * srcN);
            scr[(2 * i + kr) * 65 + 2 * cq] = v.x; scr[(2 * i + kr) * 65 + 2 * cq + 1] = v.y; }
    }
    asm volatile("s_waitcnt lgkmcnt(0)" ::: "memory");
    const int c = lane & 7;
    f32x4 g0 = {1.f, 1.f, 1.f, 1.f}, g1 = g0;
    if (gk) { g0 = *(const f32x4*)(gk + k0 + 8 * c); g1 = *(const f32x4*)(gk + k0 + 8 * c + 4); }
#pragma unroll
    for (int j = 0; j < 8; ++j) { const int n = (lane >> 3) + 8 * j; const LAS float* s = scr + (8 * c) * 65 + n;
        v4u o = {0u, 0u, 0u, 0u};
        if (c0 >= 0) { o.x = pk2(s[0 * 65] * g0.x, s[1 * 65] * g0.y); o.y = pk2(s[2 * 65] * g0.z, s[3 * 65] * g0.w); o.z = pk2(s[4 * 65] * g1.x, s[5 * 65] * g1.y); o.w = pk2(s[6 * 65] * g1.z, s[7 * 65] * g1.w); }
        *(v4u*)(WT + (size_t)(n0 + n) * dstK + k0 + 8 * c) = o; }
    asm volatile("s_waitcnt lgkmcnt(0)" ::: "memory");
}
__device__ __forceinline__ void convert_item(const Params& P, int l, int r, LAS float* scr, int lane) {
    if (r < 704) { const int nb = r >> 4, kb = r & 15, n0 = nb * 64; const int c0 = nb < 38 ? n0 : (nb < 42 ? n0 + 6 : (nb == 42 ? 2432 : -1));
        transpose_item(P.in[I_WIN] + (size_t)l * D * INW, INW, c0, nb == 42 ? 6 : 64, P.in[I_NMIX] + l * D, kb * 64, (bf16*)(P.ws + WS_WIN) + (size_t)l * NIN * D, D, n0, scr, lane); }
    else if (r < 960) { r -= 704; const int nb = r >> 4, kb = r & 15;
        transpose_item(P.in[I_WOUT] + (size_t)l * D * D, D, nb * 64, 64, nullptr, kb * 64, (bf16*)(P.ws + WS_WOUT) + (size_t)l * D * D, D, nb * 64, scr, lane); }
    else if (r < 2368) { r -= 960; const int nb = r >> 4, kb = r & 15, n0 = nb * 64, pn = n0 >> 8, rr = n0 & 255; const int c0 = rr < 128 ? 128 * pn + rr : FF + 128 * pn + (rr - 128);
        transpose_item(P.in[I_WGU] + (size_t)l * D * NGU, NGU, c0, 64, P.in[I_NFFN] + l * D, kb * 64, (bf16*)(P.ws + WS_WGU) + (size_t)l * NGU * D, D, n0, scr, lane); }
    else { r -= 2368; const int nb = r / 44, kb = r % 44;
        transpose_item(P.in[I_WD] + (size_t)l * FF * D, D, nb * 64, 64, nullptr, kb * 64, (bf16*)(P.ws + WS_WD) + (size_t)l * D * FF, FF, nb * 64, scr, lane); }
}
__device__ __forceinline__ void convert_in_slack(const Params& P, LAS unsigned char* lds, int l, int it0, int it1, int nwg, int bid, int G, int wid, int lane) {
    const int first_light = nwg % G, n_parts = first_light ? G - first_light : G, part = first_light ? bid - first_light : bid;
    if (part < 0) return;
    LAS float* scr = (LAS float*)lds + wid * (64 * 65);
    for (int it = it0 + part * 8 + wid; it < it1; it += n_parts * 8) convert_item(P, l, it, scr, lane);
}
__device__ __forceinline__ void phase_prologue(const Params& P, LAS unsigned char* lds, int bid, int G, int tid, int wid, int lane) {
    LAS float* scr = (LAS float*)lds + wid * (64 * 65);
    const int gw = bid * 8 + wid, nw = G * 8;
    for (int it = gw; it < 3072; it += nw) convert_item(P, 0, it, scr, lane);
    const int gt = bid * 512 + tid, nt = G * 512;
    { bf16* XB = (bf16*)(P.ws + WS_XB); float* RS = (float*)(P.ws + WS_RS);
      for (int row = bid * 8 + wid; row < T; row += G * 8) {
          const float* xr = P.in[I_X] + (size_t)row * D + 4 * lane; float s = 0.f;
          v2u* o8 = (v2u*)(XB + (size_t)row * D + 4 * lane);
#pragma unroll
          for (int j = 0; j < 4; ++j) { const f32x4 v = *(const f32x4*)(xr + 256 * j); s += (v.x * v.x + v.y * v.y) + (v.z * v.z + v.w * v.w); v2u o; o.x = pk2(v.x, v.y); o.y = pk2(v.z, v.w); o8[64 * j] = o; }
          s = wave_sum(s);
          if (lane < 16) RS[(size_t)row * 16 + lane] = lane == 0 ? s : 0.f;
      } }
    bf16* pwt = (bf16*)(P.ws + WS_PWT);
    for (int i = gt; i < DEPTH * 4 * 64 * 64; i += nt) { const int lg = i >> 12, d = (i >> 6) & 63, c = i & 63; pwt[i] = (bf16)f2bf(P.in[I_POOLW][(lg * 64 + c) * 64 + d]); }
}

__device__ __forceinline__ void phase_norm(const Params& P, int l, int mode, int bid, int G, int wid, int lane) {
    const bf16* XB = (const bf16*)(P.ws + WS_XB); const float* g = P.in[I_NFIN];
    f32x4 gv[4];
#pragma unroll
    for (int j = 0; j < 4; ++j) gv[j] = *(const f32x4*)(g + 4 * lane + 256 * j);
    for (int row = bid * 8 + wid; row < T; row += G * 8) {
        const v2u* xr = (const v2u*)(XB + (size_t)row * D + 4 * lane);
        f32x4 v[4]; float s = 0.f;
#pragma unroll
        for (int j = 0; j < 4; ++j) { const v2u q = xr[64 * j]; v[j] = (f32x4){bf2f(q.x & 0xffff), bf2f(q.x >> 16), bf2f(q.y & 0xffff), bf2f(q.y >> 16)}; s += (v[j].x * v[j].x + v[j].y * v[j].y) + (v[j].z * v[j].z + v[j].w * v[j].w); }
        const float rstd = rsqrtf(wave_sum(s) * (1.f / D) + EPS);
#pragma unroll
        for (int j = 0; j < 4; ++j) *(f32x4*)(P.out + (size_t)row * D + 4 * lane + 256 * j) = (v[j] * rstd) * gv[j];
    }
}
typedef float f32x16 __attribute__((ext_vector_type(16)));
typedef short s16x8 __attribute__((ext_vector_type(8)));
typedef short s16x4 __attribute__((ext_vector_type(4)));
typedef short v4i16_t __attribute__((ext_vector_type(4)));
#define MFMA32(a, b, c) __builtin_amdgcn_mfma_f32_32x32x16_bf16((a), (b), (c), 0, 0, 0)
__device__ __forceinline__ s16x4 lds_tr(LAS const unsigned char* p) { return __builtin_bit_cast(s16x4, __builtin_amdgcn_ds_read_tr16_b64_v4i16((LAS v4i16_t*)p)); }
__device__ __forceinline__ float xhalf_sum(float v) { float a = v, b = v; asm volatile("s_nop 1\n\tv_permlane32_swap_b32 %0, %1" : "+v"(a), "+v"(b)); return a + b; }
__device__ __forceinline__ float xhalf_max(float v) { float a = v, b = v; asm volatile("s_nop 1\n\tv_permlane32_swap_b32 %0, %1" : "+v"(a), "+v"(b)); return fmaxf(a, b); }
typedef float f32x2_t __attribute__((ext_vector_type(2)));
typedef __bf16 bf16x2_t __attribute__((ext_vector_type(2)));
__device__ __forceinline__ unsigned cvtpk(float lo, float hi) { const f32x2_t v = {lo, hi}; const bf16x2_t b = __builtin_convertvector(v, bf16x2_t); return __builtin_bit_cast(unsigned, b); }
constexpr int AT_KS = 144;
constexpr int AT_BLK = 256 * AT_KS;
constexpr int AT_K0 = 0, AT_V0 = AT_BLK, AT_KM = 2 * AT_BLK, AT_PART = AT_KM + 8 * 64 * 4;
__device__ __forceinline__ void attn_unit(const Params& P, int b, int h, int blk, LAS unsigned char* lds, int tid, int wid, int lane) {
    const bf16* U = (const bf16*)(P.ws + WS_U); bf16* MIX = (bf16*)(P.ws + WS_H);
    const int r = lane & 31, hh = lane >> 5;
    const size_t row0 = (size_t)b * SEQ;
    LAS float* KM = (LAS float*)(lds + AT_KM);
    const int ldrow = tid >> 3, ldch = tid & 7;
    const bf16* kvbase = U + (row0 + ldrow) * NIN + UK + h * 64 + ldch * 8;
    const int ldoff = ldrow * AT_KS + ldch * 16;
    auto blk_key0 = [&](int i) { return i == 0 ? blk * 256 : (i - 1) * 256; };
    v4u kreg[4], vreg[4];
#define AT_LOAD(i) do { const bf16* p_ = kvbase + (size_t)blk_key0(i) * NIN; _Pragma("unroll") for (int j_ = 0; j_ < 4; ++j_) { kreg[j_] = *(const v4u*)(p_ + (size_t)(64 * j_) * NIN); vreg[j_] = *(const v4u*)(p_ + (size_t)(64 * j_) * NIN + 384); } } while (0)
#define AT_STORE() do { _Pragma("unroll") for (int j_ = 0; j_ < 4; ++j_) { *(LAS v4u*)(lds + AT_K0 + 64 * j_ * AT_KS + ldoff) = kreg[j_]; *(LAS v4u*)(lds + AT_V0 + 64 * j_ * AT_KS + ldoff) = vreg[j_]; } } while (0)
    AT_LOAD(0);
    __syncthreads();
    if (blk >= 4) {
        LAS float* part = (LAS float*)(lds + AT_PART);
        const int c8 = tid & 7, rg = tid >> 3;
        const bf16* kb = U + (row0 + rg * 4) * NIN + UK + h * 64 + c8 * 8;
#pragma unroll
        for (int ps = 0; ps < 2; ++ps) {
            v4u kq[4][4];
#pragma unroll
            for (int jj = 0; jj < 4; ++jj) { const int j = 4 * ps + jj;
#pragma unroll
                for (int i = 0; i < 4; ++i) { kq[jj][i] = (v4u){0u, 0u, 0u, 0u}; if (j < blk) kq[jj][i] = *(const v4u*)(kb + (size_t)(j * 256 + i) * NIN); } }
#pragma unroll
            for (int jj = 0; jj < 4; ++jj) { const int j = 4 * ps + jj;
                if (j < 7) {
                    float sm[8];
#pragma unroll
                    for (int e = 0; e < 8; ++e) sm[e] = 0.f;
#pragma unroll
                    for (int i = 0; i < 4; ++i) { const v4u q = kq[jj][i];
                        sm[0] += bf2f(q.x & 0xffff); sm[1] += bf2f(q.x >> 16); sm[2] += bf2f(q.y & 0xffff); sm[3] += bf2f(q.y >> 16);
                        sm[4] += bf2f(q.z & 0xffff); sm[5] += bf2f(q.z >> 16); sm[6] += bf2f(q.w & 0xffff); sm[7] += bf2f(q.w >> 16); }
#pragma unroll
                    for (int e = 0; e < 8; ++e) {
                        float v = sm[e];
                        v += SWZ_XOR(v, 8); v += SWZ_XOR(v, 16); v = xhalf_sum(v);
                        sm[e] = v; }
                    if (lane < 8 && j < blk) { *(LAS f32x4*)(part + (j * 8 + wid) * 64 + c8 * 8) = (f32x4){sm[0], sm[1], sm[2], sm[3]}; *(LAS f32x4*)(part + (j * 8 + wid) * 64 + c8 * 8 + 4) = (f32x4){sm[4], sm[5], sm[6], sm[7]}; }
                } }
        }
        __syncthreads();
        if (tid < blk * 64) { const int j = tid >> 6, d = tid & 63; float sacc = 0.f;
#pragma unroll
            for (int k = 0; k < 8; ++k) sacc += part[(j * 8 + k) * 64 + d];
            KM[j * 64 + d] = sacc * (1.f / 256.f); }
    }
    AT_STORE();
    __syncthreads();
    const int qrow = blk * 256 + wid * 32 + r;
    s16x8 qf[4];
    { const v4u* qp = (const v4u*)(U + (row0 + qrow) * NIN + UQ + h * 64 + 8 * hh);
#pragma unroll
      for (int s = 0; s < 4; ++s) qf[s] = __builtin_bit_cast(s16x8, qp[2 * s]); }
    unsigned sel = (1u << blk) - 1u;
    if (blk >= 4) {
        float gate[8];
#pragma unroll
        for (int j = 0; j < 8; ++j) gate[j] = -3e38f;
#pragma unroll
        for (int j = 0; j < 7; ++j) if (j < blk) { float g = 0.f;
#pragma unroll
            for (int s = 0; s < 4; ++s) {
                const f32x4 k0 = *(LAS const f32x4*)(KM + j * 64 + 16 * s + 8 * hh), k1 = *(LAS const f32x4*)(KM + j * 64 + 16 * s + 8 * hh + 4);
                g += bf2f((unsigned short)qf[s][0]) * k0.x + bf2f((unsigned short)qf[s][1]) * k0.y + bf2f((unsigned short)qf[s][2]) * k0.z + bf2f((unsigned short)qf[s][3]) * k0.w
                   + bf2f((unsigned short)qf[s][4]) * k1.x + bf2f((unsigned short)qf[s][5]) * k1.y + bf2f((unsigned short)qf[s][6]) * k1.z + bf2f((unsigned short)qf[s][7]) * k1.w; }
            gate[j] = xhalf_sum(g); }
        sel = 0u;
#pragma unroll
        for (int t = 0; t < 3; ++t) { int best = 0; float bv = -3.4e38f;
#pragma unroll
            for (int j = 0; j < 8; ++j) { const bool ok = !((sel >> j) & 1u) && gate[j] > bv; bv = ok ? gate[j] : bv; best = ok ? j : best; }
            sel |= 1u << best; }
    }
    f32x16 o0, o1;
#pragma unroll
    for (int i = 0; i < 16; ++i) { o0[i] = 0.f; o1[i] = 0.f; }
    float m = -1e30f, lsum = 0.f;
    const float SC = 0.125f * 1.44269504088896f;
    const int i16 = lane & 15, b16 = (lane >> 4) & 1;
    const int troff = (i16 >> 2) * AT_KS + (16 * b16) * 2 + 8 * (i16 & 3);
    const int qpos = 32 * wid + r;
    for (int bi = 0; bi <= blk; ++bi) {
        if (bi < blk) AT_LOAD(bi + 1);
        const int jpast = bi - 1;
        const bool lane_on = (bi == 0) || ((sel >> jpast) & 1u);
        const bool need_blk = (bi == 0) || (__builtin_amdgcn_ballot_w64(lane_on) != 0ull);
        if (need_blk) {
            const int nt = bi == 0 ? ((32 * wid + 31) >> 6) + 1 : 4;
#define AT_QK(dA, dB, ktile) do { LAS const unsigned char* Kt_ = lds + AT_K0 + (ktile) * 64 * AT_KS; \
                _Pragma("unroll") for (int e_ = 0; e_ < 16; ++e_) { dA[e_] = 0.f; dB[e_] = 0.f; } \
                _Pragma("unroll") for (int s_ = 0; s_ < 4; ++s_) { \
                    const s16x8 ka_ = *(LAS const s16x8*)(Kt_ + r * AT_KS + 32 * s_ + 16 * hh); \
                    const s16x8 kb_ = *(LAS const s16x8*)(Kt_ + (32 + r) * AT_KS + 32 * s_ + 16 * hh); \
                    dA = MFMA32(ka_, qf[s_], dA); dB = MFMA32(kb_, qf[s_], dB); } } while (0)
            f32x16 sA, sB, nA, nB;
            AT_QK(sA, sB, 0);
            for (int kt = 0; kt < nt; ++kt) {
                LAS const unsigned char* Vt = lds + AT_V0 + kt * 64 * AT_KS;
                if (kt + 1 < nt) AT_QK(nA, nB, kt + 1);
                if (bi == 0 && kt == nt - 1) {
#pragma unroll
                    for (int e = 0; e < 16; ++e) { const int kr = (e & 3) + 8 * (e >> 2) + 4 * hh;
                        if (64 * kt + kr > qpos) sA[e] = -3e38f; if (64 * kt + 32 + kr > qpos) sB[e] = -3e38f; }
                }
                float mx = fmaxf(sA[0], sB[0]);
#pragma unroll
                for (int e = 1; e < 16; ++e) mx = fmaxf(mx, fmaxf(sA[e], sB[e]));
                mx = lane_on ? mx * SC : -1e30f;
                mx = xhalf_max(mx);
                const float mn = fmaxf(m, mx);
                const float nb = lane_on ? -mn : -3e38f;
                if (__builtin_amdgcn_ballot_w64(mn > m) != 0ull) {
                    const float alpha = __builtin_amdgcn_exp2f(m - mn);
                    lsum *= alpha;
#pragma unroll
                    for (int e = 0; e < 16; ++e) { o0[e] *= alpha; o1[e] *= alpha; }
                    m = mn;
                }
                float ps = 0.f;
#pragma unroll
                for (int e = 0; e < 16; ++e) { sA[e] = __builtin_amdgcn_exp2f(__builtin_fmaf(sA[e], SC, nb)); sB[e] = __builtin_amdgcn_exp2f(__builtin_fmaf(sB[e], SC, nb)); ps += sA[e] + sB[e]; }
                lsum += ps;
#pragma unroll
                for (int sub = 0; sub < 2; ++sub)
#pragma unroll
                    for (int s2 = 0; s2 < 2; ++s2) {
                        s16x8 pb;
#pragma unroll
                        for (int jj = 0; jj < 8; jj += 2) { const float x0 = sub ? sB[8 * s2 + jj] : sA[8 * s2 + jj], x1 = sub ? sB[8 * s2 + jj + 1] : sA[8 * s2 + jj + 1];
                            const unsigned w = cvtpk(x0, x1); pb[jj] = (short)(w & 0xffff); pb[jj + 1] = (short)(w >> 16); }
                        const int klo = 32 * sub + 16 * s2 + 4 * hh;
#pragma unroll
                        for (int db = 0; db < 2; ++db) {
                            const s16x4 lo = lds_tr(Vt + klo * AT_KS + troff + 64 * db), hi = lds_tr(Vt + (klo + 8) * AT_KS + troff + 64 * db);
                            const s16x8 va = __builtin_shufflevector(lo, hi, 0, 1, 2, 3, 4, 5, 6, 7);
                            if (db == 0) o0 = MFMA32(va, pb, o0); else o1 = MFMA32(va, pb, o1);
                        }
                    }
                sA = nA; sB = nB;
            }
#undef AT_QK
        }
        if (bi < blk) { __syncthreads(); AT_STORE(); __syncthreads(); }
    }
#undef AT_LOAD
#undef AT_STORE
    const float inv = 1.f / xhalf_sum(lsum);
    bf16* orow = MIX + (row0 + qrow) * D + h * 64 + 4 * hh;
#pragma unroll
    for (int g = 0; g < 4; ++g) {
        v2u w0, w1;
        w0.x = pk2(o0[4 * g] * inv, o0[4 * g + 1] * inv); w0.y = pk2(o0[4 * g + 2] * inv, o0[4 * g + 3] * inv);
        w1.x = pk2(o1[4 * g] * inv, o1[4 * g + 1] * inv); w1.y = pk2(o1[4 * g + 2] * inv, o1[4 * g + 3] * inv);
        *(v2u*)(orow + 8 * g) = w0; *(v2u*)(orow + 32 + 8 * g) = w1;
    }
}
constexpr int SX_S = 400, SB_S = 272;
constexpr int S_X = 0, S_B = 51200, S_C = 86016, S_PREV = 120832, S_DT = 138240, S_AC = S_DT + 1536, S_DA = S_AC + 1536;
__device__ __forceinline__ int crow16(int i, int hh) { return (i & 3) + 8 * (i >> 2) + 4 * hh; }
template <bool PHASE_A>
__device__ __forceinline__ void ssd_stage(const Params& P, int l, int b, int c, int g, LAS unsigned char* lds, int tid) {
    const bf16* U = (const bf16*)(P.ws + WS_U); const float* DT = (const float*)(P.ws + WS_DT);
    const float* alog = P.in[I_ALOG]; const float* convw = P.in[I_CONVW]; const float* convb = P.in[I_CONVB];
    asm volatile("" : "+s"(alog), "+s"(convw), "+s"(convb));
    const size_t row0 = (size_t)b * SEQ + c * 128;
    LAS float* dts = (LAS float*)(lds + S_DT); LAS float* acs = (LAS float*)(lds + S_AC); LAS float* das = (LAS float*)(lds + S_DA);
    const int cc = tid & 63, tg = tid >> 6;
    const bool conv_on = cc < (PHASE_A ? 40 : 56);
    const int ch = cc < 24 ? g * 192 + cc * 8 : (cc < 40 ? 384 + g * 128 + (cc - 24) * 8 : 640 + g * 128 + (cc - 40) * 8);
    v4u rows[19];
    if (conv_on) {
        const bf16* src = U + (row0 + tg * 16) * NIN + UXS + ch;
        const bool has_prev = !(c == 0 && tg == 0);
#pragma unroll
        for (int k = 0; k < 3; ++k) { rows[k] = (v4u){0u, 0u, 0u, 0u}; if (has_prev) rows[k] = *(const v4u*)(src - (size_t)(3 - k) * NIN); }
#pragma unroll
        for (int t = 0; t < 16; ++t) rows[3 + t] = *(const v4u*)(src + (size_t)t * NIN);
    }
    if (tid < 384) { const int hh3 = tid >> 7, li = tid & 127, h = 3 * g + hh3; const float dt = DT[(row0 + li) * 8 + h]; dts[tid] = dt; das[tid] = dt * -__expf(alog[l * 6 + h]); }
    __syncthreads();
    if (tid < 384) {
        const int hh3 = tid >> 7, li = tid & 127; float s = 0.f;
#pragma unroll
        for (int q = 0; q < 32; ++q) { const f32x4 v = *(LAS const f32x4*)(das + hh3 * 128 + 4 * q);
            s += (4 * q <= li ? v.x : 0.f); s += (4 * q + 1 <= li ? v.y : 0.f); s += (4 * q + 2 <= li ? v.z : 0.f); s += (4 * q + 3 <= li ? v.w : 0.f); }
        acs[tid] = s; }
    __syncthreads();
    if (conv_on) {
        const float* cw = convw + (size_t)l * 4 * XBC + ch; const float* cb = convb + (size_t)l * XBC + ch;
        float w[4][8], bias[8];
#pragma unroll
        for (int k = 0; k < 4; ++k) { const f32x4 a = *(const f32x4*)(cw + k * XBC), d = *(const f32x4*)(cw + k * XBC + 4);
            w[k][0] = a.x; w[k][1] = a.y; w[k][2] = a.z; w[k][3] = a.w; w[k][4] = d.x; w[k][5] = d.y; w[k][6] = d.z; w[k][7] = d.w; }
        { const f32x4 a = *(const f32x4*)cb, d = *(const f32x4*)(cb + 4); bias[0] = a.x; bias[1] = a.y; bias[2] = a.z; bias[3] = a.w; bias[4] = d.x; bias[5] = d.y; bias[6] = d.z; bias[7] = d.w; }
        const int hh3 = cc >> 3;
        const float ac_end = acs[(cc < 24 ? hh3 : 0) * 128 + 127];
        LAS unsigned char* dst = lds + (cc < 24 ? S_X + cc * 16 : (cc < 40 ? S_B + (cc - 24) * 16 : S_C + (cc - 40) * 16));
        const int dstride = cc < 24 ? SX_S : SB_S;
#define UNPK(q, j) ((j) == 0 ? bf2f((q).x & 0xffff) : (j) == 1 ? bf2f((q).x >> 16) : (j) == 2 ? bf2f((q).y & 0xffff) : (j) == 3 ? bf2f((q).y >> 16) : (j) == 4 ? bf2f((q).z & 0xffff) : (j) == 5 ? bf2f((q).z >> 16) : (j) == 6 ? bf2f((q).w & 0xffff) : bf2f((q).w >> 16))
#pragma unroll
        for (int t = 0; t < 16; ++t) {
            const int tok = tg * 16 + t;
            float sc = 1.f;
            if (PHASE_A && cc < 24) sc = dts[hh3 * 128 + tok] * __expf(ac_end - acs[hh3 * 128 + tok]);
            float o[8];
#pragma unroll
            for (int j = 0; j < 8; ++j) { const float a = bias[j] + w[0][j] * UNPK(rows[t], j) + w[1][j] * UNPK(rows[t + 1], j) + w[2][j] * UNPK(rows[t + 2], j) + w[3][j] * UNPK(rows[t + 3], j); o[j] = silu(a) * sc; }
            v4u pk; pk.x = pk2(o[0], o[1]); pk.y = pk2(o[2], o[3]); pk.z = pk2(o[4], o[5]); pk.w = pk2(o[6], o[7]);
            *(LAS v4u*)(dst + tok * dstride) = pk;
        }
#undef UNPK
    }
    __syncthreads();
}
__device__ __forceinline__ void ssd_unit_a(const Params& P, int l, int b, int c, int g, LAS unsigned char* lds, int tid, int wid, int lane) {
    __syncthreads();
    ssd_stage<true>(P, l, b, c, g, lds, tid);
    LAS float* acs = (LAS float*)(lds + S_AC);
    if (tid < 3) ((float*)(P.ws + WS_CD))[(b * 16 + c) * 6 + 3 * g + tid] = __expf(acs[tid * 128 + 127]);
    const int r = lane & 31, hh = lane >> 5, nt = wid & 3, pt = wid >> 2, i16 = lane & 15, b16 = (lane >> 4) & 1;
    const int troffB = (i16 >> 2) * SB_S + (32 * nt + 16 * b16) * 2 + 8 * (i16 & 3);
    s16x8 bfr[8];
#pragma unroll
    for (int s = 0; s < 8; ++s) { const int k0 = 16 * s + 8 * hh;
        const s16x4 lo = lds_tr(lds + S_B + k0 * SB_S + troffB), hi = lds_tr(lds + S_B + (k0 + 4) * SB_S + troffB);
        bfr[s] = __builtin_shufflevector(lo, hi, 0, 1, 2, 3, 4, 5, 6, 7); }
    float* ST = (float*)(P.ws + WS_ST);
#pragma unroll
    for (int hh3 = 0; hh3 < 3; ++hh3) {
        const int troffX = (i16 >> 2) * SX_S + (hh3 * 64 + 32 * pt + 16 * b16) * 2 + 8 * (i16 & 3);
        f32x16 acc;
#pragma unroll
        for (int e = 0; e < 16; ++e) acc[e] = 0.f;
#pragma unroll
        for (int s = 0; s < 8; ++s) { const int k0 = 16 * s + 8 * hh;
            const s16x4 lo = lds_tr(lds + S_X + k0 * SX_S + troffX), hi = lds_tr(lds + S_X + (k0 + 4) * SX_S + troffX);
            const s16x8 xa = __builtin_shufflevector(lo, hi, 0, 1, 2, 3, 4, 5, 6, 7);
            acc = MFMA32(xa, bfr[s], acc); }
        float* S = ST + ((size_t)((b * 16 + c) * 6 + 3 * g + hh3)) * 8192;
#pragma unroll
        for (int e = 0; e < 16; ++e) S[(32 * pt + crow16(e, hh)) * 128 + 32 * nt + r] = acc[e];
    }
}
__device__ __forceinline__ void ssd_scan(const Params& P, int bid, int G, int tid) {
    const float* ST = (const float*)(P.ws + WS_ST); const float* CD = (const float*)(P.ws + WS_CD); bf16* PV = (bf16*)(P.ws + WS_PREV);
    for (int it = bid * 512 + tid; it < BATCH * 6 * 2048; it += G * 512) {
        const int bh = it >> 11, e4 = (it & 2047) * 4, b = bh / 6, h = bh % 6;
        f32x4 sv[15]; float dv[15];
#pragma unroll
        for (int c = 0; c < 15; ++c) { sv[c] = *(const f32x4*)(ST + ((size_t)((b * 16 + c) * 6 + h)) * 8192 + e4); dv[c] = CD[(b * 16 + c) * 6 + h]; }
        f32x4 acc = {0.f, 0.f, 0.f, 0.f};
#pragma unroll
        for (int c = 0; c < 16; ++c) {
            v2u w; w.x = pk2(acc.x, acc.y); w.y = pk2(acc.z, acc.w);
            *(v2u*)(PV + ((size_t)((b * 16 + c) * 6 + h)) * 8192 + e4) = w;
            if (c < 15) acc = acc * dv[c] + sv[c];
        }
    }
}
__device__ __forceinline__ void ssd_unit_b(const Params& P, int l, int b, int c, int g, LAS unsigned char* lds, int tid, int wid, int lane) {
    const float* dskip = P.in[I_DSKIP]; const float* ssdn = P.in[I_SSDN];
    asm volatile("" : "+s"(dskip), "+s"(ssdn));
    v4u pq[3][2];
    { const bf16* PV0 = (const bf16*)(P.ws + WS_PREV);
#pragma unroll
      for (int hh3 = 0; hh3 < 3; ++hh3) { const v4u* src = (const v4u*)(PV0 + ((size_t)((b * 16 + c) * 6 + 3 * g + hh3)) * 8192) + tid; pq[hh3][0] = src[0]; pq[hh3][1] = src[512]; } }
    __syncthreads();
    ssd_stage<false>(P, l, b, c, g, lds, tid);
    const bf16* U = (const bf16*)(P.ws + WS_U); bf16* MIX = (bf16*)(P.ws + WS_H);
    LAS float* dts = (LAS float*)(lds + S_DT); LAS float* acs = (LAS float*)(lds + S_AC); LAS float* ssb = (LAS float*)(lds + S_DA);
    const size_t row0 = (size_t)b * SEQ + c * 128;
    const int r = lane & 31, hh = lane >> 5, lt = wid & 3, pb = wid >> 2, i16 = lane & 15, b16 = (lane >> 4) & 1;
#define CF(s) (*(LAS const s16x8*)(lds + S_C + (32 * lt + r) * SB_S + (16 * (s) + 8 * hh) * 2))
    f32x16 Y[3];
#pragma unroll
    for (int hh3 = 0; hh3 < 3; ++hh3) {
        const int h = 3 * g + hh3;
        __syncthreads();
        *(LAS v4u*)(lds + S_PREV + (tid >> 4) * SB_S + (tid & 15) * 16) = pq[hh3][0]; *(LAS v4u*)(lds + S_PREV + (32 + (tid >> 4)) * SB_S + (tid & 15) * 16) = pq[hh3][1];
        __syncthreads();
        f32x16 acc;
#pragma unroll
        for (int e = 0; e < 16; ++e) acc[e] = 0.f;
#pragma unroll
        for (int s = 0; s < 8; ++s) { const s16x8 a = *(LAS const s16x8*)(lds + S_PREV + (32 * pb + r) * SB_S + (16 * s + 8 * hh) * 2); acc = MFMA32(a, CF(s), acc); }
        const float el = __expf(acs[hh3 * 128 + 32 * lt + r]);
#pragma unroll
        for (int e = 0; e < 16; ++e) Y[hh3][e] = acc[e] * el;
    }
    for (int st = 0; st <= lt; ++st) {
        f32x16 Gt;
#pragma unroll
        for (int e = 0; e < 16; ++e) Gt[e] = 0.f;
#pragma unroll
        for (int s = 0; s < 8; ++s) { const s16x8 a = *(LAS const s16x8*)(lds + S_B + (32 * st + r) * SB_S + (16 * s + 8 * hh) * 2); Gt = MFMA32(a, CF(s), Gt); }
#pragma unroll
        for (int hh3 = 0; hh3 < 3; ++hh3) {
            const float acl = acs[hh3 * 128 + 32 * lt + r];
            const int troffX = (i16 >> 2) * SX_S + (hh3 * 64 + 32 * pb + 16 * b16) * 2 + 8 * (i16 & 3);
#pragma unroll
            for (int s2 = 0; s2 < 2; ++s2) {
                s16x8 pbk;
#pragma unroll
                for (int jj = 0; jj < 8; jj += 2) {
                    float mv[2];
#pragma unroll
                    for (int t = 0; t < 2; ++t) { const int e = 8 * s2 + jj + t, kr = crow16(e, hh), stok = 32 * st + kr;
                        const bool valid = (st < lt) || (kr <= r);
                        const float v = Gt[e] * __expf(fminf(acl - acs[hh3 * 128 + stok], 0.f)) * dts[hh3 * 128 + stok];
                        mv[t] = valid ? v : 0.f; }
                    const unsigned w = pk2(mv[0], mv[1]); pbk[jj] = (short)(w & 0xffff); pbk[jj + 1] = (short)(w >> 16); }
                const int klo = 32 * st + 16 * s2 + 4 * hh;
                const s16x4 lo = lds_tr(lds + S_X + klo * SX_S + troffX), hi = lds_tr(lds + S_X + (klo + 8) * SX_S + troffX);
                const s16x8 xa = __builtin_shufflevector(lo, hi, 0, 1, 2, 3, 4, 5, 6, 7);
                Y[hh3] = MFMA32(xa, pbk, Y[hh3]);
                __builtin_amdgcn_sched_barrier(0);
            }
        }
    }
    float ssq = 0.f;
    const size_t grow = row0 + 32 * lt + r;
#pragma unroll
    for (int hh3 = 0; hh3 < 3; ++hh3) { const int h = 3 * g + hh3; const float Dk = dskip[l * 6 + h];
#pragma unroll
        for (int q4 = 0; q4 < 4; ++q4) { const int p0 = 32 * pb + 8 * q4 + 4 * hh;
            const v2u xr = *(LAS const v2u*)(lds + S_X + (32 * lt + r) * SX_S + (hh3 * 64 + p0) * 2);
            const v2u zr = *(const v2u*)(U + grow * NIN + UZ + h * 64 + p0);
            const f32x4 xv = {bf2f(xr.x & 0xffff), bf2f(xr.x >> 16), bf2f(xr.y & 0xffff), bf2f(xr.y >> 16)};
            const f32x4 zv = {bf2f(zr.x & 0xffff), bf2f(zr.x >> 16), bf2f(zr.y & 0xffff), bf2f(zr.y >> 16)};
#pragma unroll
            for (int e = 0; e < 4; ++e) { const float y = (Y[hh3][4 * q4 + e] + Dk * xv[e]) * silu(zv[e]); Y[hh3][4 * q4 + e] = y; ssq += y * y; } } }
    ssq = xhalf_sum(ssq);
    if (hh == 0) ssb[pb * 128 + 32 * lt + r] = ssq;
    __syncthreads();
    const float rs = rsqrtf((ssb[32 * lt + r] + ssb[128 + 32 * lt + r]) * (1.f / 192.f) + EPS);
#pragma unroll
    for (int hh3 = 0; hh3 < 3; ++hh3)
#pragma unroll
        for (int q4 = 0; q4 < 4; ++q4) { const int p0 = 32 * pb + 8 * q4 + 4 * hh, chn = g * 192 + hh3 * 64 + p0;
            const f32x4 nw = *(const f32x4*)(ssdn + l * 384 + chn);
            v2u w; w.x = pk2(Y[hh3][4 * q4] * rs * nw.x, Y[hh3][4 * q4 + 1] * rs * nw.y); w.y = pk2(Y[hh3][4 * q4 + 2] * rs * nw.z, Y[hh3][4 * q4 + 3] * rs * nw.w);
            *(v2u*)(MIX + grow * D + 384 + chn) = w; }
}
constexpr int PL_S = 528;
__device__ __forceinline__ void pool_unit(const Params& P, int l, int unit, LAS unsigned char* lds, int tid, int wid, int lane) {
    const bf16* U = (const bf16*)(P.ws + WS_U); bf16* MIX = (bf16*)(P.ws + WS_H);
    const bf16* pwt = (const bf16*)(P.ws + WS_PWT) + (size_t)l * 4 * 4096;
    const float* pscale = P.in[I_POOLS]; asm volatile("" : "+s"(pscale));
    const size_t row0 = (size_t)unit * 64;
    __syncthreads();
    { const int cc = tid & 31, ts = tid >> 5, g = cc >> 3, W = 2 << g;
      const bf16* src = U + row0 * NIN + UP + cc * 8;
      f32x4 s0 = {0.f, 0.f, 0.f, 0.f}, s1 = s0;
      const int t0 = ts * 4, pos0 = (int)((row0 + t0) & (SEQ - 1));
#pragma unroll
      for (int i = 1; i < 16; ++i) if (i < W && i <= pos0) { const v4u q = *(const v4u*)(src + (ptrdiff_t)(t0 - i) * NIN);
          s0.x += bf2f(q.x & 0xffff); s0.y += bf2f(q.x >> 16); s0.z += bf2f(q.y & 0xffff); s0.w += bf2f(q.y >> 16);
          s1.x += bf2f(q.z & 0xffff); s1.y += bf2f(q.z >> 16); s1.z += bf2f(q.w & 0xffff); s1.w += bf2f(q.w >> 16); }
#pragma unroll
      for (int t = 0; t < 4; ++t) {
          const int tok = t0 + t, pos = pos0 + t;
          const v4u q = *(const v4u*)(src + (size_t)tok * NIN);
          const f32x4 x0 = {bf2f(q.x & 0xffff), bf2f(q.x >> 16), bf2f(q.y & 0xffff), bf2f(q.y >> 16)}, x1 = {bf2f(q.z & 0xffff), bf2f(q.z >> 16), bf2f(q.w & 0xffff), bf2f(q.w >> 16)};
          s0 += x0; s1 += x1;
          if (t > 0 && pos - W >= 0) { const v4u o = *(const v4u*)(src + (ptrdiff_t)(tok - W) * NIN);
              const f32x4 y0 = {bf2f(o.x & 0xffff), bf2f(o.x >> 16), bf2f(o.y & 0xffff), bf2f(o.y >> 16)}, y1 = {bf2f(o.z & 0xffff), bf2f(o.z >> 16), bf2f(o.w & 0xffff), bf2f(o.w >> 16)};
              s0 -= y0; s1 -= y1; }
          const float inv = 1.f / (float)(pos + 1 < W ? pos + 1 : W);
          const f32x4 d0 = s0 * inv - x0, d1 = s1 * inv - x1;
          v4u pk; pk.x = pk2(d0.x, d0.y); pk.y = pk2(d0.z, d0.w); pk.z = pk2(d1.x, d1.y); pk.w = pk2(d1.z, d1.w);
          *(LAS v4u*)(lds + tok * PL_S + cc * 16) = pk;
      } }
    __syncthreads();
    const int r = lane & 31, hh = lane >> 5, g = wid >> 1, dt = wid & 1;
    s16x8 wa[4];
#pragma unroll
    for (int s = 0; s < 4; ++s) wa[s] = __builtin_bit_cast(s16x8, *(const v4u*)(pwt + (size_t)g * 4096 + (32 * dt + r) * 64 + 16 * s + 8 * hh));
#pragma unroll
    for (int tt = 0; tt < 2; ++tt) {
        f32x16 acc;
#pragma unroll
        for (int e = 0; e < 16; ++e) acc[e] = 0.f;
#pragma unroll
        for (int s = 0; s < 4; ++s) { const s16x8 bq = *(LAS const s16x8*)(lds + (32 * tt + r) * PL_S + (g * 64 + 16 * s + 8 * hh) * 2); acc = MFMA32(wa[s], bq, acc); }
        bf16* orow = MIX + (row0 + 32 * tt + r) * D + 768 + g * 64 + 32 * dt + 4 * hh;
#pragma unroll
        for (int q4 = 0; q4 < 4; ++q4) { const f32x4 sc = *(const f32x4*)(pscale + l * 256 + g * 64 + 32 * dt + 4 * hh + 8 * q4);
            v2u w; w.x = pk2(acc[4 * q4] * sc.x, acc[4 * q4 + 1] * sc.y); w.y = pk2(acc[4 * q4 + 2] * sc.z, acc[4 * q4 + 3] * sc.w);
            *(v2u*)(orow + 8 * q4) = w; }
    }
}
#define XB_TMO      128
#define XB_XCNT(j)  (256  + 64 * (j))
#define XB_XSUB(j)  (1280 + 64 * (j))
#define XB_XGEN(j)  (2304 + 64 * (j))
#define XB_TOP      3328
#define XB_TOPGEN   3392
#define XCD_BAR_WORDS 3456
#define XB_SPIN_CAP (1u << 18)

__device__ __forceinline__ unsigned xb_ld(unsigned* p)              { return __hip_atomic_load(p, __ATOMIC_RELAXED, __HIP_MEMORY_SCOPE_AGENT); }
__device__ __forceinline__ unsigned xb_add(unsigned* p, unsigned v) { return __hip_atomic_fetch_add(p, v, __ATOMIC_RELAXED, __HIP_MEMORY_SCOPE_AGENT); }
__device__ __forceinline__ unsigned xb_xcc_id() { return (unsigned)__builtin_amdgcn_s_getreg((3 << 11) | 20) & 0xFu; }
#define XB_SPIN(cond, bar) do { unsigned _sp = 0; while (cond) { __builtin_amdgcn_s_sleep(1); \
    if ((++_sp & 255u) == 0u) { if (xb_ld(&(bar)[XB_TMO])) break; if (_sp > XB_SPIN_CAP) { atomicAdd(&(bar)[XB_TMO], 1u); break; } } } } while (0)

struct XcdBarrier {
    unsigned* bar; unsigned x;
    volatile LAS unsigned* st;
};

__device__ __forceinline__ XcdBarrier xcd_barrier_post(unsigned* bar, volatile LAS unsigned* st, const bool leader) {
    XcdBarrier b; b.bar = bar; b.x = xb_xcc_id(); b.st = st;
    if (leader) (void)xb_add(&bar[XB_XCNT(b.x)], 1u);
    return b;
}
__device__ __forceinline__ void xcd_barrier_complete(unsigned* bar, unsigned x, unsigned& nloc, unsigned& nx) {
    const unsigned G = gridDim.x * gridDim.y * gridDim.z;
    unsigned sum, cnt, mine, sp = 0u;
    for (;;) {
        sum = 0u; cnt = 0u; mine = 0u;
#pragma unroll
        for (unsigned j = 0; j < 16; ++j) { const unsigned c = xb_ld(&bar[XB_XCNT(j)]); sum += c; cnt += (c > 0u) ? 1u : 0u; mine = (j == x) ? c : mine; }
        if (sum == G) break;
        __builtin_amdgcn_s_sleep(1);
        if ((++sp & 255u) == 0u) { if (xb_ld(&bar[XB_TMO])) break; if (sp > XB_SPIN_CAP) { atomicAdd(&bar[XB_TMO], 1u); break; } }
    }
    nloc = mine > 0u ? mine : 1u; nx = cnt > 0u ? cnt : 1u;
}

__device__ __forceinline__ void xcd_barrier(const XcdBarrier& b, const bool leader) {
    asm volatile("s_waitcnt vmcnt(0)" ::: "memory");
    __syncthreads();
    if (leader) {
        unsigned* bar = b.bar;
        __builtin_amdgcn_s_waitcnt(0);
        unsigned nloc = b.st[0], nx = b.st[1];
        if (nloc == 0u) { xcd_barrier_complete(bar, b.x, nloc, nx); b.st[0] = nloc; b.st[1] = nx; }
        const unsigned old = xb_add(&bar[XB_XSUB(b.x)], 1u);
        const unsigned gen = old / nloc;
        if (old + 1u == (gen + 1u) * nloc) {
            __builtin_amdgcn_fence(__ATOMIC_RELEASE, "agent");
            asm volatile("s_waitcnt vmcnt(0)" ::: "memory");
            const unsigned og = xb_add(&bar[XB_TOP], 1u);
            const unsigned tg = og / nx;
            if (og + 1u == (tg + 1u) * nx) xb_add(&bar[XB_TOPGEN], 1u);
            else XB_SPIN(xb_ld(&bar[XB_TOPGEN]) == tg, bar);
            __builtin_amdgcn_fence(__ATOMIC_ACQUIRE, "agent");
            xb_add(&bar[XB_XGEN(b.x)], 1u);
            asm volatile("s_waitcnt vmcnt(0)" ::: "memory");
        } else {
            XB_SPIN(xb_ld(&bar[XB_XGEN(b.x)]) == gen, bar);
            __builtin_amdgcn_fence(__ATOMIC_ACQUIRE, "agent");
            asm volatile("s_waitcnt vmcnt(0)" ::: "memory");
        }
    }
    __syncthreads();
}
constexpr int BAR_LDS_OFF = LDS_BYTES - 16;
constexpr size_t WS_BAR = 65536;
__device__ __forceinline__ bool is_leader(int wid0) { int lane; asm volatile("v_mbcnt_lo_u32_b32 %0, -1, 0\n\tv_mbcnt_hi_u32_b32 %0, -1, %0" : "=v"(lane)); return wid0 == 0 && lane == 0; }
__device__ __forceinline__ void grid_sync(unsigned char* ws, LAS unsigned char* lds, int wid0) {
    XcdBarrier b; b.bar = (unsigned*)(ws + WS_BAR); b.x = xb_xcc_id(); b.st = (volatile LAS unsigned*)(lds + BAR_LDS_OFF);
    xcd_barrier(b, is_leader(wid0));
}
template <int PH> __device__ __forceinline__ void run_phase(const Params& P0, LAS unsigned char* lds, const int wid0) {
    Params P = P0; asm volatile("" : "+s"(P.ws), "+s"(P.out));
#pragma unroll
    for (int i = 0; i < 16; ++i) asm volatile("" : "+s"(P.in[i]));
    int lane_; asm volatile("v_mbcnt_lo_u32_b32 %0, -1, 0\n\tv_mbcnt_hi_u32_b32 %0, -1, %0" : "=v"(lane_));
    int wid_ = wid0; asm volatile("" : "+s"(wid_));
    const int tid = wid_ * 64 + lane_;
    int bid = blockIdx.x, G = gridDim.x; asm volatile("" : "+s"(bid), "+s"(G));
    const int lane = lane_, wid = wid_;
    if constexpr (PH == 0) phase_prologue(P, lds, bid, G, tid, wid, lane);
    else if constexpr (PH == N_PHASES - 1) phase_norm(P, 0, 2, bid, G, wid, lane);
    else {
        constexpr int l = (PH - 1) / NPH, s = (PH - 1) % NPH;
        float* RS = (float*)(P.ws + WS_RS);
        if constexpr (s == 0) { pg8::Gemm g{(const pg8::bf16_t*)(P.ws + WS_XB), (const pg8::bf16_t*)(P.ws + WS_WIN) + (size_t)l * NIN * D, T, NIN, D};
            pg8::StaticOrder S; S.init(T, NIN, G, bid); const int fm = pg8::stage_rstd(RS + (size_t)(2 * l) * T * 16, lds, S, tid);
            pg8::EpiStoreBf16 E{(pg8::bf16_t*)(P.ws + WS_U), NIN, RS + (size_t)(2 * l) * T * 16, (float*)(P.ws + WS_DT), P.in[I_DTB] + l * 6, (const LAS float*)(lds + pg8::RSTD_LDS_OFF), fm};
            pg8::gemm_phase<pg8::EpiStoreBf16, pg8::StaticOrder, true, true>(lds, g, S, E, tid);
            if constexpr (l + 1 < DEPTH) convert_in_slack(P, lds, l + 1, 0, 960, (T / 256) * (NIN / 256), bid, G, wid, lane); }
        else if constexpr (s == 1) {
            { unsigned* qctr = (unsigned*)(P.ws + WS_CTL) + 64 * (l + 1);
              volatile LAS unsigned* qslot = (volatile LAS unsigned*)(lds + BAR_LDS_OFF + 8);
              for (;;) {
                  __syncthreads();
                  if (tid == 0) *qslot = __hip_atomic_fetch_add(qctr, 1u, __ATOMIC_RELAXED, __HIP_MEMORY_SCOPE_AGENT);
                  __syncthreads();
                  int q = (int)*qslot;
                  if (q >= 384 * (1 + (DUP_MIX & 1)) + 240 + 256) break;
                  int t2 = tid; asm volatile("" : "+v"(t2));
                  if (q < 384 * (1 + (DUP_MIX & 1))) { const int u = q % 384; attn_unit(P, (u % 48) / 6, (u % 48) % 6, 7 - u / 48, lds, t2, wid, t2 & 63); }
                  else { q -= 384 * (1 + (DUP_MIX & 1));
                      if (q < 240) { const int bb = q / 30, rem = q % 30; ssd_unit_a(P, l, bb, rem >> 1, rem & 1, lds, t2, wid, t2 & 63); }
                      else pool_unit(P, l, q - 240, lds, t2, wid, t2 & 63); }
              } }
        }
        else if constexpr (s == 2) ssd_scan(P, bid, G, tid);
        else if constexpr (s == 3) { for (int u = bid; u < 256; u += G) { int t2 = tid; asm volatile("" : "+v"(t2)); ssd_unit_b(P, l, u >> 5, (u >> 1) & 15, u & 1, lds, t2, wid, t2 & 63); } }
        else if constexpr (s == 4) { pg8::Gemm g{(const pg8::bf16_t*)(P.ws + WS_H), (const pg8::bf16_t*)(P.ws + WS_WOUT) + (size_t)l * D * D, T, D, D};
            pg8::StaticOrder S; S.init(T, D, G, bid); pg8::EpiResidual<l == 0> E{P.in[I_X], D, (pg8::bf16_t*)(P.ws + WS_XB), RS + (size_t)(2 * l + 1) * T * 16};
            pg8::gemm_phase<pg8::EpiResidual<l == 0>, pg8::StaticOrder, true, true>(lds, g, S, E, tid); }
        else if constexpr (s == 5) { pg8::Gemm g{(const pg8::bf16_t*)(P.ws + WS_XB), (const pg8::bf16_t*)(P.ws + WS_WGU) + (size_t)l * NGU * D, T, NGU, D};
            pg8::StaticOrder S; S.init(T, NGU, G, bid); const int fm = pg8::stage_rstd(RS + (size_t)(2 * l + 1) * T * 16, lds, S, tid);
            pg8::EpiSwiGLU E{(pg8::bf16_t*)(P.ws + WS_U), FF, RS + (size_t)(2 * l + 1) * T * 16, (const LAS float*)(lds + pg8::RSTD_LDS_OFF), fm};
            pg8::gemm_phase<pg8::EpiSwiGLU, pg8::StaticOrder, true, true>(lds, g, S, E, tid);
            if constexpr (l + 1 < DEPTH) convert_in_slack(P, lds, l + 1, 960, 3072, (T / 256) * (NGU / 256), bid, G, wid, lane); }
        else { pg8::Gemm g{(const pg8::bf16_t*)(P.ws + WS_U), (const pg8::bf16_t*)(P.ws + WS_WD) + (size_t)l * D * FF, T, D, FF};
            pg8::StaticOrder S; S.init(T, D, G, bid); pg8::EpiResidual<false> E{nullptr, D, (pg8::bf16_t*)(P.ws + WS_XB), RS + (size_t)(2 * l + 2) * T * 16};
            pg8::gemm_phase<pg8::EpiResidual<false>, pg8::StaticOrder, true, true>(lds, g, S, E, tid); }
    }
}
template <int PH> __device__ __forceinline__ void run_all(const Params& P0, LAS unsigned char* lds, const int wid0, const int lo, const int hi) {
    if constexpr (PH < N_PHASES) {
        if (PH >= lo && PH < hi) { run_phase<PH>(P0, lds, wid0);
#if DUP_S
            if constexpr (PH >= 1 && PH < N_PHASES - 1 && ((DUP_S >> ((PH - 1) % NPH)) & 1)) { __syncthreads(); run_phase<PH>(P0, lds, wid0); }
            if constexpr (PH == 0 && ((DUP_S >> 30) & 1)) { __syncthreads(); run_phase<PH>(P0, lds, wid0); }
#endif
            if (PH + 1 < hi) {
#pragma unroll
                for (int rep = 0; rep < SYNC_REP; ++rep) grid_sync(P0.ws, lds, wid0); } }
        run_all<PH + 1>(P0, lds, wid0, lo, hi);
    }
}
__global__ void __launch_bounds__(512, 2) mega(Params P0) {
    extern __shared__ __attribute__((aligned(16))) unsigned char lds_raw[];
    LAS unsigned char* lds = (LAS unsigned char*)lds_raw;
    const int wid0 = __builtin_amdgcn_readfirstlane(threadIdx.x >> 6);
    { const bool leader = is_leader(wid0);
      if (leader) { ((volatile LAS unsigned*)(lds + BAR_LDS_OFF))[0] = 0u; ((volatile LAS unsigned*)(lds + BAR_LDS_OFF))[1] = 0u; }
      __syncthreads();
      if (P0.ph_hi - P0.ph_lo > 1) (void)xcd_barrier_post((unsigned*)(P0.ws + WS_BAR), (volatile LAS unsigned*)(lds + BAR_LDS_OFF), leader); }
    run_all<0>(P0, lds, wid0, P0.ph_lo, P0.ph_hi);
}

#ifndef ONE_LAUNCH
#define ONE_LAUNCH 1
#endif
extern "C" void kernel_launch(void* const* d_in, const int* in_sizes, int n_in, void* d_out, int out_size, void* d_ws, size_t ws_size, hipStream_t stream) {
    static int grid = 0;
    if (grid == 0) {
        if (n_in != 16 || out_size != T * D || ws_size < WS_END) { fprintf(stderr, "kernel_launch: unexpected shapes n_in %d out %d ws %zu\n", n_in, out_size, ws_size); grid = -1; return; }
        int dev = 0, cus = 0, per_cu = 0;
        hipGetDevice(&dev); hipDeviceGetAttribute(&cus, hipDeviceAttributeMultiprocessorCount, dev);
        if (hipFuncSetAttribute((const void*)mega, hipFuncAttributeMaxDynamicSharedMemorySize, LDS_BYTES) != hipSuccess) { fprintf(stderr, "kernel_launch: hipFuncSetAttribute failed\n"); grid = -1; return; }
        hipOccupancyMaxActiveBlocksPerMultiprocessor(&per_cu, (const void*)mega, 512, LDS_BYTES);
        if (per_cu < 1) { fprintf(stderr, "kernel_launch: occupancy query says %d\n", per_cu); per_cu = 1; }
        (void)hipGetLastError();
        grid = cus * per_cu;
    }
    if (grid < 0) return;
    if (hipMemsetAsync((char*)d_ws + WS_CTL, 0, 131072, stream) != hipSuccess) { fprintf(stderr, "kernel_launch: memset failed\n"); return; }
    Params p{};
    for (int i = 0; i < 16; ++i) p.in[i] = (const float*)d_in[i];
    p.out = (float*)d_out; p.ws = (unsigned char*)d_ws;
#if ONE_LAUNCH
    p.ph_lo = 0; p.ph_hi = N_PHASES;
    void* args[] = {&p};
    hipError_t e = hipLaunchCooperativeKernel((const void*)mega, dim3(grid), dim3(512), args, LDS_BYTES, stream);
    if (e != hipSuccess) fprintf(stderr, "cooperative launch failed: %s (grid %d)\n", hipGetErrorString(e), grid);
#else
    for (int ph = 0; ph < N_PHASES; ++ph) { p.ph_lo = ph; p.ph_hi = ph + 1; hipLaunchKernelGGL(mega, dim3(grid), dim3(512), LDS_BYTES, stream, p); }
#endif
}
```

```cpp
#include <hip/hip_runtime.h>
#include <hip/hip_cooperative_groups.h>
#include <cstdio>
#include <cstdint>
namespace cg = cooperative_groups;
#ifndef EPI_REP
#define EPI_REP 0
#endif
namespace pg8 {
#define PG8_LAS __attribute__((address_space(3)))
typedef unsigned short bf16_t;
typedef short bf16x8 __attribute__((ext_vector_type(8)));
typedef float f32x4 __attribute__((ext_vector_type(4)));
typedef unsigned u32x4 __attribute__((ext_vector_type(4)));
constexpr int BM = 256, BK = 64, HALF = 128, HTB = HALF * BK * 2  , STAGE_BYTES = 8 * HTB, NXCD = 8, WGM = 8;

__host__ __device__ __forceinline__ int lds_byte(int r, int c) { const int st = (r >> 4) * 2 + (c >> 5), rr = r & 15, cc = c & 31, ob = rr * 64 + cc * 2; return st * 1024 + (ob ^ (((ob >> 9) & 1) << 5)); }
__host__ __device__ __forceinline__ void stage_rc(int b, int& R, int& C) { const int st = b / 1024, sb = b % 1024, swz = sb ^ (((sb >> 9) & 1) << 5); R = (st >> 1) * 16 + swz / 64; C = (st & 1) * 32 + (swz % 64) / 2; }
__host__ __device__ __forceinline__ int perm32(int rho) { const int n = rho >> 4, i = rho & 15; return 8 * (i >> 2) + 4 * n + (i & 3); }

struct Unit { int pm, pn; };
struct Gemm { const bf16_t* A; const bf16_t* Bt; int M, N, K; };

struct StaticOrder {
    int nM, nN, nwg, G, c;
    __host__ __device__ void init(int M, int N, int G_, int c_) { nM = M / BM; nN = N / BM; nwg = nM * nN; G = G_; c = c_; }
    __host__ __device__ bool next(int i, Unit& u) const {
        const long L = (long)i * G + c; if (L >= nwg) return false;
        int wgid = (int)L; { const int q = nwg / NXCD, r = nwg % NXCD, xcd = wgid % NXCD, off = wgid / NXCD; wgid = (xcd < r ? xcd * (q + 1) : r * (q + 1) + (xcd - r) * q) + off; }
        const int nig = WGM * nN, gid = wgid / nig, fm = gid * WGM, gsz = (nM - fm) < WGM ? (nM - fm) : WGM;
        u.pm = fm + ((wgid % nig) % gsz); u.pn = (wgid % nig) / gsz; return true;
    }
    __device__ __forceinline__ void a_ready(const Unit&) const {}
    __device__ __forceinline__ void done(const Unit&) const {}
};

__device__ __forceinline__ unsigned cvt_pk_bf16(float lo, float hi) { unsigned r; asm volatile("v_cvt_pk_bf16_f32 %0, %1, %2" : "=v"(r) : "v"(lo), "v"(hi)); return r; }
__device__ __forceinline__ float rstd_of(const float* rs, size_t row) {
    const f32x4 a = *(const f32x4*)(rs + row * 16), b = *(const f32x4*)(rs + row * 16 + 4), c = *(const f32x4*)(rs + row * 16 + 8), d = *(const f32x4*)(rs + row * 16 + 12);
    const float t = (((a[0] + a[1]) + (a[2] + a[3])) + ((b[0] + b[1]) + (b[2] + b[3]))) + (((c[0] + c[1]) + (c[2] + c[3])) + ((d[0] + d[1]) + (d[2] + d[3])));
    return __builtin_amdgcn_rsqf(t * (1.f / 1024.f) + 1e-6f);
}
constexpr int RSTD_LDS_OFF = 131072;
template <class Sched> __device__ __forceinline__ int stage_rstd(const float* rs, PG8_LAS unsigned char* lds, const Sched& S, int tid) {
    Unit u0; if (!S.next(0, u0)) return 0;
    const int fm = (u0.pm >> 3) << 3;
    PG8_LAS float* rl = (PG8_LAS float*)(lds + RSTD_LDS_OFF);
#pragma unroll
    for (int k = 0; k < 4; ++k) rl[tid + 512 * k] = rstd_of(rs, (size_t)fm * BM + tid + 512 * k);
    __syncthreads();
    return fm;
}
#define RSV_LOAD(rsv, rs, rl, fm, row0) do { _Pragma("unroll") for (int ai_ = 0; ai_ < 2; ++ai_) _Pragma("unroll") for (int m_ = 0; m_ < 4; ++m_) { \
    const int ri_ = (row0) + ai_ * HALF + m_ * 16 - (fm) * BM; (rsv)[ai_][m_] = ((unsigned)ri_ < 2048u) ? (rl)[ri_] : rstd_of((rs), (size_t)((row0) + ai_ * HALF + m_ * 16)); } } while (0)
__device__ __forceinline__ float softplus_f(float z) { return fmaxf(z, 0.f) + log1pf(__expf(-fabsf(z))); }
struct EpiStoreBf16 { static constexpr bool IDEMP = true;
    static constexpr bool PERM = true, AFTER_DRAIN = false;
    bf16_t* O; int ldc; const float* rs; float* DT; const float* dtb; const PG8_LAS float* rl; int fm;
    __device__ __forceinline__ void operator()(const f32x4 (&acc)[2][2][4][2], const Unit& u, int wr, int wc, int fr, int fq) const {
        const int row0 = u.pm * BM + wr * 64 + fr; const int col0 = u.pn * BM + wc * 32 + 8 * fq;
        const bool dtl = (u.pn == 10) && (wc == 0) && (fq == 0);
        float rsv[2][4];
        RSV_LOAD(rsv, rs, rl, fm, row0);
#pragma unroll
        for (int ai = 0; ai < 2; ++ai)
#pragma unroll
            for (int m = 0; m < 4; ++m) { const size_t row = (size_t)(row0 + ai * HALF + m * 16); bf16_t* rowp = O + row * ldc + col0;
                const float rstd = rsv[ai][m];
#pragma unroll
                for (int bj = 0; bj < 2; ++bj) { const f32x4 v0 = acc[ai][bj][m][0] * rstd, v1 = acc[ai][bj][m][1] * rstd;
                    u32x4 w; w.x = cvt_pk_bf16(v0[0], v0[1]); w.y = cvt_pk_bf16(v0[2], v0[3]); w.z = cvt_pk_bf16(v1[0], v1[1]); w.w = cvt_pk_bf16(v1[2], v1[3]);
                    *(u32x4*)(rowp + bj * HALF) = w;
                    if (bj == 1 && dtl) { f32x4 d0; d0[0] = softplus_f(v0[0] + dtb[0]); d0[1] = softplus_f(v0[1] + dtb[1]); d0[2] = softplus_f(v0[2] + dtb[2]); d0[3] = softplus_f(v0[3] + dtb[3]);
                        *(f32x4*)(DT + row * 8) = d0; DT[row * 8 + 4] = softplus_f(v1[0] + dtb[4]); DT[row * 8 + 5] = softplus_f(v1[1] + dtb[5]); } }
                __builtin_amdgcn_sched_barrier(0); }
    }
};
template <bool R32> struct EpiResidual { static constexpr bool IDEMP = false;
    static constexpr bool PERM = true, AFTER_DRAIN = false;
    const float* R; int ld; bf16_t* XB; float* RSO;
    __device__ __forceinline__ void operator()(const f32x4 (&acc)[2][2][4][2], const Unit& u, int wr, int wc, int fr, int fq) const {
        const int row0 = u.pm * BM + wr * 64 + fr; const int col0 = u.pn * BM + wc * 32 + 8 * fq;
#pragma unroll
        for (int ai = 0; ai < 2; ++ai) {
            f32x4 rv[4][2][2];
#pragma unroll
            for (int m = 0; m < 4; ++m)
#pragma unroll
                for (int bj = 0; bj < 2; ++bj) { const size_t off = (size_t)(row0 + ai * HALF + m * 16) * ld + col0 + bj * HALF;
                    if constexpr (R32) { rv[m][bj][0] = *(const f32x4*)(R + off); rv[m][bj][1] = *(const f32x4*)(R + off + 4); }
                    else { const u32x4 q = *(const u32x4*)(XB + off);
                        rv[m][bj][0] = (f32x4){__builtin_bit_cast(float, q.x << 16), __builtin_bit_cast(float, q.x & 0xffff0000u), __builtin_bit_cast(float, q.y << 16), __builtin_bit_cast(float, q.y & 0xffff0000u)};
                        rv[m][bj][1] = (f32x4){__builtin_bit_cast(float, q.z << 16), __builtin_bit_cast(float, q.z & 0xffff0000u), __builtin_bit_cast(float, q.w << 16), __builtin_bit_cast(float, q.w & 0xffff0000u)}; } }
#pragma unroll
            for (int m = 0; m < 4; ++m) { const size_t row = (size_t)(row0 + ai * HALF + m * 16); const size_t off = row * ld + col0;
                float ss = 0.f;
#pragma unroll
                for (int bj = 0; bj < 2; ++bj) {
                    const f32x4 x0 = rv[m][bj][0] + acc[ai][bj][m][0], x1 = rv[m][bj][1] + acc[ai][bj][m][1];
                    u32x4 w; w.x = cvt_pk_bf16(x0[0], x0[1]); w.y = cvt_pk_bf16(x0[2], x0[3]); w.z = cvt_pk_bf16(x1[0], x1[1]); w.w = cvt_pk_bf16(x1[2], x1[3]);
                    *(u32x4*)(XB + off + bj * HALF) = w;
                    ss += ((x0[0] * x0[0] + x0[1] * x0[1]) + (x0[2] * x0[2] + x0[3] * x0[3])) + ((x1[0] * x1[0] + x1[1] * x1[1]) + (x1[2] * x1[2] + x1[3] * x1[3])); }
                ss += __builtin_bit_cast(float, __builtin_amdgcn_ds_swizzle(__builtin_bit_cast(int, ss), (16 << 10) | 0x1f));
                { float a = ss, b = ss; asm volatile("s_nop 1\n\tv_permlane32_swap_b32 %0, %1" : "+v"(a), "+v"(b)); ss = a + b; }
                if (fq == 0) RSO[row * 16 + u.pn * 4 + wc] = ss; }
            __builtin_amdgcn_sched_barrier(0); }
    }
};
__device__ __forceinline__ float silu_f(float g) { return g * __builtin_amdgcn_rcpf(1.f + __expf(-g)); }
struct EpiSwiGLU { static constexpr bool IDEMP = true;
    static constexpr bool PERM = true, AFTER_DRAIN = false;
    bf16_t* O; int ldc; const float* rs; const PG8_LAS float* rl; int fm;
    __device__ __forceinline__ void operator()(const f32x4 (&acc)[2][2][4][2], const Unit& u, int wr, int wc, int fr, int fq) const {
        const int row0 = u.pm * BM + wr * 64 + fr; const int col0 = u.pn * HALF + wc * 32 + 8 * fq;
        float rsv[2][4];
        RSV_LOAD(rsv, rs, rl, fm, row0);
#pragma unroll
        for (int ai = 0; ai < 2; ++ai)
#pragma unroll
            for (int m = 0; m < 4; ++m) { const size_t row = (size_t)(row0 + ai * HALF + m * 16); bf16_t* rowp = O + row * ldc + col0;
                const float rstd = rsv[ai][m];
                const f32x4 g0 = acc[ai][0][m][0] * rstd, g1 = acc[ai][0][m][1] * rstd, u0 = acc[ai][1][m][0] * rstd, u1 = acc[ai][1][m][1] * rstd;
                u32x4 w; w.x = cvt_pk_bf16(silu_f(g0[0]) * u0[0], silu_f(g0[1]) * u0[1]); w.y = cvt_pk_bf16(silu_f(g0[2]) * u0[2], silu_f(g0[3]) * u0[3]);
                w.z = cvt_pk_bf16(silu_f(g1[0]) * u1[0], silu_f(g1[1]) * u1[1]); w.w = cvt_pk_bf16(silu_f(g1[2]) * u1[2], silu_f(g1[3]) * u1[3]);
                *(u32x4*)rowp = w; __builtin_amdgcn_sched_barrier(0); }
    }
};
template <class Epi, class Sched, bool ALIGN_EPI = false, bool SP2 = false>
__device__ __forceinline__ void gemm_phase(PG8_LAS unsigned char* lds, const Gemm g, const Sched& S, const Epi& E, const int tid) {
    const int wid = __builtin_amdgcn_readfirstlane(tid >> 6), lane = tid & 63, wr = wid >> 2, wc = wid & 3, fr = lane & 15, fq = lane >> 4;
    const int K = g.K, nt = K / BK;
    unsigned voffA[2], voffB[2];
#pragma unroll
    for (int i = 0; i < 2; ++i) { int R, C; stage_rc(tid * 16 + i * 8192, R, C); const int Rb = Epi::PERM ? ((R & ~31) + perm32(R & 31)) : R;
        voffA[i] = (unsigned)(R * K + C) * 2u; voffB[i] = (unsigned)(Rb * K + C) * 2u; }
    const size_t kstep = (size_t)(BK * 2);
    const size_t hstep = (size_t)HALF * K * 2;
    const size_t tstep = 2 * hstep;
    const unsigned ldsw = (unsigned)wid * 1024u;
    const int aoff = lds_byte(wr * 64 + fr, fq * 8), boff = lds_byte(wc * 32 + fr, fq * 8);
#define PG8_SA(b, h) (((b) * 2 + (h)) * HTB)
#define PG8_SB(b, h) ((4 + (b) * 2 + (h)) * HTB)
#define PG8_STAGE(bufoff, gbase, voff) do { _Pragma("unroll") for (int _i = 0; _i < 2; ++_i) \
        __builtin_amdgcn_global_load_lds((const unsigned*)((const char*)(gbase) + (voff)[_i]), (PG8_LAS unsigned*)(lds + (bufoff) + ldsw + _i * 8192), 16, 0, 0); } while (0)
#define PG8_LDA(dst, b, h) do { _Pragma("unroll") for (int m = 0; m < 4; ++m) _Pragma("unroll") for (int k = 0; k < 2; ++k) dst[m][k] = *(const PG8_LAS bf16x8*)(lds + PG8_SA(b, h) + aoff + m * 2048 + k * 1024); } while (0)
#define PG8_LDB(dst, b, h) do { _Pragma("unroll") for (int n = 0; n < 2; ++n) _Pragma("unroll") for (int k = 0; k < 2; ++k) dst[n][k] = *(const PG8_LAS bf16x8*)(lds + PG8_SB(b, h) + boff + n * 2048 + k * 1024); } while (0)
#define PG8_MMA(ai, bj, At, Bt) do { __builtin_amdgcn_s_setprio(1); _Pragma("unroll") for (int m = 0; m < 4; ++m) _Pragma("unroll") for (int n = 0; n < 2; ++n) _Pragma("unroll") for (int k = 0; k < 2; ++k) \
        acc[ai][bj][m][n] = __builtin_amdgcn_mfma_f32_16x16x32_bf16(Bt[n][k], At[m][k], acc[ai][bj][m][n], 0, 0, 0); __builtin_amdgcn_s_setprio(0); } while (0)
#define PG8_WAIT_V(n) asm volatile("s_waitcnt vmcnt(" #n ")" ::: "memory")
#define PG8_WAIT_L(n) asm volatile("s_waitcnt lgkmcnt(" #n ")" ::: "memory")
#define PG8_BAR __builtin_amdgcn_s_barrier()
#define PG8_SCHED __builtin_amdgcn_sched_barrier(0)
    Unit cur, nxt; int ui = 0;
    if (!S.next(0, cur)) return;
    f32x4 acc[2][2][4][2];
#pragma unroll
    for (int a = 0; a < 2; ++a)
#pragma unroll
        for (int b = 0; b < 2; ++b)
#pragma unroll
            for (int m = 0; m < 4; ++m)
#pragma unroll
                for (int n = 0; n < 2; ++n) acc[a][b][m][n] = (f32x4){0.f, 0.f, 0.f, 0.f};
    bf16x8 At[4][2], B0[2][2], B1[2][2];
    const char* cA = (const char*)g.A + (size_t)cur.pm * tstep; const char* cB = (const char*)g.Bt + (size_t)cur.pn * tstep;
    S.a_ready(cur);
    if constexpr (SP2) {
        PG8_STAGE(PG8_SB(0, 0), cB, voffB); PG8_STAGE(PG8_SB(0, 1), cB + hstep, voffB); PG8_STAGE(PG8_SA(0, 0), cA, voffA); PG8_STAGE(PG8_SA(0, 1), cA + hstep, voffA);
        if (wr == 1) PG8_BAR;
        PG8_WAIT_V(2); PG8_BAR;
        PG8_STAGE(PG8_SB(1, 0), cB + kstep, voffB); PG8_STAGE(PG8_SA(1, 0), cA + kstep, voffA); PG8_STAGE(PG8_SB(1, 1), cB + hstep + kstep, voffB);
        PG8_WAIT_V(6); PG8_BAR;
    } else {
        PG8_STAGE(PG8_SB(0, 0), cB, voffB); PG8_STAGE(PG8_SA(0, 0), cA, voffA); PG8_STAGE(PG8_SB(0, 1), cB + hstep, voffB); PG8_STAGE(PG8_SA(0, 1), cA + hstep, voffA);
        if (wr == 1) PG8_BAR;
        PG8_WAIT_V(4); PG8_BAR;
        PG8_STAGE(PG8_SB(1, 0), cB + kstep, voffB); PG8_STAGE(PG8_SA(1, 0), cA + kstep, voffA); PG8_STAGE(PG8_SB(1, 1), cB + hstep + kstep, voffB);
        PG8_WAIT_V(6); PG8_BAR;
    }
    for (;;) {
        const bool has_next = S.next(ui + 1, nxt);
        const char* nA = has_next ? (const char*)g.A + (size_t)nxt.pm * tstep : cA; const char* nB = has_next ? (const char*)g.Bt + (size_t)nxt.pn * tstep : cB;
        for (int t = 0; t < nt; t += 2) {
            const bool last = (t == nt - 2);
            const char* a1 = cA + (size_t)(t + 1) * kstep;
            const char* a2 = last ? nA : cA + (size_t)(t + 2) * kstep; const char* b2 = last ? nB : cB + (size_t)(t + 2) * kstep;
            const char* a3 = a2 + kstep; const char* b3 = b2 + kstep;
            if (last && has_next) S.a_ready(nxt);
            if constexpr (SP2) {
            PG8_LDB(B0, 0, 0); PG8_LDB(B1, 0, 1); PG8_SCHED; PG8_LDA(At, 0, 0); PG8_STAGE(PG8_SA(1, 1), a1 + hstep, voffA);
            PG8_WAIT_V(8); PG8_WAIT_L(0); PG8_BAR; PG8_MMA(0, 0, At, B0); PG8_MMA(0, 1, At, B1); PG8_BAR; PG8_SCHED;
            PG8_LDA(At, 0, 1); PG8_STAGE(PG8_SB(0, 0), b2, voffB); PG8_STAGE(PG8_SB(0, 1), b2 + hstep, voffB); PG8_STAGE(PG8_SA(0, 0), a2, voffA);
            PG8_WAIT_V(8); PG8_WAIT_L(0); PG8_BAR; PG8_MMA(1, 0, At, B0); PG8_MMA(1, 1, At, B1); PG8_BAR; PG8_SCHED;
            PG8_LDB(B0, 1, 0); PG8_LDB(B1, 1, 1); PG8_SCHED; PG8_LDA(At, 1, 0); PG8_STAGE(PG8_SA(0, 1), a2 + hstep, voffA);
            PG8_WAIT_V(8); PG8_WAIT_L(0); PG8_BAR; PG8_MMA(0, 0, At, B0); PG8_MMA(0, 1, At, B1); PG8_BAR; PG8_SCHED;
            PG8_LDA(At, 1, 1); PG8_STAGE(PG8_SB(1, 0), b3, voffB); PG8_STAGE(PG8_SB(1, 1), b3 + hstep, voffB); PG8_STAGE(PG8_SA(1, 0), a3, voffA);
            PG8_WAIT_V(8); PG8_WAIT_L(0); PG8_BAR; PG8_MMA(1, 0, At, B0); PG8_MMA(1, 1, At, B1); PG8_BAR; PG8_SCHED;
            } else {
            PG8_LDB(B0, 0, 0); PG8_SCHED; PG8_LDA(At, 0, 0); PG8_STAGE(PG8_SA(1, 1), a1 + hstep, voffA);
            PG8_WAIT_L(8); PG8_BAR; PG8_WAIT_L(0); PG8_MMA(0, 0, At, B0); PG8_BAR; PG8_SCHED;
            PG8_LDB(B1, 0, 1); PG8_STAGE(PG8_SB(0, 0), b2, voffB);
            PG8_BAR; PG8_WAIT_L(0); PG8_MMA(0, 1, At, B1); PG8_BAR;
            PG8_LDA(At, 0, 1); PG8_STAGE(PG8_SA(0, 0), a2, voffA);
            PG8_BAR; PG8_WAIT_L(0); PG8_MMA(1, 0, At, B0); PG8_BAR; PG8_SCHED;
            PG8_STAGE(PG8_SB(0, 1), b2 + hstep, voffB);
            PG8_WAIT_V(6); PG8_BAR; PG8_MMA(1, 1, At, B1); PG8_BAR;
            PG8_LDB(B0, 1, 0); PG8_SCHED; PG8_LDA(At, 1, 0); PG8_STAGE(PG8_SA(0, 1), a2 + hstep, voffA);
            PG8_WAIT_L(8); PG8_BAR; PG8_WAIT_L(0); PG8_MMA(0, 0, At, B0); PG8_BAR; PG8_SCHED;
            PG8_LDB(B1, 1, 1); PG8_STAGE(PG8_SB(1, 0), b3, voffB);
            PG8_BAR; PG8_WAIT_L(0); PG8_MMA(0, 1, At, B1); PG8_BAR;
            PG8_LDA(At, 1, 1); PG8_STAGE(PG8_SA(1, 0), a3, voffA);
            PG8_BAR; PG8_WAIT_L(0); PG8_MMA(1, 0, At, B0); PG8_BAR; PG8_SCHED;
            PG8_STAGE(PG8_SB(1, 1), b3 + hstep, voffB);
            PG8_WAIT_V(6); PG8_BAR; PG8_MMA(1, 1, At, B1); PG8_BAR;
            }
        }
        if constexpr (ALIGN_EPI) { if (wr == 0) PG8_BAR; }
        if constexpr (!Epi::AFTER_DRAIN) { E(acc, cur, wr, wc, fr, fq);
#if EPI_REP
            if constexpr (Epi::IDEMP) { __builtin_amdgcn_sched_barrier(0); E(acc, cur, wr, wc, fr, fq); }
#endif
            S.done(cur); }
        if (!has_next) break;
#pragma unroll
        for (int a = 0; a < 2; ++a)
#pragma unroll
            for (int b = 0; b < 2; ++b)
#pragma unroll
                for (int m = 0; m < 4; ++m)
#pragma unroll
                    for (int n = 0; n < 2; ++n) acc[a][b][m][n] = (f32x4){0.f, 0.f, 0.f, 0.f};
        cur = nxt; cA = nA; cB = nB; ++ui;
        if constexpr (ALIGN_EPI) { if (wr == 1) PG8_BAR; }
    }
    PG8_WAIT_V(0);
    if constexpr (!ALIGN_EPI) { if (wr == 0) PG8_BAR; }
    PG8_BAR;
    if constexpr (Epi::AFTER_DRAIN) { E.fused(acc, cur, wr, wc, fr, fq, lds, wid, lane); S.done(cur); }
#undef PG8_SA
#undef PG8_SB
#undef PG8_STAGE
#undef PG8_LDA
#undef PG8_LDB
#undef PG8_MMA
#undef PG8_WAIT_V
#undef PG8_WAIT_L
#undef PG8_BAR
#undef PG8_SCHED
}
}

#define LAS __attribute__((address_space(3)))
typedef unsigned short bf16;
typedef unsigned v4u __attribute__((ext_vector_type(4)));
typedef unsigned v2u __attribute__((ext_vector_type(2)));
typedef float f32x4 __attribute__((ext_vector_type(4)));
constexpr int BATCH = 8, SEQ = 2048, T = BATCH * SEQ, D = 1024, DEPTH = 4;
constexpr int INW = 2694, NIN = 2816, FF = 2816, NGU = 5632;
constexpr int UQ = 0, UK = 384, UV = 768, UZ = 1152, UXS = 1536, UP = 2432;
constexpr int XBC = 896;
constexpr float EPS = 1e-6f;
constexpr size_t MiB = 1u << 20;
constexpr size_t WS_CTL = 0;
constexpr size_t WS_WIN = 1 * MiB, WS_WOUT = 23 * MiB, WS_WGU = 31 * MiB, WS_WD = 75 * MiB;
constexpr size_t WS_DTW = 97 * MiB, WS_PWT = WS_DTW + 128 * 1024, WS_KM = WS_DTW + 256 * 1024, WS_CD = WS_DTW + 512 * 1024;
constexpr size_t WS_DT = 98 * MiB, WS_H = 99 * MiB, WS_U = 131 * MiB, WS_ST = 219 * MiB, WS_PREV = 243 * MiB, WS_RS = 255 * MiB, WS_XB = 266 * MiB, WS_END = 298 * MiB;
constexpr int LDS_BYTES = 147456;
#ifndef NAIVE_ATTN
#define NAIVE_ATTN 0
#endif
#ifndef NAIVE_SSD
#define NAIVE_SSD 0
#endif
#ifndef NAIVE_POOL
#define NAIVE_POOL 0
#endif
#ifndef DUP_S
#define DUP_S 0
#endif
#ifndef SYNC_REP
#define SYNC_REP 1
#endif
#ifndef DUP_MIX
#define DUP_MIX 0
#endif
constexpr int NPH = 7;
constexpr int N_PHASES = 2 + DEPTH * NPH;

__device__ __forceinline__ float bf2f(unsigned short u) { return __builtin_bit_cast(float, (unsigned)u << 16); }
__device__ __forceinline__ unsigned f2bf(float f) { unsigned u = __builtin_bit_cast(unsigned, f); return (u + 0x7fffu + ((u >> 16) & 1u)) >> 16; }
__device__ __forceinline__ unsigned pk2(float lo, float hi) { return f2bf(lo) | (f2bf(hi) << 16); }
#define SWZ_XOR(v, m) __builtin_bit_cast(float, __builtin_amdgcn_ds_swizzle(__builtin_bit_cast(int, (v)), ((m) << 10) | 0x1f))
__device__ __forceinline__ float half_sum(float v) { v += SWZ_XOR(v, 1); v += SWZ_XOR(v, 2); v += SWZ_XOR(v, 4); v += SWZ_XOR(v, 8); v += SWZ_XOR(v, 16); return v; }
__device__ __forceinline__ float wave_sum(float v) {
    v = half_sum(v);
    return __builtin_bit_cast(float, __builtin_amdgcn_readlane(__builtin_bit_cast(int, v), 0)) + __builtin_bit_cast(float, __builtin_amdgcn_readlane(__builtin_bit_cast(int, v), 32));
}
__device__ __forceinline__ float wave_max(float v) {
    v = fmaxf(v, SWZ_XOR(v, 1)); v = fmaxf(v, SWZ_XOR(v, 2)); v = fmaxf(v, SWZ_XOR(v, 4)); v = fmaxf(v, SWZ_XOR(v, 8)); v = fmaxf(v, SWZ_XOR(v, 16));
    return fmaxf(__builtin_bit_cast(float, __builtin_amdgcn_readlane(__builtin_bit_cast(int, v), 0)), __builtin_bit_cast(float, __builtin_amdgcn_readlane(__builtin_bit_cast(int, v), 32)));
}
__device__ __forceinline__ float silu(float g) { return g / (1.f + __expf(-g)); }

struct Params { const float* in[16]; float* out; unsigned char* ws; int ph_lo, ph_hi; };
enum { I_X = 0, I_NMIX, I_WIN, I_CONVW, I_CONVB, I_DTB, I_ALOG, I_DSKIP, I_SSDN, I_POOLW, I_POOLS, I_WOUT, I_NFFN, I_WGU, I_WD, I_NFIN };

typedef float f32x2v __attribute__((ext_vector_type(2)));
__device__ __forceinline__ void transpose_item(const float* W, int srcN, int c0, int ncols, const float* gk, int k0, bf16* WT, int dstK, int n0, LAS float* scr, int lane) {
    const int cq = lane & 31, kr = lane >> 5;
    if (c0 >= 0) {
        const float* src = W + (size_t)(k0 + kr) * srcN + c0 + 2 * cq;
#pragma unroll
        for (int i = 0; i < 32; ++i) { f32x2v v = {0.f, 0.f};
            if (2 * cq < ncols) v = *(const f32x2v*)(src + (size_t)(2 * i) * srcN);
            scr[(2 * i + kr) * 65 + 2 * cq] = v.x; scr[(2 * i + kr) * 65 + 2 * cq + 1] = v.y; }
    }
    asm volatile("s_waitcnt lgkmcnt(0)" ::: "memory");
    const int c = lane & 7;
    f32x4 g0 = {1.f, 1.f, 1.f, 1.f}, g1 = g0;
    if (gk) { g0 = *(const f32x4*)(gk + k0 + 8 * c); g1 = *(const f32x4*)(gk + k0 + 8 * c + 4); }
#pragma unroll
    for (int j = 0; j < 8; ++j) { const int n = (lane >> 3) + 8 * j; const LAS float* s = scr + (8 * c) * 65 + n;
        v4u o = {0u, 0u, 0u, 0u};
        if (c0 >= 0) { o.x = pk2(s[0 * 65] * g0.x, s[1 * 65] * g0.y); o.y = pk2(s[2 * 65] * g0.z, s[3 * 65] * g0.w); o.z = pk2(s[4 * 65] * g1.x, s[5 * 65] * g1.y); o.w = pk2(s[6 * 65] * g1.z, s[7 * 65] * g1.w); }
        *(v4u*)(WT + (size_t)(n0 + n) * dstK + k0 + 8 * c) = o; }
    asm volatile("s_waitcnt lgkmcnt(0)" ::: "memory");
}
__device__ __forceinline__ void convert_item(const Params& P, int l, int r, LAS float* scr, int lane) {
    if (r < 704) { const int nb = r >> 4, kb = r & 15, n0 = nb * 64; const int c0 = nb < 38 ? n0 : (nb < 42 ? n0 + 6 : (nb == 42 ? 2432 : -1));
        transpose_item(P.in[I_WIN] + (size_t)l * D * INW, INW, c0, nb == 42 ? 6 : 64, P.in[I_NMIX] + l * D, kb * 64, (bf16*)(P.ws + WS_WIN) + (size_t)l * NIN * D, D, n0, scr, lane); }
    else if (r < 960) { r -= 704; const int nb = r >> 4, kb = r & 15;
        transpose_item(P.in[I_WOUT] + (size_t)l * D * D, D, nb * 64, 64, nullptr, kb * 64, (bf16*)(P.ws + WS_WOUT) + (size_t)l * D * D, D, nb * 64, scr, lane); }
    else if (r < 2368) { r -= 960; const int nb = r >> 4, kb = r & 15, n0 = nb * 64, pn = n0 >> 8, rr = n0 & 255; const int c0 = rr < 128 ? 128 * pn + rr : FF + 128 * pn + (rr - 128);
        transpose_item(P.in[I_WGU] + (size_t)l * D * NGU, NGU, c0, 64, P.in[I_NFFN] + l * D, kb * 64, (bf16*)(P.ws + WS_WGU) + (size_t)l * NGU * D, D, n0, scr, lane); }
    else { r -= 2368; const int nb = r / 44, kb = r % 44;
        transpose_item(P.in[I_WD] + (size_t)l * FF * D, D, nb * 64, 64, nullptr, kb * 64, (bf16*)(P.ws + WS_WD) + (size_t)l * D * FF, FF, nb * 64, scr, lane); }
}
__device__ __forceinline__ void convert_in_slack(const Params& P, LAS unsigned char* lds, int l, int it0, int it1, int nwg, int bid, int G, int wid, int lane) {
    const int first_light = nwg % G, n_parts = first_light ? G - first_light : G, part = first_light ? bid - first_light : bid;
    if (part < 0) return;
    LAS float* scr = (LAS float*)lds + wid * (64 * 65);
    for (int it = it0 + part * 8 + wid; it < it1; it += n_parts * 8) convert_item(P, l, it, scr, lane);
}
__device__ __forceinline__ void phase_prologue(const Params& P, LAS unsigned char* lds, int bid, int G, int tid, int wid, int lane) {
    LAS float* scr = (LAS float*)lds + wid * (64 * 65);
    const int gw = bid * 8 + wid, nw = G * 8;
    for (int it = gw; it < 3072; it += nw) convert_item(P, 0, it, scr, lane);
    const int gt = bid * 512 + tid, nt = G * 512;
    { bf16* XB = (bf16*)(P.ws + WS_XB); float* RS = (float*)(P.ws + WS_RS);
      for (int row = bid * 8 + wid; row < T; row += G * 8) {
          const float* xr = P.in[I_X] + (size_t)row * D + 4 * lane; float s = 0.f;
          v2u* o8 = (v2u*)(XB + (size_t)row * D + 4 * lane);
#pragma unroll
          for (int j = 0; j < 4; ++j) { const f32x4 v = *(const f32x4*)(xr + 256 * j); s += (v.x * v.x + v.y * v.y) + (v.z * v.z + v.w * v.w); v2u o; o.x = pk2(v.x, v.y); o.y = pk2(v.z, v.w); o8[64 * j] = o; }
          s = wave_sum(s);
          if (lane < 16) RS[(size_t)row * 16 + lane] = lane == 0 ? s : 0.f;
      } }
    bf16* pwt = (bf16*)(P.ws + WS_PWT);
    for (int i = gt; i < DEPTH * 4 * 64 * 64; i += nt) { const int lg = i >> 12, d = (i >> 6) & 63, c = i & 63; pwt[i] = (bf16)f2bf(P.in[I_POOLW][(lg * 64 + c) * 64 + d]); }
}

__device__ __forceinline__ void phase_norm(const Params& P, int l, int mode, int bid, int G, int wid, int lane) {
    const bf16* XB = (const bf16*)(P.ws + WS_XB); const float* g = P.in[I_NFIN];
    f32x4 gv[4];
#pragma unroll
    for (int j = 0; j < 4; ++j) gv[j] = *(const f32x4*)(g + 4 * lane + 256 * j);
    for (int row = bid * 8 + wid; row < T; row += G * 8) {
        const v2u* xr = (const v2u*)(XB + (size_t)row * D + 4 * lane);
        f32x4 v[4]; float s = 0.f;
#pragma unroll
        for (int j = 0; j < 4; ++j) { const v2u q = xr[64 * j]; v[j] = (f32x4){bf2f(q.x & 0xffff), bf2f(q.x >> 16), bf2f(q.y & 0xffff), bf2f(q.y >> 16)}; s += (v[j].x * v[j].x + v[j].y * v[j].y) + (v[j].z * v[j].z + v[j].w * v[j].w); }
        const float rstd = rsqrtf(wave_sum(s) * (1.f / D) + EPS);
#pragma unroll
        for (int j = 0; j < 4; ++j) *(f32x4*)(P.out + (size_t)row * D + 4 * lane + 256 * j) = (v[j] * rstd) * gv[j];
    }
}
typedef float f32x16 __attribute__((ext_vector_type(16)));
typedef short s16x8 __attribute__((ext_vector_type(8)));
typedef short s16x4 __attribute__((ext_vector_type(4)));
typedef short v4i16_t __attribute__((ext_vector_type(4)));
#define MFMA32(a, b, c) __builtin_amdgcn_mfma_f32_32x32x16_bf16((a), (b), (c), 0, 0, 0)
__device__ __forceinline__ s16x4 lds_tr(LAS const unsigned char* p) { return __builtin_bit_cast(s16x4, __builtin_amdgcn_ds_read_tr16_b64_v4i16((LAS v4i16_t*)p)); }
__device__ __forceinline__ float xhalf_sum(float v) { float a = v, b = v; asm volatile("s_nop 1\n\tv_permlane32_swap_b32 %0, %1" : "+v"(a), "+v"(b)); return a + b; }
__device__ __forceinline__ float xhalf_max(float v) { float a = v, b = v; asm volatile("s_nop 1\n\tv_permlane32_swap_b32 %0, %1" : "+v"(a), "+v"(b)); return fmaxf(a, b); }
typedef float f32x2_t __attribute__((ext_vector_type(2)));
typedef __bf16 bf16x2_t __attribute__((ext_vector_type(2)));
__device__ __forceinline__ unsigned cvtpk(float lo, float hi) { const f32x2_t v = {lo, hi}; const bf16x2_t b = __builtin_convertvector(v, bf16x2_t); return __builtin_bit_cast(unsigned, b); }
constexpr int AT_KS = 144;
constexpr int AT_BLK = 256 * AT_KS;
constexpr int AT_K0 = 0, AT_V0 = AT_BLK, AT_KM = 2 * AT_BLK, AT_PART = AT_KM + 8 * 64 * 4;
__device__ __forceinline__ void attn_unit(const Params& P, int b, int h, int blk, LAS unsigned char* lds, int tid, int wid, int lane) {
    const bf16* U = (const bf16*)(P.ws + WS_U); bf16* MIX = (bf16*)(P.ws + WS_H);
    const int r = lane & 31, hh = lane >> 5;
    const size_t row0 = (size_t)b * SEQ;
    LAS float* KM = (LAS float*)(lds + AT_KM);
    const int ldrow = tid >> 3, ldch = tid & 7;
    const bf16* kvbase = U + (row0 + ldrow) * NIN + UK + h * 64 + ldch * 8;
    const int ldoff = ldrow * AT_KS + ldch * 16;
    auto blk_key0 = [&](int i) { return i == 0 ? blk * 256 : (i - 1) * 256; };
    v4u kreg[4], vreg[4];
#define AT_LOAD(i) do { const bf16* p_ = kvbase + (size_t)blk_key0(i) * NIN; _Pragma("unroll") for (int j_ = 0; j_ < 4; ++j_) { kreg[j_] = *(const v4u*)(p_ + (size_t)(64 * j_) * NIN); vreg[j_] = *(const v4u*)(p_ + (size_t)(64 * j_) * NIN + 384); } } while (0)
#define AT_STORE() do { _Pragma("unroll") for (int j_ = 0; j_ < 4; ++j_) { *(LAS v4u*)(lds + AT_K0 + 64 * j_ * AT_KS + ldoff) = kreg[j_]; *(LAS v4u*)(lds + AT_V0 + 64 * j_ * AT_KS + ldoff) = vreg[j_]; } } while (0)
    AT_LOAD(0);
    __syncthreads();
    if (blk >= 4) {
        LAS float* part = (LAS float*)(lds + AT_PART);
        const int c8 = tid & 7, rg = tid >> 3;
        const bf16* kb = U + (row0 + rg * 4) * NIN + UK + h * 64 + c8 * 8;
#pragma unroll
        for (int ps = 0; ps < 2; ++ps) {
            v4u kq[4][4];
#pragma unroll
            for (int jj = 0; jj < 4; ++jj) { const int j = 4 * ps + jj;
#pragma unroll
                for (int i = 0; i < 4; ++i) { kq[jj][i] = (v4u){0u, 0u, 0u, 0u}; if (j < blk) kq[jj][i] = *(const v4u*)(kb + (size_t)(j * 256 + i) * NIN); } }
#pragma unroll
            for (int jj = 0; jj < 4; ++jj) { const int j = 4 * ps + jj;
                if (j < 7) {
                    float sm[8];
#pragma unroll
                    for (int e = 0; e < 8; ++e) sm[e] = 0.f;
#pragma unroll
                    for (int i = 0; i < 4; ++i) { const v4u q = kq[jj][i];
                        sm[0] += bf2f(q.x & 0xffff); sm[1] += bf2f(q.x >> 16); sm[2] += bf2f(q.y & 0xffff); sm[3] += bf2f(q.y >> 16);
                        sm[4] += bf2f(q.z & 0xffff); sm[5] += bf2f(q.z >> 16); sm[6] += bf2f(q.w & 0xffff); sm[7] += bf2f(q.w >> 16); }
#pragma unroll
                    for (int e = 0; e < 8; ++e) {
                        float v = sm[e];
                        v += SWZ_XOR(v, 8); v += SWZ_XOR(v, 16); v = xhalf_sum(v);
                        sm[e] = v; }
                    if (lane < 8 && j < blk) { *(LAS f32x4*)(part + (j * 8 + wid) * 64 + c8 * 8) = (f32x4){sm[0], sm[1], sm[2], sm[3]}; *(LAS f32x4*)(part + (j * 8 + wid) * 64 + c8 * 8 + 4) = (f32x4){sm[4], sm[5], sm[6], sm[7]}; }
                } }
        }
        __syncthreads();
        if (tid < blk * 64) { const int j = tid >> 6, d = tid & 63; float sacc = 0.f;
#pragma unroll
            for (int k = 0; k < 8; ++k) sacc += part[(j * 8 + k) * 64 + d];
            KM[j * 64 + d] = sacc * (1.f / 256.f); }
    }
    AT_STORE();
    __syncthreads();
    const int qrow = blk * 256 + wid * 32 + r;
    s16x8 qf[4];
    { const v4u* qp = (const v4u*)(U + (row0 + qrow) * NIN + UQ + h * 64 + 8 * hh);
#pragma unroll
      for (int s = 0; s < 4; ++s) qf[s] = __builtin_bit_cast(s16x8, qp[2 * s]); }
    unsigned sel = (1u << blk) - 1u;
    if (blk >= 4) {
        float gate[8];
#pragma unroll
        for (int j = 0; j < 8; ++j) gate[j] = -3e38f;
#pragma unroll
        for (int j = 0; j < 7; ++j) if (j < blk) { float g = 0.f;
#pragma unroll
            for (int s = 0; s < 4; ++s) {
                const f32x4 k0 = *(LAS const f32x4*)(KM + j * 64 + 16 * s + 8 * hh), k1 = *(LAS const f32x4*)(KM + j * 64 + 16 * s + 8 * hh + 4);
                g += bf2f((unsigned short)qf[s][0]) * k0.x + bf2f((unsigned short)qf[s][1]) * k0.y + bf2f((unsigned short)qf[s][2]) * k0.z + bf2f((unsigned short)qf[s][3]) * k0.w
                   + bf2f((unsigned short)qf[s][4]) * k1.x + bf2f((unsigned short)qf[s][5]) * k1.y + bf2f((unsigned short)qf[s][6]) * k1.z + bf2f((unsigned short)qf[s][7]) * k1.w; }
            gate[j] = xhalf_sum(g); }
        sel = 0u;
#pragma unroll
        for (int t = 0; t < 3; ++t) { int best = 0; float bv = -3.4e38f;
#pragma unroll
            for (int j = 0; j < 8; ++j) { const bool ok = !((sel >> j) & 1u) && gate[j] > bv; bv = ok ? gate[j] : bv; best = ok ? j : best; }
            sel |= 1u << best; }
    }
    f32x16 o0, o1;
#pragma unroll
    for (int i = 0; i < 16; ++i) { o0[i] = 0.f; o1[i] = 0.f; }
    float m = -1e30f, lsum = 0.f;
    const float SC = 0.125f * 1.44269504088896f;
    const int i16 = lane & 15, b16 = (lane >> 4) & 1;
    const int troff = (i16 >> 2) * AT_KS + (16 * b16) * 2 + 8 * (i16 & 3);
    const int qpos = 32 * wid + r;
    for (int bi = 0; bi <= blk; ++bi) {
        if (bi < blk) AT_LOAD(bi + 1);
        const int jpast = bi - 1;
        const bool lane_on = (bi == 0) || ((sel >> jpast) & 1u);
        const bool need_blk = (bi == 0) || (__builtin_amdgcn_ballot_w64(lane_on) != 0ull);
        if (need_blk) {
            const int nt = bi == 0 ? ((32 * wid + 31) >> 6) + 1 : 4;
#define AT_QK(dA, dB, ktile) do { LAS const unsigned char* Kt_ = lds + AT_K0 + (ktile) * 64 * AT_KS; \
                _Pragma("unroll") for (int e_ = 0; e_ < 16; ++e_) { dA[e_] = 0.f; dB[e_] = 0.f; } \
                _Pragma("unroll") for (int s_ = 0; s_ < 4; ++s_) { \
                    const s16x8 ka_ = *(LAS const s16x8*)(Kt_ + r * AT_KS + 32 * s_ + 16 * hh); \
                    const s16x8 kb_ = *(LAS const s16x8*)(Kt_ + (32 + r) * AT_KS + 32 * s_ + 16 * hh); \
                    dA = MFMA32(ka_, qf[s_], dA); dB = MFMA32(kb_, qf[s_], dB); } } while (0)
            f32x16 sA, sB, nA, nB;
            AT_QK(sA, sB, 0);
            for (int kt = 0; kt < nt; ++kt) {
                LAS const unsigned char* Vt = lds + AT_V0 + kt * 64 * AT_KS;
                if (kt + 1 < nt) AT_QK(nA, nB, kt + 1);
                if (bi == 0 && kt == nt - 1) {
#pragma unroll
                    for (int e = 0; e < 16; ++e) { const int kr = (e & 3) + 8 * (e >> 2) + 4 * hh;
                        if (64 * kt + kr > qpos) sA[e] = -3e38f; if (64 * kt + 32 + kr > qpos) sB[e] = -3e38f; }
                }
                float mx = fmaxf(sA[0], sB[0]);
#pragma unroll
                for (int e = 1; e < 16; ++e) mx = fmaxf(mx, fmaxf(sA[e], sB[e]));
                mx = lane_on ? mx * SC : -1e30f;
                mx = xhalf_max(mx);
                if (__builtin_amdgcn_ballot_w64(mx > m + 6.0f) != 0ull) {
                    const float mn = fmaxf(m, mx);
                    const float alpha = __builtin_amdgcn_exp2f(m - mn);
                    lsum *= alpha;
#pragma unroll
                    for (int e = 0; e < 16; ++e) { o0[e] *= alpha; o1[e] *= alpha; }
                    m = mn;
                }
                const float nb = lane_on ? -m : -3e38f;
                float ps = 0.f;
#pragma unroll
                for (int e = 0; e < 16; ++e) { sA[e] = __builtin_amdgcn_exp2f(__builtin_fmaf(sA[e], SC, nb)); sB[e] = __builtin_amdgcn_exp2f(__builtin_fmaf(sB[e], SC, nb)); ps += sA[e] + sB[e]; }
                lsum += ps;
#pragma unroll
                for (int sub = 0; sub < 2; ++sub)
#pragma unroll
                    for (int s2 = 0; s2 < 2; ++s2) {
                        s16x8 pb;
#pragma unroll
                        for (int jj = 0; jj < 8; jj += 2) { const float x0 = sub ? sB[8 * s2 + jj] : sA[8 * s2 + jj], x1 = sub ? sB[8 * s2 + jj + 1] : sA[8 * s2 + jj + 1];
                            const unsigned w = cvtpk(x0, x1); pb[jj] = (short)(w & 0xffff); pb[jj + 1] = (short)(w >> 16); }
                        const int klo = 32 * sub + 16 * s2 + 4 * hh;
#pragma unroll
                        for (int db = 0; db < 2; ++db) {
                            const s16x4 lo = lds_tr(Vt + klo * AT_KS + troff + 64 * db), hi = lds_tr(Vt + (klo + 8) * AT_KS + troff + 64 * db);
                            const s16x8 va = __builtin_shufflevector(lo, hi, 0, 1, 2, 3, 4, 5, 6, 7);
                            if (db == 0) o0 = MFMA32(va, pb, o0); else o1 = MFMA32(va, pb, o1);
                        }
                    }
                sA = nA; sB = nB;
            }
#undef AT_QK
        }
        if (bi < blk) { __syncthreads(); AT_STORE(); __syncthreads(); }
    }
#undef AT_LOAD
#undef AT_STORE
    const float inv = 1.f / xhalf_sum(lsum);
    bf16* orow = MIX + (row0 + qrow) * D + h * 64 + 4 * hh;
#pragma unroll
    for (int g = 0; g < 4; ++g) {
        v2u w0, w1;
        w0.x = pk2(o0[4 * g] * inv, o0[4 * g + 1] * inv); w0.y = pk2(o0[4 * g + 2] * inv, o0[4 * g + 3] * inv);
        w1.x = pk2(o1[4 * g] * inv, o1[4 * g + 1] * inv); w1.y = pk2(o1[4 * g + 2] * inv, o1[4 * g + 3] * inv);
        *(v2u*)(orow + 8 * g) = w0; *(v2u*)(orow + 32 + 8 * g) = w1;
    }
}
constexpr int SX_S = 400, SB_S = 272;
constexpr int S_X = 0, S_B = 51200, S_C = 86016, S_PREV = 120832, S_DT = 138240, S_AC = S_DT + 1536, S_DA = S_AC + 1536;
__device__ __forceinline__ int crow16(int i, int hh) { return (i & 3) + 8 * (i >> 2) + 4 * hh; }
template <bool PHASE_A>
__device__ __forceinline__ void ssd_stage(const Params& P, int l, int b, int c, int g, LAS unsigned char* lds, int tid) {
    const bf16* U = (const bf16*)(P.ws + WS_U); const float* DT = (const float*)(P.ws + WS_DT);
    const float* alog = P.in[I_ALOG]; const float* convw = P.in[I_CONVW]; const float* convb = P.in[I_CONVB];
    asm volatile("" : "+s"(alog), "+s"(convw), "+s"(convb));
    const size_t row0 = (size_t)b * SEQ + c * 128;
    LAS float* dts = (LAS float*)(lds + S_DT); LAS float* acs = (LAS float*)(lds + S_AC); LAS float* das = (LAS float*)(lds + S_DA);
    const int cc = tid & 63, tg = tid >> 6;
    const bool conv_on = cc < (PHASE_A ? 40 : 56);
    const int ch = cc < 24 ? g * 192 + cc * 8 : (cc < 40 ? 384 + g * 128 + (cc - 24) * 8 : 640 + g * 128 + (cc - 40) * 8);
    v4u rows[19];
    if (conv_on) {
        const bf16* src = U + (row0 + tg * 16) * NIN + UXS + ch;
        const bool has_prev = !(c == 0 && tg == 0);
#pragma unroll
        for (int k = 0; k < 3; ++k) { rows[k] = (v4u){0u, 0u, 0u, 0u}; if (has_prev) rows[k] = *(const v4u*)(src - (size_t)(3 - k) * NIN); }
#pragma unroll
        for (int t = 0; t < 16; ++t) rows[3 + t] = *(const v4u*)(src + (size_t)t * NIN);
    }
    if (tid < 384) { const int hh3 = tid >> 7, li = tid & 127, h = 3 * g + hh3; const float dt = DT[(row0 + li) * 8 + h]; dts[tid] = dt; das[tid] = dt * -__expf(alog[l * 6 + h]); }
    __syncthreads();
    if (tid < 384) {
        const int hh3 = tid >> 7, li = tid & 127; float s = 0.f;
#pragma unroll
        for (int q = 0; q < 32; ++q) { const f32x4 v = *(LAS const f32x4*)(das + hh3 * 128 + 4 * q);
            s += (4 * q <= li ? v.x : 0.f); s += (4 * q + 1 <= li ? v.y : 0.f); s += (4 * q + 2 <= li ? v.z : 0.f); s += (4 * q + 3 <= li ? v.w : 0.f); }
        acs[tid] = s; }
    __syncthreads();
    if (conv_on) {
        const float* cw = convw + (size_t)l * 4 * XBC + ch; const float* cb = convb + (size_t)l * XBC + ch;
        float w[4][8], bias[8];
#pragma unroll
        for (int k = 0; k < 4; ++k) { const f32x4 a = *(const f32x4*)(cw + k * XBC), d = *(const f32x4*)(cw + k * XBC + 4);
            w[k][0] = a.x; w[k][1] = a.y; w[k][2] = a.z; w[k][3] = a.w; w[k][4] = d.x; w[k][5] = d.y; w[k][6] = d.z; w[k][7] = d.w; }
        { const f32x4 a = *(const f32x4*)cb, d = *(const f32x4*)(cb + 4); bias[0] = a.x; bias[1] = a.y; bias[2] = a.z; bias[3] = a.w; bias[4] = d.x; bias[5] = d.y; bias[6] = d.z; bias[7] = d.w; }
        const int hh3 = cc >> 3;
        const float ac_end = acs[(cc < 24 ? hh3 : 0) * 128 + 127];
        LAS unsigned char* dst = lds + (cc < 24 ? S_X + cc * 16 : (cc < 40 ? S_B + (cc - 24) * 16 : S_C + (cc - 40) * 16));
        const int dstride = cc < 24 ? SX_S : SB_S;
#define UNPK(q, j) ((j) == 0 ? bf2f((q).x & 0xffff) : (j) == 1 ? bf2f((q).x >> 16) : (j) == 2 ? bf2f((q).y & 0xffff) : (j) == 3 ? bf2f((q).y >> 16) : (j) == 4 ? bf2f((q).z & 0xffff) : (j) == 5 ? bf2f((q).z >> 16) : (j) == 6 ? bf2f((q).w & 0xffff) : bf2f((q).w >> 16))
#pragma unroll
        for (int t = 0; t < 16; ++t) {
            const int tok = tg * 16 + t;
            float sc = 1.f;
            if (PHASE_A && cc < 24) sc = dts[hh3 * 128 + tok] * __expf(ac_end - acs[hh3 * 128 + tok]);
            float o[8];
#pragma unroll
            for (int j = 0; j < 8; ++j) { const float a = bias[j] + w[0][j] * UNPK(rows[t], j) + w[1][j] * UNPK(rows[t + 1], j) + w[2][j] * UNPK(rows[t + 2], j) + w[3][j] * UNPK(rows[t + 3], j); o[j] = silu(a) * sc; }
            v4u pk; pk.x = pk2(o[0], o[1]); pk.y = pk2(o[2], o[3]); pk.z = pk2(o[4], o[5]); pk.w = pk2(o[6], o[7]);
            *(LAS v4u*)(dst + tok * dstride) = pk;
        }
#undef UNPK
    }
    __syncthreads();
}
__device__ __forceinline__ void ssd_unit_a(const Params& P, int l, int b, int c, int g, LAS unsigned char* lds, int tid, int wid, int lane) {
    __syncthreads();
    ssd_stage<true>(P, l, b, c, g, lds, tid);
    LAS float* acs = (LAS float*)(lds + S_AC);
    if (tid < 3) ((float*)(P.ws + WS_CD))[(b * 16 + c) * 6 + 3 * g + tid] = __expf(acs[tid * 128 + 127]);
    const int r = lane & 31, hh = lane >> 5, nt = wid & 3, pt = wid >> 2, i16 = lane & 15, b16 = (lane >> 4) & 1;
    const int troffB = (i16 >> 2) * SB_S + (32 * nt + 16 * b16) * 2 + 8 * (i16 & 3);
    s16x8 bfr[8];
#pragma unroll
    for (int s = 0; s < 8; ++s) { const int k0 = 16 * s + 8 * hh;
        const s16x4 lo = lds_tr(lds + S_B + k0 * SB_S + troffB), hi = lds_tr(lds + S_B + (k0 + 4) * SB_S + troffB);
        bfr[s] = __builtin_shufflevector(lo, hi, 0, 1, 2, 3, 4, 5, 6, 7); }
    float* ST = (float*)(P.ws + WS_ST);
#pragma unroll
    for (int hh3 = 0; hh3 < 3; ++hh3) {
        const int troffX = (i16 >> 2) * SX_S + (hh3 * 64 + 32 * pt + 16 * b16) * 2 + 8 * (i16 & 3);
        f32x16 acc;
#pragma unroll
        for (int e = 0; e < 16; ++e) acc[e] = 0.f;
#pragma unroll
        for (int s = 0; s < 8; ++s) { const int k0 = 16 * s + 8 * hh;
            const s16x4 lo = lds_tr(lds + S_X + k0 * SX_S + troffX), hi = lds_tr(lds + S_X + (k0 + 4) * SX_S + troffX);
            const s16x8 xa = __builtin_shufflevector(lo, hi, 0, 1, 2, 3, 4, 5, 6, 7);
            acc = MFMA32(xa, bfr[s], acc); }
        float* S = ST + ((size_t)((b * 16 + c) * 6 + 3 * g + hh3)) * 8192;
#pragma unroll
        for (int e = 0; e < 16; ++e) S[(32 * pt + crow16(e, hh)) * 128 + 32 * nt + r] = acc[e];
    }
}
__device__ __forceinline__ void ssd_scan(const Params& P, int bid, int G, int tid) {
    const float* ST = (const float*)(P.ws + WS_ST); const float* CD = (const float*)(P.ws + WS_CD); bf16* PV = (bf16*)(P.ws + WS_PREV);
    for (int it = bid * 512 + tid; it < BATCH * 6 * 2048; it += G * 512) {
        const int bh = it >> 11, e4 = (it & 2047) * 4, b = bh / 6, h = bh % 6;
        f32x4 sv[15]; float dv[15];
#pragma unroll
        for (int c = 0; c < 15; ++c) { sv[c] = *(const f32x4*)(ST + ((size_t)((b * 16 + c) * 6 + h)) * 8192 + e4); dv[c] = CD[(b * 16 + c) * 6 + h]; }
        f32x4 acc = {0.f, 0.f, 0.f, 0.f};
#pragma unroll
        for (int c = 0; c < 16; ++c) {
            v2u w; w.x = pk2(acc.x, acc.y); w.y = pk2(acc.z, acc.w);
            *(v2u*)(PV + ((size_t)((b * 16 + c) * 6 + h)) * 8192 + e4) = w;
            if (c < 15) acc = acc * dv[c] + sv[c];
        }
    }
}
__device__ __forceinline__ void ssd_unit_b(const Params& P, int l, int b, int c, int g, LAS unsigned char* lds, int tid, int wid, int lane) {
    const float* dskip = P.in[I_DSKIP]; const float* ssdn = P.in[I_SSDN];
    asm volatile("" : "+s"(dskip), "+s"(ssdn));
    v4u pq[3][2];
    { const bf16* PV0 = (const bf16*)(P.ws + WS_PREV);
#pragma unroll
      for (int hh3 = 0; hh3 < 3; ++hh3) { const v4u* src = (const v4u*)(PV0 + ((size_t)((b * 16 + c) * 6 + 3 * g + hh3)) * 8192) + tid; pq[hh3][0] = src[0]; pq[hh3][1] = src[512]; } }
    __syncthreads();
    ssd_stage<false>(P, l, b, c, g, lds, tid);
    const bf16* U = (const bf16*)(P.ws + WS_U); bf16* MIX = (bf16*)(P.ws + WS_H);
    LAS float* dts = (LAS float*)(lds + S_DT); LAS float* acs = (LAS float*)(lds + S_AC); LAS float* ssb = (LAS float*)(lds + S_DA);
    const size_t row0 = (size_t)b * SEQ + c * 128;
    const int r = lane & 31, hh = lane >> 5, lt = wid & 3, pb = wid >> 2, i16 = lane & 15, b16 = (lane >> 4) & 1;
#define CF(s) (*(LAS const s16x8*)(lds + S_C + (32 * lt + r) * SB_S + (16 * (s) + 8 * hh) * 2))
    f32x16 Y[3];
#pragma unroll
    for (int hh3 = 0; hh3 < 3; ++hh3) {
        const int h = 3 * g + hh3;
        __syncthreads();
        *(LAS v4u*)(lds + S_PREV + (tid >> 4) * SB_S + (tid & 15) * 16) = pq[hh3][0]; *(LAS v4u*)(lds + S_PREV + (32 + (tid >> 4)) * SB_S + (tid & 15) * 16) = pq[hh3][1];
        __syncthreads();
        f32x16 acc;
#pragma unroll
        for (int e = 0; e < 16; ++e) acc[e] = 0.f;
#pragma unroll
        for (int s = 0; s < 8; ++s) { const s16x8 a = *(LAS const s16x8*)(lds + S_PREV + (32 * pb + r) * SB_S + (16 * s + 8 * hh) * 2); acc = MFMA32(a, CF(s), acc); }
        const float el = __expf(acs[hh3 * 128 + 32 * lt + r]);
#pragma unroll
        for (int e = 0; e < 16; ++e) Y[hh3][e] = acc[e] * el;
    }
    for (int st = 0; st <= lt; ++st) {
        f32x16 Gt;
#pragma unroll
        for (int e = 0; e < 16; ++e) Gt[e] = 0.f;
#pragma unroll
        for (int s = 0; s < 8; ++s) { const s16x8 a = *(LAS const s16x8*)(lds + S_B + (32 * st + r) * SB_S + (16 * s + 8 * hh) * 2); Gt = MFMA32(a, CF(s), Gt); }
#pragma unroll
        for (int hh3 = 0; hh3 < 3; ++hh3) {
            const float acl = acs[hh3 * 128 + 32 * lt + r];
            const int troffX = (i16 >> 2) * SX_S + (hh3 * 64 + 32 * pb + 16 * b16) * 2 + 8 * (i16 & 3);
#pragma unroll
            for (int s2 = 0; s2 < 2; ++s2) {
                s16x8 pbk;
#pragma unroll
                for (int jj = 0; jj < 8; jj += 2) {
                    float mv[2];
#pragma unroll
                    for (int t = 0; t < 2; ++t) { const int e = 8 * s2 + jj + t, kr = crow16(e, hh), stok = 32 * st + kr;
                        const bool valid = (st < lt) || (kr <= r);
                        const float v = Gt[e] * __expf(fminf(acl - acs[hh3 * 128 + stok], 0.f)) * dts[hh3 * 128 + stok];
                        mv[t] = valid ? v : 0.f; }
                    const unsigned w = pk2(mv[0], mv[1]); pbk[jj] = (short)(w & 0xffff); pbk[jj + 1] = (short)(w >> 16); }
                const int klo = 32 * st + 16 * s2 + 4 * hh;
                const s16x4 lo = lds_tr(lds + S_X + klo * SX_S + troffX), hi = lds_tr(lds + S_X + (klo + 8) * SX_S + troffX);
                const s16x8 xa = __builtin_shufflevector(lo, hi, 0, 1, 2, 3, 4, 5, 6, 7);
                Y[hh3] = MFMA32(xa, pbk, Y[hh3]);
                __builtin_amdgcn_sched_barrier(0);
            }
        }
    }
    float ssq = 0.f;
    const size_t grow = row0 + 32 * lt + r;
#pragma unroll
    for (int hh3 = 0; hh3 < 3; ++hh3) { const int h = 3 * g + hh3; const float Dk = dskip[l * 6 + h];
#pragma unroll
        for (int q4 = 0; q4 < 4; ++q4) { const int p0 = 32 * pb + 8 * q4 + 4 * hh;
            const v2u xr = *(LAS const v2u*)(lds + S_X + (32 * lt + r) * SX_S + (hh3 * 64 + p0) * 2);
            const v2u zr = *(const v2u*)(U + grow * NIN + UZ + h * 64 + p0);
            const f32x4 xv = {bf2f(xr.x & 0xffff), bf2f(xr.x >> 16), bf2f(xr.y & 0xffff), bf2f(xr.y >> 16)};
            const f32x4 zv = {bf2f(zr.x & 0xffff), bf2f(zr.x >> 16), bf2f(zr.y & 0xffff), bf2f(zr.y >> 16)};
#pragma unroll
            for (int e = 0; e < 4; ++e) { const float y = (Y[hh3][4 * q4 + e] + Dk * xv[e]) * silu(zv[e]); Y[hh3][4 * q4 + e] = y; ssq += y * y; } } }
    ssq = xhalf_sum(ssq);
    if (hh == 0) ssb[pb * 128 + 32 * lt + r] = ssq;
    __syncthreads();
    const float rs = rsqrtf((ssb[32 * lt + r] + ssb[128 + 32 * lt + r]) * (1.f / 192.f) + EPS);
#pragma unroll
    for (int hh3 = 0; hh3 < 3; ++hh3)
#pragma unroll
        for (int q4 = 0; q4 < 4; ++q4) { const int p0 = 32 * pb + 8 * q4 + 4 * hh, chn = g * 192 + hh3 * 64 + p0;
            const f32x4 nw = *(const f32x4*)(ssdn + l * 384 + chn);
            v2u w; w.x = pk2(Y[hh3][4 * q4] * rs * nw.x, Y[hh3][4 * q4 + 1] * rs * nw.y); w.y = pk2(Y[hh3][4 * q4 + 2] * rs * nw.z, Y[hh3][4 * q4 + 3] * rs * nw.w);
            *(v2u*)(MIX + grow * D + 384 + chn) = w; }
}
constexpr int PL_S = 528;
__device__ __forceinline__ void pool_unit(const Params& P, int l, int unit, LAS unsigned char* lds, int tid, int wid, int lane) {
    const bf16* U = (const bf16*)(P.ws + WS_U); bf16* MIX = (bf16*)(P.ws + WS_H);
    const bf16* pwt = (const bf16*)(P.ws + WS_PWT) + (size_t)l * 4 * 4096;
    const float* pscale = P.in[I_POOLS]; asm volatile("" : "+s"(pscale));
    const size_t row0 = (size_t)unit * 64;
    __syncthreads();
    { const int cc = tid & 31, ts = tid >> 5, g = cc >> 3, W = 2 << g;
      const bf16* src = U + row0 * NIN + UP + cc * 8;
      f32x4 s0 = {0.f, 0.f, 0.f, 0.f}, s1 = s0;
      const int t0 = ts * 4, pos0 = (int)((row0 + t0) & (SEQ - 1));
#pragma unroll
      for (int i = 1; i < 16; ++i) if (i < W && i <= pos0) { const v4u q = *(const v4u*)(src + (ptrdiff_t)(t0 - i) * NIN);
          s0.x += bf2f(q.x & 0xffff); s0.y += bf2f(q.x >> 16); s0.z += bf2f(q.y & 0xffff); s0.w += bf2f(q.y >> 16);
          s1.x += bf2f(q.z & 0xffff); s1.y += bf2f(q.z >> 16); s1.z += bf2f(q.w & 0xffff); s1.w += bf2f(q.w >> 16); }
#pragma unroll
      for (int t = 0; t < 4; ++t) {
          const int tok = t0 + t, pos = pos0 + t;
          const v4u q = *(const v4u*)(src + (size_t)tok * NIN);
          const f32x4 x0 = {bf2f(q.x & 0xffff), bf2f(q.x >> 16), bf2f(q.y & 0xffff), bf2f(q.y >> 16)}, x1 = {bf2f(q.z & 0xffff), bf2f(q.z >> 16), bf2f(q.w & 0xffff), bf2f(q.w >> 16)};
          s0 += x0; s1 += x1;
          if (t > 0 && pos - W >= 0) { const v4u o = *(const v4u*)(src + (ptrdiff_t)(tok - W) * NIN);
              const f32x4 y0 = {bf2f(o.x & 0xffff), bf2f(o.x >> 16), bf2f(o.y & 0xffff), bf2f(o.y >> 16)}, y1 = {bf2f(o.z & 0xffff), bf2f(o.z >> 16), bf2f(o.w & 0xffff), bf2f(o.w >> 16)};
              s0 -= y0; s1 -= y1; }
          const float inv = 1.f / (float)(pos + 1 < W ? pos + 1 : W);
          const f32x4 d0 = s0 * inv - x0, d1 = s1 * inv - x1;
          v4u pk; pk.x = pk2(d0.x, d0.y); pk.y = pk2(d0.z, d0.w); pk.z = pk2(d1.x, d1.y); pk.w = pk2(d1.z, d1.w);
          *(LAS v4u*)(lds + tok * PL_S + cc * 16) = pk;
      } }
    __syncthreads();
    const int r = lane & 31, hh = lane >> 5, g = wid >> 1, dt = wid & 1;
    s16x8 wa[4];
#pragma unroll
    for (int s = 0; s < 4; ++s) wa[s] = __builtin_bit_cast(s16x8, *(const v4u*)(pwt + (size_t)g * 4096 + (32 * dt + r) * 64 + 16 * s + 8 * hh));
#pragma unroll
    for (int tt = 0; tt < 2; ++tt) {
        f32x16 acc;
#pragma unroll
        for (int e = 0; e < 16; ++e) acc[e] = 0.f;
#pragma unroll
        for (int s = 0; s < 4; ++s) { const s16x8 bq = *(LAS const s16x8*)(lds + (32 * tt + r) * PL_S + (g * 64 + 16 * s + 8 * hh) * 2); acc = MFMA32(wa[s], bq, acc); }
        bf16* orow = MIX + (row0 + 32 * tt + r) * D + 768 + g * 64 + 32 * dt + 4 * hh;
#pragma unroll
        for (int q4 = 0; q4 < 4; ++q4) { const f32x4 sc = *(const f32x4*)(pscale + l * 256 + g * 64 + 32 * dt + 4 * hh + 8 * q4);
            v2u w; w.x = pk2(acc[4 * q4] * sc.x, acc[4 * q4 + 1] * sc.y); w.y = pk2(acc[4 * q4 + 2] * sc.z, acc[4 * q4 + 3] * sc.w);
            *(v2u*)(orow + 8 * q4) = w; }
    }
}
#define XB_TMO      128
#define XB_XCNT(j)  (256  + 64 * (j))
#define XB_XSUB(j)  (1280 + 64 * (j))
#define XB_XGEN(j)  (2304 + 64 * (j))
#define XB_TOP      3328
#define XB_TOPGEN   3392
#define XCD_BAR_WORDS 3456
#define XB_SPIN_CAP (1u << 18)

__device__ __forceinline__ unsigned xb_ld(unsigned* p)              { return __hip_atomic_load(p, __ATOMIC_RELAXED, __HIP_MEMORY_SCOPE_AGENT); }
__device__ __forceinline__ unsigned xb_add(unsigned* p, unsigned v) { return __hip_atomic_fetch_add(p, v, __ATOMIC_RELAXED, __HIP_MEMORY_SCOPE_AGENT); }
__device__ __forceinline__ unsigned xb_xcc_id() { return (unsigned)__builtin_amdgcn_s_getreg((3 << 11) | 20) & 0xFu; }
#define XB_SPIN(cond, bar) do { unsigned _sp = 0; while (cond) { __builtin_amdgcn_s_sleep(1); \
    if ((++_sp & 255u) == 0u) { if (xb_ld(&(bar)[XB_TMO])) break; if (_sp > XB_SPIN_CAP) { atomicAdd(&(bar)[XB_TMO], 1u); break; } } } } while (0)

struct XcdBarrier {
    unsigned* bar; unsigned x;
    volatile LAS unsigned* st;
};

__device__ __forceinline__ XcdBarrier xcd_barrier_post(unsigned* bar, volatile LAS unsigned* st, const bool leader) {
    XcdBarrier b; b.bar = bar; b.x = xb_xcc_id(); b.st = st;
    if (leader) (void)xb_add(&bar[XB_XCNT(b.x)], 1u);
    return b;
}
__device__ __forceinline__ void xcd_barrier_complete(unsigned* bar, unsigned x, unsigned& nloc, unsigned& nx) {
    const unsigned G = gridDim.x * gridDim.y * gridDim.z;
    unsigned sum, cnt, mine, sp = 0u;
    for (;;) {
        sum = 0u; cnt = 0u; mine = 0u;
#pragma unroll
        for (unsigned j = 0; j < 16; ++j) { const unsigned c = xb_ld(&bar[XB_XCNT(j)]); sum += c; cnt += (c > 0u) ? 1u : 0u; mine = (j == x) ? c : mine; }
        if (sum == G) break;
        __builtin_amdgcn_s_sleep(1);
        if ((++sp & 255u) == 0u) { if (xb_ld(&bar[XB_TMO])) break; if (sp > XB_SPIN_CAP) { atomicAdd(&bar[XB_TMO], 1u); break; } }
    }
    nloc = mine > 0u ? mine : 1u; nx = cnt > 0u ? cnt : 1u;
}

__device__ __forceinline__ void xcd_barrier(const XcdBarrier& b, const bool leader) {
    asm volatile("s_waitcnt vmcnt(0)" ::: "memory");
    __syncthreads();
    if (leader) {
        unsigned* bar = b.bar;
        __builtin_amdgcn_s_waitcnt(0);
        unsigned nloc = b.st[0], nx = b.st[1];
        if (nloc == 0u) { xcd_barrier_complete(bar, b.x, nloc, nx); b.st[0] = nloc; b.st[1] = nx; }
        const unsigned old = xb_add(&bar[XB_XSUB(b.x)], 1u);
        const unsigned gen = old / nloc;
        if (old + 1u == (gen + 1u) * nloc) {
            __builtin_amdgcn_fence(__ATOMIC_RELEASE, "agent");
            asm volatile("s_waitcnt vmcnt(0)" ::: "memory");
            const unsigned og = xb_add(&bar[XB_TOP], 1u);
            const unsigned tg = og / nx;
            if (og + 1u == (tg + 1u) * nx) xb_add(&bar[XB_TOPGEN], 1u);
            else XB_SPIN(xb_ld(&bar[XB_TOPGEN]) == tg, bar);
            __builtin_amdgcn_fence(__ATOMIC_ACQUIRE, "agent");
            xb_add(&bar[XB_XGEN(b.x)], 1u);
            asm volatile("s_waitcnt vmcnt(0)" ::: "memory");
        } else {
            XB_SPIN(xb_ld(&bar[XB_XGEN(b.x)]) == gen, bar);
            __builtin_amdgcn_fence(__ATOMIC_ACQUIRE, "agent");
            asm volatile("s_waitcnt vmcnt(0)" ::: "memory");
        }
    }
    __syncthreads();
}
constexpr int BAR_LDS_OFF = LDS_BYTES - 16;
constexpr size_t WS_BAR = 65536;
__device__ __forceinline__ bool is_leader(int wid0) { int lane; asm volatile("v_mbcnt_lo_u32_b32 %0, -1, 0\n\tv_mbcnt_hi_u32_b32 %0, -1, %0" : "=v"(lane)); return wid0 == 0 && lane == 0; }
__device__ __forceinline__ void grid_sync(unsigned char* ws, LAS unsigned char* lds, int wid0) {
    XcdBarrier b; b.bar = (unsigned*)(ws + WS_BAR); b.x = xb_xcc_id(); b.st = (volatile LAS unsigned*)(lds + BAR_LDS_OFF);
    xcd_barrier(b, is_leader(wid0));
}
template <int PH> __device__ __forceinline__ void run_phase(const Params& P0, LAS unsigned char* lds, const int wid0) {
    Params P = P0; asm volatile("" : "+s"(P.ws), "+s"(P.out));
#pragma unroll
    for (int i = 0; i < 16; ++i) asm volatile("" : "+s"(P.in[i]));
    int lane_; asm volatile("v_mbcnt_lo_u32_b32 %0, -1, 0\n\tv_mbcnt_hi_u32_b32 %0, -1, %0" : "=v"(lane_));
    int wid_ = wid0; asm volatile("" : "+s"(wid_));
    const int tid = wid_ * 64 + lane_;
    int bid = blockIdx.x, G = gridDim.x; asm volatile("" : "+s"(bid), "+s"(G));
    const int lane = lane_, wid = wid_;
    if constexpr (PH == 0) phase_prologue(P, lds, bid, G, tid, wid, lane);
    else if constexpr (PH == N_PHASES - 1) phase_norm(P, 0, 2, bid, G, wid, lane);
    else {
        constexpr int l = (PH - 1) / NPH, s = (PH - 1) % NPH;
        float* RS = (float*)(P.ws + WS_RS);
        if constexpr (s == 0) { pg8::Gemm g{(const pg8::bf16_t*)(P.ws + WS_XB), (const pg8::bf16_t*)(P.ws + WS_WIN) + (size_t)l * NIN * D, T, NIN, D};
            pg8::StaticOrder S; S.init(T, NIN, G, bid); const int fm = pg8::stage_rstd(RS + (size_t)(2 * l) * T * 16, lds, S, tid);
            pg8::EpiStoreBf16 E{(pg8::bf16_t*)(P.ws + WS_U), NIN, RS + (size_t)(2 * l) * T * 16, (float*)(P.ws + WS_DT), P.in[I_DTB] + l * 6, (const LAS float*)(lds + pg8::RSTD_LDS_OFF), fm};
            pg8::gemm_phase<pg8::EpiStoreBf16, pg8::StaticOrder, true, true>(lds, g, S, E, tid);
            if constexpr (l + 1 < DEPTH) convert_in_slack(P, lds, l + 1, 0, 960, (T / 256) * (NIN / 256), bid, G, wid, lane); }
        else if constexpr (s == 1) {
            { unsigned* qctr = (unsigned*)(P.ws + WS_CTL) + 64 * (l + 1);
              volatile LAS unsigned* qslot = (volatile LAS unsigned*)(lds + BAR_LDS_OFF + 8);
              for (;;) {
                  __syncthreads();
                  if (tid == 0) *qslot = __hip_atomic_fetch_add(qctr, 1u, __ATOMIC_RELAXED, __HIP_MEMORY_SCOPE_AGENT);
                  __syncthreads();
                  int q = (int)*qslot;
                  if (q >= 384 * (1 + (DUP_MIX & 1)) + 240 + 256) break;
                  int t2 = tid; asm volatile("" : "+v"(t2));
                  if (q < 384 * (1 + (DUP_MIX & 1))) { const int u = q % 384; attn_unit(P, (u % 48) / 6, (u % 48) % 6, 7 - u / 48, lds, t2, wid, t2 & 63); }
                  else { q -= 384 * (1 + (DUP_MIX & 1));
                      if (q < 240) { const int bb = q / 30, rem = q % 30; ssd_unit_a(P, l, bb, rem >> 1, rem & 1, lds, t2, wid, t2 & 63); }
                      else pool_unit(P, l, q - 240, lds, t2, wid, t2 & 63); }
              } }
        }
        else if constexpr (s == 2) ssd_scan(P, bid, G, tid);
        else if constexpr (s == 3) { for (int u = bid; u < 256; u += G) { int t2 = tid; asm volatile("" : "+v"(t2)); ssd_unit_b(P, l, u >> 5, (u >> 1) & 15, u & 1, lds, t2, wid, t2 & 63); } }
        else if constexpr (s == 4) { pg8::Gemm g{(const pg8::bf16_t*)(P.ws + WS_H), (const pg8::bf16_t*)(P.ws + WS_WOUT) + (size_t)l * D * D, T, D, D};
            pg8::StaticOrder S; S.init(T, D, G, bid); pg8::EpiResidual<l == 0> E{P.in[I_X], D, (pg8::bf16_t*)(P.ws + WS_XB), RS + (size_t)(2 * l + 1) * T * 16};
            pg8::gemm_phase<pg8::EpiResidual<l == 0>, pg8::StaticOrder, true, true>(lds, g, S, E, tid); }
        else if constexpr (s == 5) { pg8::Gemm g{(const pg8::bf16_t*)(P.ws + WS_XB), (const pg8::bf16_t*)(P.ws + WS_WGU) + (size_t)l * NGU * D, T, NGU, D};
            pg8::StaticOrder S; S.init(T, NGU, G, bid); const int fm = pg8::stage_rstd(RS + (size_t)(2 * l + 1) * T * 16, lds, S, tid);
            pg8::EpiSwiGLU E{(pg8::bf16_t*)(P.ws + WS_U), FF, RS + (size_t)(2 * l + 1) * T * 16, (const LAS float*)(lds + pg8::RSTD_LDS_OFF), fm};
            pg8::gemm_phase<pg8::EpiSwiGLU, pg8::StaticOrder, true, true>(lds, g, S, E, tid);
            if constexpr (l + 1 < DEPTH) convert_in_slack(P, lds, l + 1, 960, 3072, (T / 256) * (NGU / 256), bid, G, wid, lane); }
        else { pg8::Gemm g{(const pg8::bf16_t*)(P.ws + WS_U), (const pg8::bf16_t*)(P.ws + WS_WD) + (size_t)l * D * FF, T, D, FF};
            pg8::StaticOrder S; S.init(T, D, G, bid); pg8::EpiResidual<false> E{nullptr, D, (pg8::bf16_t*)(P.ws + WS_XB), RS + (size_t)(2 * l + 2) * T * 16};
            pg8::gemm_phase<pg8::EpiResidual<false>, pg8::StaticOrder, true, true>(lds, g, S, E, tid); }
    }
}
template <int PH> __device__ __forceinline__ void run_all(const Params& P0, LAS unsigned char* lds, const int wid0, const int lo, const int hi) {
    if constexpr (PH < N_PHASES) {
        if (PH >= lo && PH < hi) { run_phase<PH>(P0, lds, wid0);
#if DUP_S
            if constexpr (PH >= 1 && PH < N_PHASES - 1 && ((DUP_S >> ((PH - 1) % NPH)) & 1)) { __syncthreads(); run_phase<PH>(P0, lds, wid0); }
            if constexpr (PH == 0 && ((DUP_S >> 30) & 1)) { __syncthreads(); run_phase<PH>(P0, lds, wid0); }
#endif
            if (PH + 1 < hi) {
#pragma unroll
                for (int rep = 0; rep < SYNC_REP; ++rep) grid_sync(P0.ws, lds, wid0); } }
        run_all<PH + 1>(P0, lds, wid0, lo, hi);
    }
}
__global__ void __launch_bounds__(512, 2) mega(Params P0) {
    extern __shared__ __attribute__((aligned(16))) unsigned char lds_raw[];
    LAS unsigned char* lds = (LAS unsigned char*)lds_raw;
    const int wid0 = __builtin_amdgcn_readfirstlane(threadIdx.x >> 6);
    { const bool leader = is_leader(wid0);
      if (leader) { ((volatile LAS unsigned*)(lds + BAR_LDS_OFF))[0] = 0u; ((volatile LAS unsigned*)(lds + BAR_LDS_OFF))[1] = 0u; }
      __syncthreads();
      if (P0.ph_hi - P0.ph_lo > 1) (void)xcd_barrier_post((unsigned*)(P0.ws + WS_BAR), (volatile LAS unsigned*)(lds + BAR_LDS_OFF), leader); }
    run_all<0>(P0, lds, wid0, P0.ph_lo, P0.ph_hi);
}

#ifndef ONE_LAUNCH
#define ONE_LAUNCH 1
#endif
extern "C" void kernel_launch(void* const* d_in, const int* in_sizes, int n_in, void* d_out, int out_size, void* d_ws, size_t ws_size, hipStream_t stream) {
    static int grid = 0;
    if (grid == 0) {
        if (n_in != 16 || out_size != T * D || ws_size < WS_END) { fprintf(stderr, "kernel_launch: unexpected shapes n_in %d out %d ws %zu\n", n_in, out_size, ws_size); grid = -1; return; }
        int dev = 0, cus = 0, per_cu = 0;
        hipGetDevice(&dev); hipDeviceGetAttribute(&cus, hipDeviceAttributeMultiprocessorCount, dev);
        if (hipFuncSetAttribute((const void*)mega, hipFuncAttributeMaxDynamicSharedMemorySize, LDS_BYTES) != hipSuccess) { fprintf(stderr, "kernel_launch: hipFuncSetAttribute failed\n"); grid = -1; return; }
        hipOccupancyMaxActiveBlocksPerMultiprocessor(&per_cu, (const void*)mega, 512, LDS_BYTES);
        if (per_cu < 1) { fprintf(stderr, "kernel_launch: occupancy query says %d\n", per_cu); per_cu = 1; }
        (void)hipGetLastError();
        grid = cus * per_cu;
    }
    if (grid < 0) return;
    if (hipMemsetAsync((char*)d_ws + WS_CTL, 0, 131072, stream) != hipSuccess) { fprintf(stderr, "kernel_launch: memset failed\n"); return; }
    Params p{};
    for (int i = 0; i < 16; ++i) p.in[i] = (const float*)d_in[i];
    p.out = (float*)d_out; p.ws = (unsigned char*)d_ws;
#if ONE_LAUNCH
    p.ph_lo = 0; p.ph_hi = N_PHASES;
    void* args[] = {&p};
    hipError_t e = hipLaunchCooperativeKernel((const void*)mega, dim3(grid), dim3(512), args, LDS_BYTES, stream);
    if (e != hipSuccess) fprintf(stderr, "cooperative launch failed: %s (grid %d)\n", hipGetErrorString(e), grid);
#else
    for (int ph = 0; ph < N_PHASES; ++ph) { p.ph_lo = ph; p.ph_hi = ph + 1; hipLaunchKernelGGL(mega, dim3(grid), dim3(512), LDS_BYTES, stream, p); }
#endif
}
```
